# Optimizing an MI355X kernel written in HIP

```python
import jax, jax.numpy as jnp
from jax import lax
import numpy as np

D_MODEL = 1024
BATCH = 8
SEQ = 4096
DEPTH = 1

PLE_DIM = 256
MIX_WIDTH = D_MODEL
HG_WIDTH = D_MODEL // 2
HG_HEADS = 4
HG_DK = HG_WIDTH // HG_HEADS
HG_DV = HG_WIDTH // HG_HEADS
HG_CHUNK = 64
SB_WIDTH = MIX_WIDTH - HG_WIDTH
SB_HEADS = 8
SB_DH = SB_WIDTH // SB_HEADS
SB_BLOCK = 128
D_FF = -(-8 * D_MODEL // (3 * 256)) * 256
IN_COLS = 4 * HG_WIDTH + 3 * SB_WIDTH
EPS = 1e-6

kernel_name = "hybrid_hgrn2_stickbreaking_block"


def rmsnorm(x, w):
    xf = x.astype(jnp.float32)
    xf = xf * lax.rsqrt(jnp.mean(xf * xf, axis=-1, keepdims=True) + EPS)
    return xf.astype(x.dtype) * w


def _to_chunks(a, heads, d):
    B, T, _ = a.shape
    return a.reshape(B, T // HG_CHUNK, HG_CHUNK, heads, d).transpose(1, 0, 3, 2, 4)


def hgrn2_mix(q, f_logit, i_in, lb):
    B, T, _ = q.shape
    q = jax.nn.silu(q.astype(jnp.float32))
    z = f_logit.astype(jnp.float32)
    log_f = jnp.logaddexp(jnp.log(lb), jnp.log1p(-lb) + jax.nn.log_sigmoid(z))
    k = -jnp.expm1(log_f)
    v = i_in.astype(jnp.float32)
    qc = _to_chunks(q, HG_HEADS, HG_DK)
    kc = _to_chunks(k, HG_HEADS, HG_DK)
    gc = _to_chunks(log_f, HG_HEADS, HG_DK)
    vc = _to_chunks(v, HG_HEADS, HG_DV)
    incl = jnp.tril(jnp.ones((HG_CHUNK, HG_CHUNK), dtype=bool))

    def step(S, inp):
        qb, kb, gb, vb = inp
        b = jnp.cumsum(gb, axis=2)
        o_inter = jnp.einsum('bhtk,bhkv->bhtv', qb * jnp.exp(b), S)
        diff = b[:, :, :, None, :] - b[:, :, None, :, :]
        decay = jnp.where(incl[:, :, None], jnp.exp(jnp.minimum(diff, 0.0)), 0.0)
        scores = jnp.einsum('bhtsk,bhsk->bhts', qb[:, :, :, None, :] * decay, kb)
        o_intra = jnp.einsum('bhts,bhsv->bhtv', scores, vb)
        b_last = b[:, :, -1:, :]
        S_new = jnp.exp(b_last[:, :, 0, :])[..., None] * S + jnp.einsum(
            'bhsk,bhsv->bhkv', kb * jnp.exp(b_last - b), vb)
        return S_new, o_inter + o_intra

    S0 = jnp.zeros((B, HG_HEADS, HG_DK, HG_DV), jnp.float32)
    _, oc = lax.scan(step, S0, (qc, kc, gc, vc))
    return oc.transpose(1, 0, 3, 2, 4).reshape(B, T, HG_HEADS * HG_DV)


def stick_breaking_mix(q, k, v):
    B, T, H, d = q.shape
    scale = d ** -0.5
    outs = []
    for blk in range(T // SB_BLOCK):
        t0 = blk * SB_BLOCK
        t1 = t0 + SB_BLOCK
        qb = q[:, t0:t1]
        kp = k[:, :t1]
        vp = v[:, :t1]
        z = jnp.einsum('bthd,bshd->bhts', qb, kp).astype(jnp.float32) * scale
        causal = jnp.arange(t1)[None, :] < jnp.arange(t0, t1)[:, None]
        log_1mb = jnp.where(causal, -jax.nn.softplus(z), 0.0)
        rem = lax.cumsum(log_1mb, axis=3, reverse=True) - log_1mb
        a = jnp.where(causal, jnp.exp(jax.nn.log_sigmoid(z) + rem), 0.0)
        outs.append(jnp.einsum('bhts,bshd->bthd', a.astype(v.dtype), vp))
    return jnp.concatenate(outs, axis=1)


def setup_inputs(seed: int = 0) -> dict:
    key = jax.random.key(seed)
    ks = jax.random.split(key, 16)
    f32 = jnp.float32
    nrm = lambda k, shape, s: jax.random.normal(k, shape, f32) * s
    gain = lambda k, shape: 1.0 + 0.05 * jax.random.normal(k, shape, f32)
    return {
        "x": jax.random.normal(ks[0], (BATCH, SEQ, D_MODEL), f32),
        "p": jax.random.normal(ks[1], (DEPTH, BATCH, SEQ, PLE_DIM), f32),
        "attn_pre_norm": gain(ks[2], (DEPTH, D_MODEL)),
        "w_in": nrm(ks[3], (DEPTH, D_MODEL, IN_COLS), D_MODEL ** -0.5),
        "hg_lower_gamma": nrm(ks[4], (DEPTH + 1, HG_WIDTH), 0.5),
        "hg_out_norm": gain(ks[5], (DEPTH, HG_WIDTH)),
        "sb_out_norm": gain(ks[6], (DEPTH, SB_WIDTH)),
        "w_out": nrm(ks[7], (DEPTH, MIX_WIDTH, D_MODEL), MIX_WIDTH ** -0.5),
        "attn_post_norm": gain(ks[8], (DEPTH, D_MODEL)),
        "ffn_pre_norm": gain(ks[9], (DEPTH, D_MODEL)),
        "w_gate_up": nrm(ks[10], (DEPTH, D_MODEL, 2 * D_FF), D_MODEL ** -0.5),
        "w_down": nrm(ks[11], (DEPTH, D_FF, D_MODEL), D_FF ** -0.5),
        "ffn_post_norm": gain(ks[12], (DEPTH, D_MODEL)),
        "ple_proj": nrm(ks[13], (DEPTH, PLE_DIM, D_MODEL), PLE_DIM ** -0.5),
        "ple_gate": nrm(ks[14], (DEPTH, D_MODEL, D_MODEL), D_MODEL ** -0.5),
    }


def reference(x, p, attn_pre_norm, w_in, hg_lower_gamma, hg_out_norm, sb_out_norm, w_out,
              attn_post_norm, ffn_pre_norm, w_gate_up, w_down, ffn_post_norm, ple_proj, ple_gate):
    B, T, _ = x.shape
    lb_all = jnp.cumsum(jax.nn.softmax(hg_lower_gamma.astype(jnp.float32), axis=0), axis=0)
    splits = [HG_WIDTH, 2 * HG_WIDTH, 3 * HG_WIDTH, 4 * HG_WIDTH,
              4 * HG_WIDTH + SB_WIDTH, 4 * HG_WIDTH + 2 * SB_WIDTH]
    h = x
    for i in range(DEPTH):
        u = rmsnorm(h, attn_pre_norm[i])
        proj = u @ w_in[i]
        hq, hf, hi, hg, sq, sk, sv = jnp.split(proj, splits, axis=-1)
        o_hg = hgrn2_mix(hq, hf, hi, lb_all[i])
        o_hg = rmsnorm(o_hg.astype(x.dtype), hg_out_norm[i]) * jax.nn.silu(hg)
        o_sb = stick_breaking_mix(sq.reshape(B, T, SB_HEADS, SB_DH),
                                  sk.reshape(B, T, SB_HEADS, SB_DH),
                                  sv.reshape(B, T, SB_HEADS, SB_DH)).reshape(B, T, SB_WIDTH)
        o_sb = rmsnorm(o_sb, sb_out_norm[i])
        mix = jnp.concatenate([o_hg, o_sb], axis=-1) @ w_out[i]
        h = h + rmsnorm(mix, attn_post_norm[i])
        u = rmsnorm(h, ffn_pre_norm[i])
        gate, up = jnp.split(u @ w_gate_up[i], [D_FF], axis=-1)
        y = (jax.nn.silu(gate) * up) @ w_down[i]
        h = h + rmsnorm(y, ffn_post_norm[i])
        h = h + (p[i] @ ple_proj[i]) * jax.nn.sigmoid(h @ ple_gate[i])
    return h
```

```cpp
#include <hip/hip_runtime.h>
#include <hip/hip_cooperative_groups.h>
#include <cstdio>
#include <cstdint>
namespace cg = cooperative_groups;

#ifndef MEGA
#define MEGA 1
#endif

typedef unsigned short bf16_t;
typedef short bf16x8 __attribute__((ext_vector_type(8)));
typedef float f32x4 __attribute__((ext_vector_type(4)));
typedef unsigned u32x4 __attribute__((ext_vector_type(4)));
typedef unsigned u32x2 __attribute__((ext_vector_type(2)));

constexpr int NB = 8, NT = 4096, DM = 1024, MT = NB * NT;
constexpr int NIN = 3584, DFF = 2816, PLE = 256;
constexpr float EPS = 1e-6f;
constexpr float LOG2E = 1.4426950408889634f;

constexpr size_t MiB = 1ull << 20;
constexpr size_t OFF_WIN = 0;
constexpr size_t OFF_WOUT = 7 * MiB;
constexpr size_t OFF_WGU = 9 * MiB;
constexpr size_t OFF_WDN = 20 * MiB;
constexpr size_t OFF_WPP = 26 * MiB;
constexpr size_t OFF_WPG = 27 * MiB;
constexpr size_t OFF_RX = 30 * MiB;
constexpr size_t OFF_RH1 = 31 * MiB;
constexpr size_t OFF_LB = 32 * MiB;
constexpr size_t OFF_PB = 40 * MiB;
constexpr size_t OFF_XB = 56 * MiB;
constexpr size_t OFF_SQ = 120 * MiB;
constexpr size_t OFF_Y = 56 * MiB;
constexpr size_t OFF_QT = 216 * MiB;
constexpr size_t OFF_BC = 344 * MiB;
constexpr size_t OFF_ACT = 216 * MiB;
constexpr size_t OFF_H2B = 216 * MiB;
constexpr size_t OFF_PLE = 408 * MiB;
constexpr size_t OFF_SLOC = 472 * MiB;
constexpr size_t OFF_AMIX = 408 * MiB;
constexpr size_t OFF_PART1 = 35 * MiB;
constexpr size_t OFF_PART2 = 36 * MiB;
constexpr size_t OFF_PART3 = 37 * MiB;
constexpr size_t OFF_CNT = 34 * MiB + 16384;
constexpr size_t CTL_BYTES = 16384 + 2 * 128 * 64 * 4 + 256;
constexpr size_t OFF_BAR = 34 * MiB;
constexpr size_t OFF_DC = 33 * MiB;
constexpr size_t OFF_U = 56 * MiB;
constexpr size_t OFF_SC = 120 * MiB;
constexpr size_t OFF_VHT = 216 * MiB + 2 * (32 * MiB);
constexpr size_t OFF_SVT = 120 * MiB + 2 * (32 * MiB);
constexpr size_t SZ_HALF = 32 * MiB;

struct Params {
    const float *x, *p, *g_attn_pre, *w_in, *gamma, *g_hg, *g_sb, *w_out, *g_attn_post, *g_ffn_pre, *w_gu, *w_down, *g_ffn_post, *w_pp, *w_pg;
    float* out; char* ws;
};

typedef __bf16 bf2_t __attribute__((ext_vector_type(2)));
typedef float f32x2 __attribute__((ext_vector_type(2)));
typedef float f32x16 __attribute__((ext_vector_type(16)));
__device__ __forceinline__ unsigned cvt_pk_bf16(float lo, float hi) { f32x2 v = {lo, hi}; return __builtin_bit_cast(unsigned, __builtin_convertvector(v, bf2_t)); }
__device__ __forceinline__ float bf2f(bf16_t h) { return __uint_as_float(((unsigned)h) << 16); }
__device__ __forceinline__ float bflo(unsigned u) { return __uint_as_float(u << 16); }
__device__ __forceinline__ float bfhi(unsigned u) { return __uint_as_float(u & 0xffff0000u); }
__device__ __forceinline__ float fexp2(float x) { return __builtin_amdgcn_exp2f(x); }
__device__ __forceinline__ float frcp(float x) { return __builtin_amdgcn_rcpf(x); }
__device__ __forceinline__ float sigmoidf_(float x) { return frcp(1.0f + fexp2(-x * LOG2E)); }
__device__ __forceinline__ float siluf_(float x) { return x * sigmoidf_(x); }
__device__ __forceinline__ float wave_sum(float v) {
#pragma unroll
    for (int o = 32; o >= 1; o >>= 1) v += __shfl_xor(v, o);
    return v;
}

__device__ __forceinline__ int opaque_tid() { int t = threadIdx.x; asm volatile("" : "+v"(t)); return t; }

namespace pg8 {
#define PG8_LAS __attribute__((address_space(3)))
typedef unsigned short bf16_t;
typedef short bf16x8 __attribute__((ext_vector_type(8)));
typedef float f32x4 __attribute__((ext_vector_type(4)));
typedef unsigned u32x4 __attribute__((ext_vector_type(4)));
constexpr int BM = 256, BK = 64, HALF = 128, HTB = HALF * BK * 2  , STAGE_BYTES = 8 * HTB, NXCD = 8, WGM = 8;

__host__ __device__ __forceinline__ int lds_byte(int r, int c) { const int st = (r >> 4) * 2 + (c >> 5), rr = r & 15, cc = c & 31, ob = rr * 64 + cc * 2; return st * 1024 + (ob ^ (((ob >> 9) & 1) << 5)); }
__host__ __device__ __forceinline__ void stage_rc(int b, int& R, int& C) { const int st = b / 1024, sb = b % 1024, swz = sb ^ (((sb >> 9) & 1) << 5); R = (st >> 1) * 16 + swz / 64; C = (st & 1) * 32 + (swz % 64) / 2; }
__host__ __device__ __forceinline__ int perm32(int rho) { const int n = rho >> 4, i = rho & 15; return 8 * (i >> 2) + 4 * n + (i & 3); }

struct Unit { int pm, pn; };
struct Gemm { const bf16_t* A; const bf16_t* Bt; int M, N, K; };

struct StaticOrder {
    int nM, nN, nwg, G, c;
    __host__ __device__ void init(int M, int N, int G_, int c_) { nM = M / BM; nN = N / BM; nwg = nM * nN; G = G_; c = c_; }
    __host__ __device__ bool next(int i, Unit& u) const {
        const long L = (long)i * G + c; if (L >= nwg) return false;
        int wgid = (int)L; { const int q = nwg / NXCD, r = nwg % NXCD, xcd = wgid % NXCD, off = wgid / NXCD; wgid = (xcd < r ? xcd * (q + 1) : r * (q + 1) + (xcd - r) * q) + off; }
        const int nig = WGM * nN, gid = wgid / nig, fm = gid * WGM, gsz = (nM - fm) < WGM ? (nM - fm) : WGM;
        u.pm = fm + ((wgid % nig) % gsz); u.pn = (wgid % nig) / gsz; return true;
    }
    __device__ __forceinline__ void a_ready(const Unit&) const {}
    __device__ __forceinline__ void done(const Unit&) const {}
};
template <class Epi, class Sched, bool ALIGN_EPI = false, bool SP2 = false>
__device__ __forceinline__ void gemm_phase(PG8_LAS unsigned char* lds, const Gemm g, const Sched& S, const Epi& E) {
    const int tid = opaque_tid(), wid = __builtin_amdgcn_readfirstlane(tid >> 6), lane = tid & 63, wr = wid >> 2, wc = wid & 3, fr = lane & 15, fq = lane >> 4;
    const int K = g.K, nt = K / BK;
    unsigned voffA[2], voffB[2];
#pragma unroll
    for (int i = 0; i < 2; ++i) { int R, C; stage_rc(tid * 16 + i * 8192, R, C); const int Rb = Epi::PERM ? ((R & ~31) + perm32(R & 31)) : R;
        voffA[i] = (unsigned)(R * K + C) * 2u; voffB[i] = (unsigned)(Rb * K + C) * 2u; }
    const size_t kstep = (size_t)(BK * 2);
    const size_t hstep = (size_t)HALF * K * 2;
    const size_t tstep = 2 * hstep;
    const unsigned ldsw = (unsigned)wid * 1024u;
    const int aoff = lds_byte(wr * 64 + fr, fq * 8), boff = lds_byte(wc * 32 + fr, fq * 8);
#define PG8_SA(b, h) (((b) * 2 + (h)) * HTB)
#define PG8_SB(b, h) ((4 + (b) * 2 + (h)) * HTB)
#define PG8_STAGE(bufoff, gbase, voff) do { _Pragma("unroll") for (int _i = 0; _i < 2; ++_i) \
        __builtin_amdgcn_global_load_lds((const unsigned*)((const char*)(gbase) + (voff)[_i]), (PG8_LAS unsigned*)(lds + (bufoff) + ldsw + _i * 8192), 16, 0, 0); } while (0)
#define PG8_LDA(dst, b, h) do { _Pragma("unroll") for (int m = 0; m < 4; ++m) _Pragma("unroll") for (int k = 0; k < 2; ++k) dst[m][k] = *(const PG8_LAS bf16x8*)(lds + PG8_SA(b, h) + aoff + m * 2048 + k * 1024); } while (0)
#define PG8_LDB(dst, b, h) do { _Pragma("unroll") for (int n = 0; n < 2; ++n) _Pragma("unroll") for (int k = 0; k < 2; ++k) dst[n][k] = *(const PG8_LAS bf16x8*)(lds + PG8_SB(b, h) + boff + n * 2048 + k * 1024); } while (0)
#define PG8_MMA(ai, bj, At, Bt) do { __builtin_amdgcn_s_setprio(1); _Pragma("unroll") for (int m = 0; m < 4; ++m) _Pragma("unroll") for (int n = 0; n < 2; ++n) _Pragma("unroll") for (int k = 0; k < 2; ++k) \
        acc[ai][bj][m][n] = __builtin_amdgcn_mfma_f32_16x16x32_bf16(Bt[n][k], At[m][k], acc[ai][bj][m][n], 0, 0, 0); __builtin_amdgcn_s_setprio(0); } while (0)
#define PG8_WAIT_V(n) asm volatile("s_waitcnt vmcnt(" #n ")" ::: "memory")
#define PG8_WAIT_L(n) asm volatile("s_waitcnt lgkmcnt(" #n ")" ::: "memory")
#define PG8_BAR __builtin_amdgcn_s_barrier()
#define PG8_SCHED __builtin_amdgcn_sched_barrier(0)
    Unit cur, nxt; int ui = 0;
    if (!S.next(0, cur)) return;
    f32x4 acc[2][2][4][2];
#pragma unroll
    for (int a = 0; a < 2; ++a)
#pragma unroll
        for (int b = 0; b < 2; ++b)
#pragma unroll
            for (int m = 0; m < 4; ++m)
#pragma unroll
                for (int n = 0; n < 2; ++n) acc[a][b][m][n] = (f32x4){0.f, 0.f, 0.f, 0.f};
    bf16x8 At[4][2], B0[2][2], B1[2][2];
    const char* cA = (const char*)g.A + (size_t)cur.pm * tstep; const char* cB = (const char*)g.Bt + (size_t)cur.pn * tstep;
    S.a_ready(cur);
    if constexpr (Epi::MIDSCALE) E.load_mid(cur);
    typename Epi::Pre pre = {};
    if constexpr (Epi::ROWPRE) pre = E.pre_issue(cur);
    if constexpr (SP2) {
        PG8_STAGE(PG8_SB(0, 0), cB, voffB); PG8_STAGE(PG8_SB(0, 1), cB + hstep, voffB); PG8_STAGE(PG8_SA(0, 0), cA, voffA); PG8_STAGE(PG8_SA(0, 1), cA + hstep, voffA);
        if (wr == 1) PG8_BAR;
        PG8_WAIT_V(2); PG8_BAR;
        PG8_STAGE(PG8_SB(1, 0), cB + kstep, voffB); PG8_STAGE(PG8_SA(1, 0), cA + kstep, voffA); PG8_STAGE(PG8_SB(1, 1), cB + hstep + kstep, voffB);
        PG8_WAIT_V(6); PG8_BAR;
    } else {
        PG8_STAGE(PG8_SB(0, 0), cB, voffB); PG8_STAGE(PG8_SA(0, 0), cA, voffA); PG8_STAGE(PG8_SB(0, 1), cB + hstep, voffB); PG8_STAGE(PG8_SA(0, 1), cA + hstep, voffA);
        if (wr == 1) PG8_BAR;
        PG8_WAIT_V(4); PG8_BAR;
        PG8_STAGE(PG8_SB(1, 0), cB + kstep, voffB); PG8_STAGE(PG8_SA(1, 0), cA + kstep, voffA); PG8_STAGE(PG8_SB(1, 1), cB + hstep + kstep, voffB);
        PG8_WAIT_V(6); PG8_BAR;
    }
    for (;;) {
        const bool has_next = S.next(ui + 1, nxt);
        const char* nA = has_next ? (const char*)g.A + (size_t)nxt.pm * tstep : cA; const char* nB = has_next ? (const char*)g.Bt + (size_t)nxt.pn * tstep : cB;
        for (int t = 0; t < nt; t += 2) {
            const bool last = (t == nt - 2);
            const char* a1 = cA + (size_t)(t + 1) * kstep;
            const char* a2 = last ? nA : cA + (size_t)(t + 2) * kstep; const char* b2 = last ? nB : cB + (size_t)(t + 2) * kstep;
            const char* a3 = a2 + kstep; const char* b3 = b2 + kstep;
            if (last && has_next) S.a_ready(nxt);
            if constexpr (Epi::ROWPRE) { if (t == 8) E.pre_commit(pre); }
            if constexpr (Epi::MIDSCALE) { if (t == Epi::MID_T) {
_Pragma("unroll") for (int a = 0; a < 2; ++a) _Pragma("unroll") for (int m = 0; m < 4; ++m) { const float sc_ = E.mid_scale(a * HALF + wr * 64 + m * 16 + fr);
_Pragma("unroll") for (int b = 0; b < 2; ++b) _Pragma("unroll") for (int n = 0; n < 2; ++n) acc[a][b][m][n] = acc[a][b][m][n] * sc_; } } }
            if constexpr (SP2) {
            PG8_LDB(B0, 0, 0); PG8_LDB(B1, 0, 1); PG8_SCHED; PG8_LDA(At, 0, 0); PG8_STAGE(PG8_SA(1, 1), a1 + hstep, voffA);
            PG8_WAIT_V(8); PG8_WAIT_L(0); PG8_BAR; PG8_MMA(0, 0, At, B0); PG8_MMA(0, 1, At, B1); PG8_BAR; PG8_SCHED;
            PG8_LDA(At, 0, 1); PG8_STAGE(PG8_SB(0, 0), b2, voffB); PG8_STAGE(PG8_SB(0, 1), b2 + hstep, voffB); PG8_STAGE(PG8_SA(0, 0), a2, voffA);
            PG8_WAIT_V(8); PG8_WAIT_L(0); PG8_BAR; PG8_MMA(1, 0, At, B0); PG8_MMA(1, 1, At, B1); PG8_BAR; PG8_SCHED;
            PG8_LDB(B0, 1, 0); PG8_LDB(B1, 1, 1); PG8_SCHED; PG8_LDA(At, 1, 0); PG8_STAGE(PG8_SA(0, 1), a2 + hstep, voffA);
            PG8_WAIT_V(8); PG8_WAIT_L(0); PG8_BAR; PG8_MMA(0, 0, At, B0); PG8_MMA(0, 1, At, B1); PG8_BAR; PG8_SCHED;
            PG8_LDA(At, 1, 1); PG8_STAGE(PG8_SB(1, 0), b3, voffB); PG8_STAGE(PG8_SB(1, 1), b3 + hstep, voffB); PG8_STAGE(PG8_SA(1, 0), a3, voffA);
            PG8_WAIT_V(8); PG8_WAIT_L(0); PG8_BAR; PG8_MMA(1, 0, At, B0); PG8_MMA(1, 1, At, B1); PG8_BAR; PG8_SCHED;
            } else {
            PG8_LDB(B0, 0, 0); PG8_SCHED; PG8_LDA(At, 0, 0); PG8_STAGE(PG8_SA(1, 1), a1 + hstep, voffA);
            PG8_WAIT_L(8); PG8_BAR; PG8_WAIT_L(0); PG8_MMA(0, 0, At, B0); PG8_BAR; PG8_SCHED;
            PG8_LDB(B1, 0, 1); PG8_STAGE(PG8_SB(0, 0), b2, voffB);
            PG8_BAR; PG8_WAIT_L(0); PG8_MMA(0, 1, At, B1); PG8_BAR;
            PG8_LDA(At, 0, 1); PG8_STAGE(PG8_SA(0, 0), a2, voffA);
            PG8_BAR; PG8_WAIT_L(0); PG8_MMA(1, 0, At, B0); PG8_BAR; PG8_SCHED;
            PG8_STAGE(PG8_SB(0, 1), b2 + hstep, voffB);
            PG8_WAIT_V(6); PG8_BAR; PG8_MMA(1, 1, At, B1); PG8_BAR;
            PG8_LDB(B0, 1, 0); PG8_SCHED; PG8_LDA(At, 1, 0); PG8_STAGE(PG8_SA(0, 1), a2 + hstep, voffA);
            PG8_WAIT_L(8); PG8_BAR; PG8_WAIT_L(0); PG8_MMA(0, 0, At, B0); PG8_BAR; PG8_SCHED;
            PG8_LDB(B1, 1, 1); PG8_STAGE(PG8_SB(1, 0), b3, voffB);
            PG8_BAR; PG8_WAIT_L(0); PG8_MMA(0, 1, At, B1); PG8_BAR;
            PG8_LDA(At, 1, 1); PG8_STAGE(PG8_SA(1, 0), a3, voffA);
            PG8_BAR; PG8_WAIT_L(0); PG8_MMA(1, 0, At, B0); PG8_BAR; PG8_SCHED;
            PG8_STAGE(PG8_SB(1, 1), b3 + hstep, voffB);
            PG8_WAIT_V(6); PG8_BAR; PG8_MMA(1, 1, At, B1); PG8_BAR;
            }
        }
        if constexpr (ALIGN_EPI) { if (wr == 0) PG8_BAR; }
        if constexpr (!Epi::AFTER_DRAIN) { E(acc, cur, wr, wc, fr, fq); S.done(cur); }
        if (!has_next) break;
#pragma unroll
        for (int a = 0; a < 2; ++a)
#pragma unroll
            for (int b = 0; b < 2; ++b)
#pragma unroll
                for (int m = 0; m < 4; ++m)
#pragma unroll
                    for (int n = 0; n < 2; ++n) acc[a][b][m][n] = (f32x4){0.f, 0.f, 0.f, 0.f};
        cur = nxt; cA = nA; cB = nB; ++ui;
        if constexpr (Epi::MIDSCALE) E.load_mid(cur);
        if constexpr (Epi::ROWPRE) pre = E.pre_issue(cur);
        if constexpr (ALIGN_EPI) { if (wr == 1) PG8_BAR; }
    }
    PG8_WAIT_V(0);
    if constexpr (!ALIGN_EPI) { if (wr == 0) PG8_BAR; }
    PG8_BAR;
    if constexpr (Epi::AFTER_DRAIN) { E.fused(acc, cur, wr, wc, fr, fq, lds, wid, lane); S.done(cur); }
#undef PG8_SA
#undef PG8_SB
#undef PG8_STAGE
#undef PG8_LDA
#undef PG8_LDB
#undef PG8_MMA
#undef PG8_WAIT_V
#undef PG8_WAIT_L
#undef PG8_BAR
#undef PG8_SCHED
}
}

#define EPI_ARGS const f32x4 (&acc)[2][2][4][2], const pg8::Unit& u, int wr, int wc, int fr, int fq
#define EPI_HEAD static constexpr bool PERM = true, AFTER_DRAIN = false, MIDSCALE = false, ROWPRE = false; typedef int Pre;
#define EPI_HEAD_PRE(T) static constexpr bool PERM = true, AFTER_DRAIN = false, MIDSCALE = false, ROWPRE = true; typedef T Pre;
#define EPI_RC const int brow = u.pm * 256, bcol = u.pn * 256;
constexpr int HALF = 128, SHM_B = 131072, LDS_TOTAL = SHM_B + 16 + 4096 + 1024;
struct EpiIn {
    EPI_HEAD_PRE(float)
    const float* rx; char* ws; char* lds;
    __device__ __forceinline__ float pre_issue(const pg8::Unit& u) const { return threadIdx.x < 256 ? rx[u.pm * 256 + threadIdx.x] : 0.f; }
    __device__ __forceinline__ void pre_commit(float v) const { if (threadIdx.x < 256) ((float*)(lds + 4096))[threadIdx.x] = v; }
    __device__ __forceinline__ void operator()(EPI_ARGS) const { EPI_RC
        const int kind = bcol >> 9;
        const int lc0 = (bcol & 256) + wc * 32 + 8 * fq;
        bf16_t* dst = (bf16_t*)(ws + (kind == 0 ? OFF_QT : kind == 1 ? OFF_QT + SZ_HALF : kind == 2 ? OFF_QT + 3 * SZ_HALF : kind == 3 ? OFF_SQ : OFF_SQ + SZ_HALF));
        if (kind == 1) {
            float* dstf = (float*)(ws + OFF_BC); const float* lbp = (const float*)(ws + OFF_LB);
#pragma unroll
            for (int bj = 0; bj < 2; ++bj)
#pragma unroll
                for (int n = 0; n < 2; ++n) {
                    const f32x4 l0 = *(const f32x4*)(lbp + lc0 + bj * HALF + 4 * n), m0 = *(const f32x4*)(lbp + 512 + lc0 + bj * HALF + 4 * n);
                    float rsv[2][4];
#pragma unroll
                    for (int ai = 0; ai < 2; ++ai)
#pragma unroll
                        for (int m = 0; m < 4; ++m) rsv[ai][m] = ((const float*)(lds + 4096))[ai * HALF + wr * 64 + m * 16 + fr];
#pragma unroll
                    for (int ai = 0; ai < 2; ++ai)
#pragma unroll
                        for (int m = 0; m < 4; ++m) {
                            const int row = brow + ai * HALF + wr * 64 + m * 16 + fr; const float rs = rsv[ai][m];
                            const f32x4 z = acc[ai][bj][m][n] * rs; f32x4 lf, kk;
#pragma unroll
                            for (int j = 0; j < 4; ++j) { const float s = sigmoidf_(z[j]); lf[j] = __builtin_amdgcn_logf(l0[j] + m0[j] * s)  ; kk[j] = m0[j] * (1.0f - s); }
                            const size_t o = (size_t)row * 512 + lc0 + bj * HALF + 4 * n;
                            *(f32x4*)(dstf + o) = lf; u32x2 w; w.x = cvt_pk_bf16(kk[0], kk[1]); w.y = cvt_pk_bf16(kk[2], kk[3]); *(u32x2*)(dst + o) = w;
                        }
                }
            return;
        }
        float rsv[2][4];
#pragma unroll
        for (int ai = 0; ai < 2; ++ai)
#pragma unroll
            for (int m = 0; m < 4; ++m) rsv[ai][m] = ((const float*)(lds + 4096))[ai * HALF + wr * 64 + m * 16 + fr] * (kind == 3 ? 0.125f * LOG2E : 1.0f);
#pragma unroll
        for (int ai = 0; ai < 2; ++ai)
#pragma unroll
            for (int m = 0; m < 4; ++m) {
                const int row = brow + ai * HALF + wr * 64 + m * 16 + fr;
                const float rs = rsv[ai][m];
#pragma unroll
                for (int bj = 0; bj < 2; ++bj) {
                    f32x4 v0 = acc[ai][bj][m][0] * rs, v1 = acc[ai][bj][m][1] * rs;
                    if (kind == 0 || kind == 2) {
#pragma unroll
                        for (int j = 0; j < 4; ++j) { v0[j] = siluf_(v0[j]); v1[j] = siluf_(v1[j]); }
                    }
                    u32x4 w; w.x = cvt_pk_bf16(v0[0], v0[1]); w.y = cvt_pk_bf16(v0[2], v0[3]); w.z = cvt_pk_bf16(v1[0], v1[1]); w.w = cvt_pk_bf16(v1[2], v1[3]);
                    *(u32x4*)(dst + (size_t)row * 512 + lc0 + bj * HALF) = w;
                }
            }
    }
};
struct EpiVT {
    EPI_HEAD_PRE(float)
    const float* rx; char* ws; char* lds;
    __device__ __forceinline__ float pre_issue(const pg8::Unit& u) const { return threadIdx.x < 256 ? rx[u.pn * 256 + threadIdx.x] : 0.f; }
    __device__ __forceinline__ void pre_commit(float v) const { if (threadIdx.x < 256) ((float*)(lds + 4096))[threadIdx.x] = v; }
    __device__ __forceinline__ void operator()(EPI_ARGS) const { EPI_RC
        bf16_t* dst = (bf16_t*)(ws + (brow < 512 ? OFF_VHT : OFF_SVT));
        const int r0 = (brow & 511) + wr * 64 + fr, c0 = bcol + wc * 32 + 8 * fq;
#pragma unroll
        for (int bj = 0; bj < 2; ++bj) {
            const f32x4 s0 = *(const f32x4*)((const float*)(lds + 4096) + wc * 32 + 8 * fq + bj * HALF), s1 = *(const f32x4*)((const float*)(lds + 4096) + wc * 32 + 8 * fq + bj * HALF + 4);
#pragma unroll
            for (int ai = 0; ai < 2; ++ai)
#pragma unroll
                for (int m = 0; m < 4; ++m) {
                    const f32x4 v0 = acc[ai][bj][m][0] * s0, v1 = acc[ai][bj][m][1] * s1;
                    u32x4 w; w.x = cvt_pk_bf16(v0[0], v0[1]); w.y = cvt_pk_bf16(v0[2], v0[3]); w.z = cvt_pk_bf16(v1[0], v1[1]); w.w = cvt_pk_bf16(v1[2], v1[3]);
                    *(u32x4*)(dst + (size_t)(r0 + ai * HALF + m * 16) * MT + c0 + bj * HALF) = w;
                }
        }
    }
};
struct EpiF32 {
    EPI_HEAD
    float* C; int ldc;
    __device__ __forceinline__ void operator()(EPI_ARGS) const { EPI_RC
#pragma unroll
        for (int ai = 0; ai < 2; ++ai)
#pragma unroll
            for (int m = 0; m < 4; ++m) {
                float* rp = C + (size_t)(brow + ai * HALF + wr * 64 + m * 16 + fr) * ldc + bcol + wc * 32 + 8 * fq;
#pragma unroll
                for (int bj = 0; bj < 2; ++bj) { *(f32x4*)(rp + bj * HALF) = acc[ai][bj][m][0]; *(f32x4*)(rp + bj * HALF + 4) = acc[ai][bj][m][1]; }
            }
    }
};
struct EpiBf16 {
    EPI_HEAD
    bf16_t* C; int ldc;
    __device__ __forceinline__ void operator()(EPI_ARGS) const { EPI_RC
#pragma unroll
        for (int ai = 0; ai < 2; ++ai)
#pragma unroll
            for (int m = 0; m < 4; ++m) {
                bf16_t* rp = C + (size_t)(brow + ai * HALF + wr * 64 + m * 16 + fr) * ldc + bcol + wc * 32 + 8 * fq;
#pragma unroll
                for (int bj = 0; bj < 2; ++bj) {
                    const f32x4 v0 = acc[ai][bj][m][0], v1 = acc[ai][bj][m][1];
                    u32x4 w; w.x = cvt_pk_bf16(v0[0], v0[1]); w.y = cvt_pk_bf16(v0[2], v0[3]); w.z = cvt_pk_bf16(v1[0], v1[1]); w.w = cvt_pk_bf16(v1[2], v1[3]);
                    *(u32x4*)(rp + bj * HALF) = w;
                }
            }
    }
};
struct EpiAct {
    EPI_HEAD_PRE(f32x4)
    const float* rh; bf16_t* act; char* lds;
    __device__ __forceinline__ f32x4 pre_issue(const pg8::Unit& u) const { return threadIdx.x < 256 ? *(const f32x4*)(rh + (size_t)(u.pm * 256 + threadIdx.x) * 4) : (f32x4){0.f, 0.f, 0.f, 0.f}; }
    __device__ __forceinline__ void pre_commit(f32x4 q) const { if (threadIdx.x < 256) ((float*)(lds + 4096))[threadIdx.x] = rsqrtf(((q[0] + q[1]) + (q[2] + q[3])) * (1.0f / DM) + EPS); }
    __device__ __forceinline__ void operator()(EPI_ARGS) const { EPI_RC
        const int c0 = (bcol >> 1) + wc * 32 + 8 * fq;
        float rsv[2][4];
#pragma unroll
        for (int ai = 0; ai < 2; ++ai)
#pragma unroll
            for (int m = 0; m < 4; ++m) rsv[ai][m] = ((const float*)(lds + 4096))[ai * HALF + wr * 64 + m * 16 + fr];
#pragma unroll
        for (int ai = 0; ai < 2; ++ai)
#pragma unroll
            for (int m = 0; m < 4; ++m) {
                const int row = brow + ai * HALF + wr * 64 + m * 16 + fr;
                const float rs = rsv[ai][m];
                float o[8];
#pragma unroll
                for (int n = 0; n < 2; ++n)
#pragma unroll
                    for (int j = 0; j < 4; ++j) { const float g = acc[ai][0][m][n][j] * rs, u = acc[ai][1][m][n][j] * rs; o[n * 4 + j] = siluf_(g) * u; }
                u32x4 w; w.x = cvt_pk_bf16(o[0], o[1]); w.y = cvt_pk_bf16(o[2], o[3]); w.z = cvt_pk_bf16(o[4], o[5]); w.w = cvt_pk_bf16(o[6], o[7]);
                *(u32x4*)(act + (size_t)row * DFF + c0) = w;
            }
    }
};
struct EpiFinal {
    EPI_HEAD
    float* out; const bf16_t* ple; const bf16_t* h2;
    __device__ __forceinline__ void operator()(EPI_ARGS) const { EPI_RC
#pragma unroll
        for (int ai = 0; ai < 2; ++ai)
#pragma unroll
            for (int mp = 0; mp < 1; ++mp) {
                u32x4 pv[4][2], hv[4][2];
#pragma unroll
                for (int mm = 0; mm < 4; ++mm)
#pragma unroll
                    for (int bj = 0; bj < 2; ++bj) {
                        const size_t ro = (size_t)(brow + ai * HALF + wr * 64 + (4 * mp + mm) * 16 + fr) * DM + bcol + wc * 32 + 8 * fq + bj * HALF;
                        pv[mm][bj] = *(const u32x4*)(ple + ro); hv[mm][bj] = *(const u32x4*)(h2 + ro);
                    }
#pragma unroll
                for (int mm = 0; mm < 4; ++mm)
#pragma unroll
                    for (int bj = 0; bj < 2; ++bj) {
                        const int m = 4 * mp + mm;
                        const size_t ro = (size_t)(brow + ai * HALF + wr * 64 + m * 16 + fr) * DM + bcol + wc * 32 + 8 * fq + bj * HALF;
                        const f32x4 a0 = acc[ai][bj][m][0], a1 = acc[ai][bj][m][1]; const u32x4 q = pv[mm][bj], hq = hv[mm][bj]; f32x4 x0, x1;
                        x0[0] = bflo(hq.x) + bflo(q.x) * sigmoidf_(a0[0]); x0[1] = bfhi(hq.x) + bfhi(q.x) * sigmoidf_(a0[1]); x0[2] = bflo(hq.y) + bflo(q.y) * sigmoidf_(a0[2]); x0[3] = bfhi(hq.y) + bfhi(q.y) * sigmoidf_(a0[3]);
                        x1[0] = bflo(hq.z) + bflo(q.z) * sigmoidf_(a1[0]); x1[1] = bfhi(hq.z) + bfhi(q.z) * sigmoidf_(a1[1]); x1[2] = bflo(hq.w) + bflo(q.w) * sigmoidf_(a1[2]); x1[3] = bfhi(hq.w) + bfhi(q.w) * sigmoidf_(a1[3]);
                        *(f32x4*)(out + ro) = x0; *(f32x4*)(out + ro + 4) = x1;
                    }
            }
    }
};

template <int WHICH> struct EpiRes {
    static constexpr bool PERM = true, AFTER_DRAIN = false, MIDSCALE = (WHICH == 1), ROWPRE = false; typedef int Pre; static constexpr int MID_T = 8;
    const float* gain; bf16_t* hb; float* part; unsigned* cnt; float* part2; char* lds; const float* parth;
    __device__ __forceinline__ void load_mid(const pg8::Unit& u) const {
        if (threadIdx.x < 256) { const f32x4 q = *(const f32x4*)(parth + (size_t)(u.pm * 256 + threadIdx.x) * 4); ((float*)(lds + 4096))[threadIdx.x] = rsqrtf(((q[0] + q[1]) + (q[2] + q[3])) * (1.0f / 512) + EPS); }
    }
    __device__ __forceinline__ float mid_scale(int r) const { return ((const float*)(lds + 4096))[r]; }
    __device__ __forceinline__ void operator()(EPI_ARGS) const { EPI_RC
        float* red = (float*)lds; const int tid = threadIdx.x;
#pragma unroll
        for (int ai = 0; ai < 2; ++ai)
#pragma unroll
            for (int m = 0; m < 4; ++m) {
                float s = 0.f;
#pragma unroll
                for (int bj = 0; bj < 2; ++bj)
#pragma unroll
                    for (int n = 0; n < 2; ++n) { const f32x4 v = acc[ai][bj][m][n]; s += (v[0] * v[0] + v[1] * v[1]) + (v[2] * v[2] + v[3] * v[3]); }
                s += __shfl_xor(s, 16); s += __shfl_xor(s, 32);
                if (fq == 0) red[(ai * HALF + wr * 64 + m * 16 + fr) * 4 + wc] = s;
            }
        f32x4 g[2][2]; u32x4 bv[4][2];
#pragma unroll
        for (int bj = 0; bj < 2; ++bj) { g[bj][0] = *(const f32x4*)(gain + bcol + bj * HALF + wc * 32 + 8 * fq); g[bj][1] = *(const f32x4*)(gain + bcol + bj * HALF + wc * 32 + 8 * fq + 4); }
#pragma unroll
        for (int m = 0; m < 4; ++m)
#pragma unroll
            for (int bj = 0; bj < 2; ++bj) bv[m][bj] = *(const u32x4*)(hb + (size_t)(brow + wr * 64 + m * 16 + fr) * DM + bcol + bj * HALF + wc * 32 + 8 * fq);
        __syncthreads();
        if (tid < 256) { const f32x4 v = *(const f32x4*)(red + tid * 4); __hip_atomic_store(part + (size_t)(brow + tid) * 4 + u.pn, (v[0] + v[1]) + (v[2] + v[3]), __ATOMIC_RELAXED, __HIP_MEMORY_SCOPE_AGENT); }
        asm volatile("s_waitcnt vmcnt(0)" ::: "memory");
        __syncthreads();
        if (tid == 0) {
            unsigned* c = cnt + u.pm * 64;
            __hip_atomic_fetch_add(c, 1u, __ATOMIC_RELAXED, __HIP_MEMORY_SCOPE_AGENT);
            unsigned sp = 0;
            while (__hip_atomic_load(c, __ATOMIC_RELAXED, __HIP_MEMORY_SCOPE_AGENT) < 4u && ++sp < (1u << 20)) __builtin_amdgcn_s_sleep(1);
        }
        __syncthreads();
#pragma unroll
        for (int ai = 0; ai < 2; ++ai) {
            float pq[4][4];
#pragma unroll
            for (int m = 0; m < 4; ++m) {
                const float* pp = part + (size_t)(brow + ai * HALF + wr * 64 + m * 16 + fr) * 4;
#pragma unroll
                for (int q = 0; q < 4; ++q) pq[m][q] = __hip_atomic_load(pp + q, __ATOMIC_RELAXED, __HIP_MEMORY_SCOPE_AGENT);
            }
            if (ai == 1) {
#pragma unroll
                for (int m = 0; m < 4; ++m)
#pragma unroll
                    for (int bj = 0; bj < 2; ++bj) bv[m][bj] = *(const u32x4*)(hb + (size_t)(brow + HALF + wr * 64 + m * 16 + fr) * DM + bcol + bj * HALF + wc * 32 + 8 * fq);
            }
#pragma unroll
            for (int m = 0; m < 4; ++m) {
                float s2 = 0.f; const float r = rsqrtf(((pq[m][0] + pq[m][1]) + (pq[m][2] + pq[m][3])) * (1.0f / DM) + EPS);
#pragma unroll
                for (int bj = 0; bj < 2; ++bj) { const size_t ro = (size_t)(brow + ai * HALF + wr * 64 + m * 16 + fr) * DM + bcol + bj * HALF + wc * 32 + 8 * fq;
                    const u32x4 q = bv[m][bj]; const f32x4 b0 = {bflo(q.x), bfhi(q.x), bflo(q.y), bfhi(q.y)}, b1 = {bflo(q.z), bfhi(q.z), bflo(q.w), bfhi(q.w)};
                    f32x4 h0, h1;
#pragma unroll
                    for (int j = 0; j < 4; ++j) { h0[j] = b0[j] + acc[ai][bj][m][0][j] * r * g[bj][0][j]; h1[j] = b1[j] + acc[ai][bj][m][1][j] * r * g[bj][1][j]; s2 += h0[j] * h0[j] + h1[j] * h1[j]; }
                    u32x4 w; w.x = cvt_pk_bf16(h0[0], h0[1]); w.y = cvt_pk_bf16(h0[2], h0[3]); w.z = cvt_pk_bf16(h1[0], h1[1]); w.w = cvt_pk_bf16(h1[2], h1[3]);
                    *(u32x4*)(hb + ro) = w; }
                if (WHICH == 1) { s2 += __shfl_xor(s2, 16); s2 += __shfl_xor(s2, 32); if (fq == 0) red[(ai * HALF + wr * 64 + m * 16 + fr) * 4 + wc] = s2; }
            }
        }
        if (WHICH == 1) {
            __syncthreads();
            if (tid < 256) { const f32x4 v = *(const f32x4*)(red + tid * 4); part2[(size_t)(brow + tid) * 4 + u.pn] = (v[0] + v[1]) + (v[2] + v[3]); }
        }
    }
};

template <class Epi>
__device__ __forceinline__ void run_gemm(const bf16_t* A, const bf16_t* Bt, int M, int N, int K, char* shm, const Epi& epi) {
    asm volatile("" : "+s"(K));
    pg8::Gemm g{A, Bt, M, N, K}; pg8::StaticOrder S; S.init(M, N, (int)gridDim.x, (int)blockIdx.x);
    pg8::gemm_phase<Epi, pg8::StaticOrder, true, true>((PG8_LAS unsigned char*)shm, g, S, epi);
}

__device__ __forceinline__ int src_col(int r, int mode) {
    if (mode == 0) return r;
    if (mode == 2) { const int g = r >> 9; const int sg = g == 0 ? 0 : g == 1 ? 1 : g == 2 ? 3 : g == 3 ? 4 : g == 4 ? 5 : g == 5 ? 2 : 6; return sg * 512 + (r & 511); }
    const int tile = r >> 8, w = r & 255, bj = w >> 7, j = w & 127;
    return bj * DFF + tile * 128 + j;
}
__device__ void conv_weight(const float* __restrict__ W, int K, int ldw, bf16_t* __restrict__ Wt, int Nrows, int mode, const float* __restrict__ gain, float* lds, int vb, int nvb) {
    const int nk = K / 64, nr = Nrows / 256, tid = threadIdx.x;
    for (int it = vb; it < nk * nr; it += nvb) {
        const int k0 = (it % nk) * 64, r0 = (it / nk) * 256;
        f32x4 v[8];
        const int sc = src_col(r0 + (tid & 63) * 4, mode);
#pragma unroll
        for (int i = 0; i < 8; ++i) v[i] = *(const f32x4*)(W + (size_t)(k0 + (tid >> 6) + 8 * i) * ldw + sc);
        __syncthreads();
#pragma unroll
        for (int i = 0; i < 8; ++i) *(f32x4*)(lds + ((tid >> 6) + 8 * i) * 260 + (tid & 63) * 4) = v[i];
        __syncthreads();
#pragma unroll
        for (int j = 0; j < 4; ++j) {
            const int e = tid + 512 * j, r = e & 255, kg = e >> 8;
            float f[8];
#pragma unroll
            for (int i = 0; i < 8; ++i) { f[i] = lds[(8 * kg + i) * 260 + r]; if (gain) f[i] *= gain[k0 + 8 * kg + i]; }
            u32x4 w; w.x = cvt_pk_bf16(f[0], f[1]); w.y = cvt_pk_bf16(f[2], f[3]); w.z = cvt_pk_bf16(f[4], f[5]); w.w = cvt_pk_bf16(f[6], f[7]);
            *(u32x4*)(Wt + (size_t)(r0 + r) * K + k0 + 8 * kg) = w;
        }
    }
}
__device__ void phase0_rest(const Params& p, char* shm) {
    float* lds = (float*)shm; char* ws = p.ws;
    const int vb = blockIdx.x, nvb = gridDim.x;
    conv_weight(p.w_out, DM, DM, (bf16_t*)(ws + OFF_WOUT), DM, 0, nullptr, lds, vb, nvb);
    conv_weight(p.w_gu, DM, 2 * DFF, (bf16_t*)(ws + OFF_WGU), 2 * DFF, 1, p.g_ffn_pre, lds, vb, nvb);
    conv_weight(p.w_down, DFF, DM, (bf16_t*)(ws + OFF_WDN), DM, 0, nullptr, lds, vb, nvb);
    conv_weight(p.w_pp, PLE, DM, (bf16_t*)(ws + OFF_WPP), DM, 0, nullptr, lds, vb, nvb);
    conv_weight(p.w_pg, DM, DM, (bf16_t*)(ws + OFF_WPG), DM, 0, nullptr, lds, vb, nvb);
    __syncthreads();
    bf16_t* pb = (bf16_t*)(ws + OFF_PB);
    for (size_t i0 = (size_t)blockIdx.x * 512 + threadIdx.x; i0 < (size_t)MT * PLE / 4; i0 += (size_t)gridDim.x * 512 * 4) {
        f32x4 v[4];
#pragma unroll
        for (int j = 0; j < 4; ++j) { const size_t i = i0 + (size_t)j * gridDim.x * 512; if (i < (size_t)MT * PLE / 4) v[j] = __builtin_nontemporal_load((const f32x4*)(p.p + i * 4)); }
#pragma unroll
        for (int j = 0; j < 4; ++j) { const size_t i = i0 + (size_t)j * gridDim.x * 512; if (i < (size_t)MT * PLE / 4) { u32x2 w; w.x = cvt_pk_bf16(v[j][0], v[j][1]); w.y = cvt_pk_bf16(v[j][2], v[j][3]); *(u32x2*)(pb + i * 4) = w; } }
    }
    __syncthreads();
}
__device__ void phase0(const Params& p, char* shm) {
    float* lds = (float*)shm; char* ws = p.ws;
    const int vb = blockIdx.x, nvb = gridDim.x;
    conv_weight(p.w_in, DM, NIN, (bf16_t*)(ws + OFF_WIN), NIN, 2, p.g_attn_pre, lds, vb, nvb);
    if (blockIdx.x == 0) { float* lb = (float*)(ws + OFF_LB); const int c = threadIdx.x; const float l = sigmoidf_(p.gamma[c] - p.gamma[512 + c]); lb[c] = l; lb[512 + c] = 1.0f - l; }
    const int wid = threadIdx.x >> 6, lane = threadIdx.x & 63;
    bf16_t* xb = (bf16_t*)(ws + OFF_XB); float* rx = (float*)(ws + OFF_RX);
    for (int row0 = (blockIdx.x * 8 + wid) * 4; row0 < MT; row0 += gridDim.x * 32) {
        f32x4 v[4][4];
#pragma unroll
        for (int r = 0; r < 4; ++r)
#pragma unroll
            for (int i = 0; i < 4; ++i) v[r][i] = __builtin_nontemporal_load((const f32x4*)(p.x + (size_t)(row0 + r) * DM + i * 256 + lane * 4));
#pragma unroll
        for (int r = 0; r < 4; ++r) {
            float ss = 0.f;
#pragma unroll
            for (int i = 0; i < 4; ++i) { const f32x4 t = v[r][i]; ss += t[0] * t[0] + t[1] * t[1] + t[2] * t[2] + t[3] * t[3];
                u32x2 w; w.x = cvt_pk_bf16(t[0], t[1]); w.y = cvt_pk_bf16(t[2], t[3]); *(u32x2*)(xb + (size_t)(row0 + r) * DM + i * 256 + lane * 4) = w; }
            ss = wave_sum(ss);
            if (lane == 0) rx[row0 + r] = rsqrtf(ss * (1.0f / DM) + EPS);
        }
    }
}

template <int WHICH>
__device__ void phase_res(const Params& p) {
    char* ws = p.ws; const int wid = threadIdx.x >> 6, lane = threadIdx.x & 63;
    const float* src = (const float*)(ws + (WHICH == 1 ? OFF_QT : OFF_Y)); const float* base = WHICH == 1 ? p.x : p.out; const float* gn = WHICH == 1 ? p.g_attn_post : p.g_ffn_post;
    bf16_t* hb = (bf16_t*)(ws + (WHICH == 1 ? OFF_XB : OFF_H2B)); float* rh = (float*)(ws + OFF_RH1);
    f32x4 g[4];
#pragma unroll
    for (int i = 0; i < 4; ++i) g[i] = *(const f32x4*)(gn + i * 256 + lane * 4);
    for (int row0 = (blockIdx.x * 8 + wid) * 2; row0 < MT; row0 += gridDim.x * 16) {
        f32x4 mv[2][4], xv[2][4];
#pragma unroll
        for (int r = 0; r < 2; ++r)
#pragma unroll
            for (int i = 0; i < 4; ++i) { mv[r][i] = __builtin_nontemporal_load((const f32x4*)(src + (size_t)(row0 + r) * DM + i * 256 + lane * 4)); xv[r][i] = __builtin_nontemporal_load((const f32x4*)(base + (size_t)(row0 + r) * DM + i * 256 + lane * 4)); }
#pragma unroll
        for (int r = 0; r < 2; ++r) {
            float ss = 0.f;
#pragma unroll
            for (int i = 0; i < 4; ++i) ss += mv[r][i][0] * mv[r][i][0] + mv[r][i][1] * mv[r][i][1] + mv[r][i][2] * mv[r][i][2] + mv[r][i][3] * mv[r][i][3];
            ss = wave_sum(ss); const float rr = rsqrtf(ss * (1.0f / DM) + EPS); float s2 = 0.f;
#pragma unroll
            for (int i = 0; i < 4; ++i) { const int c = i * 256 + lane * 4; f32x4 h;
#pragma unroll
                for (int j = 0; j < 4; ++j) { h[j] = xv[r][i][j] + mv[r][i][j] * rr * g[i][j]; s2 += h[j] * h[j]; }
                *(f32x4*)(p.out + (size_t)(row0 + r) * DM + c) = h; u32x2 w; w.x = cvt_pk_bf16(h[0], h[1]); w.y = cvt_pk_bf16(h[2], h[3]); *(u32x2*)(hb + (size_t)(row0 + r) * DM + c) = w; }
            if (WHICH == 1) { s2 = wave_sum(s2); if (lane == 0) rh[row0 + r] = rsqrtf(s2 * (1.0f / DM) + EPS); }
        }
    }
}

#define MFMA32(a, b, c) __builtin_amdgcn_mfma_f32_32x32x16_bf16((a), (b), (c), 0, 0, 0)
#define MFMA16(a, b, c) __builtin_amdgcn_mfma_f32_16x16x32_bf16((a), (b), (c), 0, 0, 0)
__device__ __forceinline__ bf16x8 mk8(u32x2 a, u32x2 b) { u32x4 t; t.x = a.x; t.y = a.y; t.z = b.x; t.w = b.y; return __builtin_bit_cast(bf16x8, t); }
__device__ void phase_attn(const Params& p, char* shm, unsigned* queue) {
    char* ws = p.ws; const int tid = opaque_tid(), h = tid >> 6, lane = tid & 63, n = lane & 31, hh = lane >> 5;
    const bf16_t* SQ = (const bf16_t*)(ws + OFF_SQ); const bf16_t* SK = (const bf16_t*)(ws + OFF_SQ + SZ_HALF); const bf16_t* SVT = (const bf16_t*)(ws + OFF_SVT);
    bf16_t* am = (bf16_t*)(ws + OFF_AMIX); float* red = (float*)shm;
    int* itp = (int*)(shm + 2048);
    unsigned nxt_it = 0;
    if (threadIdx.x == 0) nxt_it = __hip_atomic_fetch_add(queue, 1u, __ATOMIC_RELAXED, __HIP_MEMORY_SCOPE_AGENT);
    for (;;) {
        __syncthreads();
        if (threadIdx.x == 0) { *itp = (int)nxt_it; if (nxt_it < NB * 128) nxt_it = __hip_atomic_fetch_add(queue, 1u, __ATOMIC_RELAXED, __HIP_MEMORY_SCOPE_AGENT); }
        __syncthreads();
        const int it0 = *itp; if (it0 >= NB * 128) break;
        const int it = NB * 128 - 1 - it0;
        const int b = it >> 7, qb = it & 127, t0 = qb * 32;
        const size_t tokq = (size_t)b * NT + t0 + n;
        bf16x8 qf[4];
#pragma unroll
        for (int ks = 0; ks < 4; ++ks) qf[ks] = *(const bf16x8*)(SQ + tokq * 512 + h * 64 + 16 * ks + 8 * hh);
        f32x16 o0, o1;
#pragma unroll
        for (int r = 0; r < 16; ++r) { o0[r] = 0.f; o1[r] = 0.f; }
        float R = 1.0f;
        bf16x8 kf[4]; u32x2 vf[2][2][2];
        const bf16_t* vbase = SVT + (size_t)(h * 64 + n) * MT + (size_t)b * NT + 4 * hh;
        {
            const size_t tk = (size_t)b * NT + t0 + n;
#pragma unroll
            for (int ks = 0; ks < 4; ++ks) kf[ks] = *(const bf16x8*)(SK + tk * 512 + h * 64 + 16 * ks + 8 * hh);
#pragma unroll
            for (int db = 0; db < 2; ++db)
#pragma unroll
                for (int s = 0; s < 2; ++s)
#pragma unroll
                    for (int hf = 0; hf < 2; ++hf) vf[db][s][hf] = *(const u32x2*)(vbase + (size_t)db * 32 * MT + t0 + 16 * s + 8 * hf);
        }
        for (int kb = qb; kb >= 0; --kb) {
            const int s1 = (kb > 0 ? kb - 1 : 0) * 32;
            bf16x8 kn[4]; u32x2 vn[2][2][2];
            {
                const size_t tk = (size_t)b * NT + s1 + n;
#pragma unroll
                for (int ks = 0; ks < 4; ++ks) kn[ks] = *(const bf16x8*)(SK + tk * 512 + h * 64 + 16 * ks + 8 * hh);
#pragma unroll
                for (int db = 0; db < 2; ++db)
#pragma unroll
                    for (int s = 0; s < 2; ++s)
#pragma unroll
                        for (int hf = 0; hf < 2; ++hf) vn[db][s][hf] = *(const u32x2*)(vbase + (size_t)db * 32 * MT + s1 + 16 * s + 8 * hf);
            }
            f32x16 st;
#pragma unroll
            for (int r = 0; r < 16; ++r) st[r] = 0.f;
#pragma unroll
            for (int ks = 0; ks < 4; ++ks) st = MFMA32(kf[ks], qf[ks], st);
            float mm[16], be[16];
#pragma unroll
            for (int r = 0; r < 16; ++r) { const float e = fexp2(st[r]); mm[r] = frcp(1.0f + e); be[r] = 1.0f - mm[r]; }
            if (kb == qb) {
#pragma unroll
                for (int r = 0; r < 16; ++r) { const bool act = ((r & 3) + 8 * (r >> 2) + 4 * hh) < n; mm[r] = act ? mm[r] : 1.0f; be[r] = act ? be[r] : 0.0f; }
            }
            float go[4], gp[4], T[4];
#pragma unroll
            for (int g = 0; g < 4; ++g) { go[g] = (mm[4 * g] * mm[4 * g + 1]) * (mm[4 * g + 2] * mm[4 * g + 3]); gp[g] = __shfl_xor(go[g], 32); }
            T[3] = 1.0f; T[2] = go[3] * gp[3]; T[1] = T[2] * (go[2] * gp[2]); T[0] = T[1] * (go[1] * gp[1]);
            const float tot = T[0] * (go[0] * gp[0]);
            float aa[16];
#pragma unroll
            for (int g = 0; g < 4; ++g) {
                float x = R * T[g] * (hh == 0 ? gp[g] : 1.0f);
                aa[4 * g + 3] = be[4 * g + 3] * x; x *= mm[4 * g + 3];
                aa[4 * g + 2] = be[4 * g + 2] * x; x *= mm[4 * g + 2];
                aa[4 * g + 1] = be[4 * g + 1] * x; x *= mm[4 * g + 1];
                aa[4 * g + 0] = be[4 * g + 0] * x;
            }
            u32x4 p0, p1;
            p0.x = cvt_pk_bf16(aa[0], aa[1]); p0.y = cvt_pk_bf16(aa[2], aa[3]); p0.z = cvt_pk_bf16(aa[4], aa[5]); p0.w = cvt_pk_bf16(aa[6], aa[7]);
            p1.x = cvt_pk_bf16(aa[8], aa[9]); p1.y = cvt_pk_bf16(aa[10], aa[11]); p1.z = cvt_pk_bf16(aa[12], aa[13]); p1.w = cvt_pk_bf16(aa[14], aa[15]);
            const bf16x8 pf0 = __builtin_bit_cast(bf16x8, p0), pf1 = __builtin_bit_cast(bf16x8, p1);
            o0 = MFMA32(mk8(vf[0][0][0], vf[0][0][1]), pf0, o0); o0 = MFMA32(mk8(vf[0][1][0], vf[0][1][1]), pf1, o0);
            o1 = MFMA32(mk8(vf[1][0][0], vf[1][0][1]), pf0, o1); o1 = MFMA32(mk8(vf[1][1][0], vf[1][1][1]), pf1, o1);
            R *= tot;
            if (__ballot(R > 0.0f) == 0ull) break;
#pragma unroll
            for (int ks = 0; ks < 4; ++ks) kf[ks] = kn[ks];
#pragma unroll
            for (int db = 0; db < 2; ++db)
#pragma unroll
                for (int s = 0; s < 2; ++s) { vf[db][s][0] = vn[db][s][0]; vf[db][s][1] = vn[db][s][1]; }
        }
        float ss = 0.f;
#pragma unroll
        for (int r = 0; r < 16; ++r) ss += o0[r] * o0[r] + o1[r] * o1[r];
        ss += __shfl_xor(ss, 32);
        __syncthreads();
        if (hh == 0) red[h * 32 + n] = ss;
        __syncthreads();
        float tsum = 0.f;
#pragma unroll
        for (int w = 0; w < 8; ++w) tsum += red[w * 32 + n];
        const float rr = rsqrtf(tsum * (1.0f / 512) + EPS);
        f32x4 gwv[2][4];
#pragma unroll
        for (int db = 0; db < 2; ++db)
#pragma unroll
            for (int g = 0; g < 4; ++g) gwv[db][g] = *(const f32x4*)(p.g_sb + h * 64 + 32 * db + 8 * g + 4 * hh);
#pragma unroll
        for (int db = 0; db < 2; ++db)
#pragma unroll
            for (int g = 0; g < 4; ++g) {
                const int d0 = 32 * db + 8 * g + 4 * hh; const f32x4 gw = gwv[db][g];
                float v[4];
#pragma unroll
                for (int j = 0; j < 4; ++j) v[j] = (db == 0 ? o0[4 * g + j] : o1[4 * g + j]) * rr * gw[j];
                u32x2 w; w.x = cvt_pk_bf16(v[0], v[1]); w.y = cvt_pk_bf16(v[2], v[3]);
                *(u32x2*)(am + tokq * DM + 512 + h * 64 + d0) = w;
            }
    }
}

#define LDS_BAR() do { asm volatile("s_waitcnt lgkmcnt(0)" ::: "memory"); __builtin_amdgcn_s_barrier(); asm volatile("" ::: "memory"); } while (0)
constexpr int HSEG = 8, HCH = 64 / HSEG;
template <bool FULL>
__device__ void phase_hgseg(const Params& p, char* shm, int bh, int seg) {
    char* ws = p.ws; const int tid = opaque_tid(), w = tid >> 6, lane = tid & 63, fr = lane & 15, fq = lane >> 4, kp = tid & 63, r8 = tid >> 6;
    const int b = bh >> 2, h = bh & 3;
    const float* LF = (const float*)(ws + OFF_BC); const bf16_t* KK = (const bf16_t*)(ws + OFF_QT + SZ_HALF); const bf16_t* QT = (const bf16_t*)(ws + OFF_QT);
    const bf16_t* G = (const bf16_t*)(ws + OFF_QT + 3 * SZ_HALF); const bf16_t* VHT = (const bf16_t*)(ws + OFF_VHT);
    bf16_t* am = (bf16_t*)(ws + OFF_AMIX); float* parth = (float*)(ws + OFF_DC); float* SLOC = (float*)(ws + OFF_SLOC); float* DSEG = (float*)(ws + OFF_SLOC + 32 * MiB);
    float* qs = (float*)shm; float* dvec = (float*)(shm + 4096); float* red = (float*)(shm + 4608);
    char* sQs = shm + 8192; char* sQd = sQs + 17408; char* sKd = sQd + 17408; char* sP = sKd + 17408; char* keT = sP + 9216;
    f32x4 S[8];
#pragma unroll
    for (int kb = 0; kb < 8; ++kb) S[kb] = (f32x4){0.f, 0.f, 0.f, 0.f};
    f32x2 lfn[8]; unsigned qn[8], kn[8]; bf16x8 vn[2]; u32x2 gn[4];
#define HG_LOAD(cc) do { const size_t _t0 = (size_t)b * NT + 64 * (cc); \
        _Pragma("unroll") for (int i = 0; i < 8; ++i) { const size_t a_ = (_t0 + 8 * r8 + i) * 512 + h * 128 + 2 * kp; lfn[i] = *(const f32x2*)(LF + a_); kn[i] = *(const unsigned*)(KK + a_); if (FULL) qn[i] = *(const unsigned*)(QT + a_); } \
        _Pragma("unroll") for (int ks = 0; ks < 2; ++ks) vn[ks] = *(const bf16x8*)(VHT + (size_t)(h * 128 + 16 * w + fr) * MT + _t0 + 32 * ks + 8 * fq); \
        if (FULL) { _Pragma("unroll") for (int tb = 0; tb < 4; ++tb) gn[tb] = *(const u32x2*)(G + (_t0 + 16 * tb + fr) * 512 + h * 128 + 16 * w + 4 * fq); } } while (0)
    const int c0 = seg * HCH;
    HG_LOAD(c0);
    if (FULL) {
        for (int s = 0; s < seg; ++s) {
            const float* sl = SLOC + ((size_t)(bh * HSEG + s) * 128 + 16 * w + fr) * 128 + 4 * fq; const float* ds = DSEG + (size_t)(bh * HSEG + s) * 128 + 4 * fq;
            f32x4 lv[8], dv[8];
#pragma unroll
            for (int kb = 0; kb < 8; ++kb) { lv[kb] = *(const f32x4*)(sl + 16 * kb); dv[kb] = *(const f32x4*)(ds + 16 * kb); }
#pragma unroll
            for (int kb = 0; kb < 8; ++kb) S[kb] = S[kb] * dv[kb] + lv[kb];
        }
    }
    f32x4 gw = {0.f, 0.f, 0.f, 0.f};
    if (FULL) gw = *(const f32x4*)(p.g_hg + h * 128 + 16 * w + 4 * fq);
    float dsum0 = 0.f, dsum1 = 0.f;
    for (int ci = 0; ci < HCH; ++ci) {
        const int c = c0 + ci; const size_t tok0 = (size_t)b * NT + 64 * c;
        f32x2 lfv[8]; unsigned qv[8], kkv[8]; bf16x8 vfr[2]; u32x2 gv[4];
#pragma unroll
        for (int i = 0; i < 8; ++i) { lfv[i] = lfn[i]; kkv[i] = kn[i]; if (FULL) qv[i] = qn[i]; }
        vfr[0] = vn[0]; vfr[1] = vn[1];
        if (FULL) {
#pragma unroll
            for (int tb = 0; tb < 4; ++tb) gv[tb] = gn[tb];
        }
        { const int cn = ci < HCH - 1 ? c + 1 : c; HG_LOAD(cn); }
        f32x2 run = {0.f, 0.f};
#pragma unroll
        for (int i = 0; i < 8; ++i) { run += lfv[i]; lfv[i] = run; }
        *(f32x2*)(qs + r8 * 128 + 2 * kp) = run;
        LDS_BAR();
        if (FULL && ci > 0 && tid < 64) { float s = 0.f;
#pragma unroll
            for (int ww = 0; ww < 8; ++ww) s += red[ww * 64 + tid];
            parth[(tok0 - 64 + tid) * 4 + h] = s; }
        f32x2 off = {0.f, 0.f}, bmid = {0.f, 0.f}, blast = {0.f, 0.f};
#pragma unroll
        for (int j = 0; j < 8; ++j) { const f32x2 q = *(const f32x2*)(qs + j * 128 + 2 * kp); if (j < r8) off += q; if (j < 4) bmid += q; blast += q; }
        if (r8 == 0) { f32x2 d; d.x = fexp2(blast.x); d.y = fexp2(blast.y); *(f32x2*)(dvec + 2 * kp) = d; dsum0 += blast.x; dsum1 += blast.y; }
        f32x2 emid, elast;
        emid.x = fexp2(bmid.x); emid.y = fexp2(bmid.y); elast.x = fexp2(blast.x - bmid.x); elast.y = fexp2(blast.y - bmid.y);
        float ke0[8], ke1[8];
#pragma unroll
        for (int i = 0; i < 8; ++i) {
            const int t = 8 * r8 + i; const f32x2 bb = off + lfv[i];
            const float k0 = bflo(kkv[i]), k1 = bfhi(kkv[i]);
            const float f0 = fexp2(bmid.x - bb.x), f1 = fexp2(bmid.y - bb.y);
            const float kd0 = k0 * f0, kd1 = k1 * f1;
            ke0[i] = kd0 * elast.x; ke1[i] = kd1 * elast.y;
            if (FULL) {
                const float e0 = fexp2(bb.x - bmid.x), e1 = fexp2(bb.y - bmid.y);
                const float qd0 = bflo(qv[i]) * e0, qd1 = bfhi(qv[i]) * e1;
                *(unsigned*)(sQd + t * 272 + kp * 4) = cvt_pk_bf16(qd0, qd1);
                *(unsigned*)(sQs + t * 272 + kp * 4) = cvt_pk_bf16(qd0 * emid.x, qd1 * emid.y);
                *(unsigned*)(sKd + t * 272 + kp * 4) = cvt_pk_bf16(kd0, kd1);
            }
        }
        { u32x4 a0, a1;
          a0.x = cvt_pk_bf16(ke0[0], ke0[1]); a0.y = cvt_pk_bf16(ke0[2], ke0[3]); a0.z = cvt_pk_bf16(ke0[4], ke0[5]); a0.w = cvt_pk_bf16(ke0[6], ke0[7]);
          a1.x = cvt_pk_bf16(ke1[0], ke1[1]); a1.y = cvt_pk_bf16(ke1[2], ke1[3]); a1.z = cvt_pk_bf16(ke1[4], ke1[5]); a1.w = cvt_pk_bf16(ke1[6], ke1[7]);
          *(u32x4*)(keT + (2 * kp) * 144 + r8 * 16) = a0; *(u32x4*)(keT + (2 * kp + 1) * 144 + r8 * 16) = a1; }
        LDS_BAR();
        if (FULL) {
            {
                const int tb = w >> 1;
                bf16x8 qf[4], kf[2][4];
#pragma unroll
                for (int ks = 0; ks < 4; ++ks) { qf[ks] = *(const bf16x8*)(sQd + (16 * tb + fr) * 272 + 64 * ks + 16 * fq);
#pragma unroll
                    for (int u = 0; u < 2; ++u) kf[u][ks] = *(const bf16x8*)(sKd + (16 * (2 * (w & 1) + u) + fr) * 272 + 64 * ks + 16 * fq); }
                __builtin_amdgcn_sched_barrier(0);
#pragma unroll
                for (int u = 0; u < 2; ++u) {
                    const int sb = 2 * (w & 1) + u;
                    f32x4 acc = {0.f, 0.f, 0.f, 0.f};
                    if (sb <= tb) {
#pragma unroll
                        for (int ks = 0; ks < 4; ++ks) acc = MFMA16(kf[u][ks], qf[ks], acc);
                    }
                    const int t = 16 * tb + fr, s0 = 16 * sb + 4 * fq;
#pragma unroll
                    for (int j = 0; j < 4; ++j) acc[j] = (s0 + j <= t) ? acc[j] : 0.f;
                    u32x2 o; o.x = cvt_pk_bf16(acc[0], acc[1]); o.y = cvt_pk_bf16(acc[2], acc[3]);
                    *(u32x2*)(sP + t * 144 + s0 * 2) = o;
                }
            }
            LDS_BAR();
            bf16x8 sb16[4];
#pragma unroll
            for (int ks = 0; ks < 4; ++ks) { u32x4 t4; t4.x = cvt_pk_bf16(S[2 * ks][0], S[2 * ks][1]); t4.y = cvt_pk_bf16(S[2 * ks][2], S[2 * ks][3]); t4.z = cvt_pk_bf16(S[2 * ks + 1][0], S[2 * ks + 1][1]); t4.w = cvt_pk_bf16(S[2 * ks + 1][2], S[2 * ks + 1][3]); sb16[ks] = __builtin_bit_cast(bf16x8, t4); }
            bf16x8 qsf[4][4], pf[4][2];
#pragma unroll
            for (int tb = 0; tb < 4; ++tb) {
#pragma unroll
                for (int ks = 0; ks < 4; ++ks) { const u32x2 lo = *(const u32x2*)(sQs + (16 * tb + fr) * 272 + (32 * ks + 4 * fq) * 2), hi = *(const u32x2*)(sQs + (16 * tb + fr) * 272 + (32 * ks + 16 + 4 * fq) * 2); qsf[tb][ks] = mk8(lo, hi); }
#pragma unroll
                for (int ks = 0; ks < 2; ++ks) pf[tb][ks] = *(const bf16x8*)(sP + (16 * tb + fr) * 144 + 64 * ks + 16 * fq);
            }
            __builtin_amdgcn_sched_barrier(0);
#pragma unroll
            for (int tb = 0; tb < 4; ++tb) {
                f32x4 acc = {0.f, 0.f, 0.f, 0.f};
#pragma unroll
                for (int ks = 0; ks < 4; ++ks) acc = MFMA16(sb16[ks], qsf[tb][ks], acc);
#pragma unroll
                for (int ks = 0; ks < 2; ++ks) acc = MFMA16(vfr[ks], pf[tb][ks], acc);
                float s = (acc[0] * acc[0] + acc[1] * acc[1]) + (acc[2] * acc[2] + acc[3] * acc[3]);
                s += __shfl_xor(s, 16); s += __shfl_xor(s, 32);
                if (fq == 0) red[w * 64 + 16 * tb + fr] = s;
                const u32x2 g2 = gv[tb];
                u32x2 o; o.x = cvt_pk_bf16(acc[0] * gw[0] * bflo(g2.x), acc[1] * gw[1] * bfhi(g2.x)); o.y = cvt_pk_bf16(acc[2] * gw[2] * bflo(g2.y), acc[3] * gw[3] * bfhi(g2.y));
                *(u32x2*)(am + (tok0 + 16 * tb + fr) * DM + h * 128 + 16 * w + 4 * fq) = o;
            }
        }
#pragma unroll
        for (int kg = 0; kg < 2; ++kg) {
            f32x4 dd[4]; bf16x8 kf[4][2];
#pragma unroll
            for (int q = 0; q < 4; ++q) { const int kb = 4 * kg + q; dd[q] = *(const f32x4*)(dvec + 16 * kb + 4 * fq);
#pragma unroll
                for (int ks = 0; ks < 2; ++ks) kf[q][ks] = *(const bf16x8*)(keT + (16 * kb + fr) * 144 + 64 * ks + 16 * fq); }
            __builtin_amdgcn_sched_barrier(0);
#pragma unroll
            for (int q = 0; q < 4; ++q) { const int kb = 4 * kg + q;
                f32x4 acc = S[kb] * dd[q];
#pragma unroll
                for (int ks = 0; ks < 2; ++ks) acc = MFMA16(kf[q][ks], vfr[ks], acc);
                S[kb] = acc; }
        }
    }
    if (FULL) {
        __syncthreads();
        if (tid < 64) { float s = 0.f;
#pragma unroll
            for (int ww = 0; ww < 8; ++ww) s += red[ww * 64 + tid];
            parth[((size_t)b * NT + 64 * (c0 + HCH - 1) + tid) * 4 + h] = s; }
    } else {
#pragma unroll
        for (int kb = 0; kb < 8; ++kb) *(f32x4*)(SLOC + ((size_t)(bh * HSEG + seg) * 128 + 16 * w + fr) * 128 + 16 * kb + 4 * fq) = S[kb];
        if (r8 == 0) { f32x2 d; d.x = fexp2(dsum0); d.y = fexp2(dsum1); *(f32x2*)(DSEG + (size_t)(bh * HSEG + seg) * 128 + 2 * kp) = d; }
    }
    __syncthreads();
#undef HG_LOAD
}

#define XB_TMO      128
#define XB_XCNT(j)  (256  + 64 * (j))
#define XB_XSUB(j)  (1280 + 64 * (j))
#define XB_XGEN(j)  (2304 + 64 * (j))
#define XB_TOP      3328
#define XB_TOPGEN   3392
#define XCD_BAR_WORDS 3456
#define XB_SPIN_CAP (1u << 18)
#define LAS __attribute__((address_space(3)))

__device__ __forceinline__ unsigned xb_ld(unsigned* p)              { return __hip_atomic_load(p, __ATOMIC_RELAXED, __HIP_MEMORY_SCOPE_AGENT); }
__device__ __forceinline__ unsigned xb_add(unsigned* p, unsigned v) { return __hip_atomic_fetch_add(p, v, __ATOMIC_RELAXED, __HIP_MEMORY_SCOPE_AGENT); }
__device__ __forceinline__ unsigned xb_xcc_id() { return (unsigned)__builtin_amdgcn_s_getreg((3 << 11) | 20) & 0xFu; }
#define XB_SPIN(cond, bar) do { unsigned _sp = 0; while (cond) { __builtin_amdgcn_s_sleep(1); \
    if ((++_sp & 255u) == 0u) { if (xb_ld(&(bar)[XB_TMO])) break; if (_sp > XB_SPIN_CAP) { atomicAdd(&(bar)[XB_TMO], 1u); break; } } } } while (0)

struct XcdBarrier {
    unsigned* bar; unsigned x;
    volatile LAS unsigned* st;
};

__device__ __forceinline__ XcdBarrier xcd_barrier_post(unsigned* bar, volatile LAS unsigned* st) {
    XcdBarrier b; b.bar = bar; b.x = xb_xcc_id(); b.st = st;
    if (threadIdx.x == 0) (void)xb_add(&bar[XB_XCNT(b.x)], 1u);
    return b;
}
__device__ __forceinline__ void xcd_barrier_complete(unsigned* bar, unsigned x, unsigned& nloc, unsigned& nx) {
    const unsigned G = gridDim.x * gridDim.y * gridDim.z;
    unsigned sum, cnt, mine, sp = 0u;
    for (;;) {
        sum = 0u; cnt = 0u; mine = 0u;
#pragma unroll
        for (unsigned j = 0; j < 16; ++j) { const unsigned c = xb_ld(&bar[XB_XCNT(j)]); sum += c; cnt += (c > 0u) ? 1u : 0u; mine = (j == x) ? c : mine; }
        if (sum == G) break;
        __builtin_amdgcn_s_sleep(1);
        if ((++sp & 255u) == 0u) { if (xb_ld(&bar[XB_TMO])) break; if (sp > XB_SPIN_CAP) { atomicAdd(&bar[XB_TMO], 1u); break; } }
    }
    nloc = mine > 0u ? mine : 1u; nx = cnt > 0u ? cnt : 1u;
}

__device__ __forceinline__ void xcd_barrier(const XcdBarrier& b) {
    asm volatile("s_waitcnt vmcnt(0)" ::: "memory");
    __syncthreads();
    if (threadIdx.x == 0) {
        unsigned* bar = b.bar;
        __builtin_amdgcn_s_waitcnt(0);
        unsigned nloc = b.st[0], nx = b.st[1];
        if (nloc == 0u) { xcd_barrier_complete(bar, b.x, nloc, nx); b.st[0] = nloc; b.st[1] = nx; }
        const unsigned old = xb_add(&bar[XB_XSUB(b.x)], 1u);
        const unsigned gen = old / nloc;
        if (old + 1u == (gen + 1u) * nloc) {
            __builtin_amdgcn_fence(__ATOMIC_RELEASE, "agent");
            asm volatile("s_waitcnt vmcnt(0)" ::: "memory");
            const unsigned og = xb_add(&bar[XB_TOP], 1u);
            const unsigned tg = og / nx;
            if (og + 1u == (tg + 1u) * nx) xb_add(&bar[XB_TOPGEN], 1u);
            else XB_SPIN(xb_ld(&bar[XB_TOPGEN]) == tg, bar);
            __builtin_amdgcn_fence(__ATOMIC_ACQUIRE, "agent");
            xb_add(&bar[XB_XGEN(b.x)], 1u);
            asm volatile("s_waitcnt vmcnt(0)" ::: "memory");
        } else {
            XB_SPIN(xb_ld(&bar[XB_XGEN(b.x)]) == gen, bar);
            __builtin_amdgcn_fence(__ATOMIC_ACQUIRE, "agent");
            asm volatile("s_waitcnt vmcnt(0)" ::: "memory");
        }
    }
    __syncthreads();
}


template <int PH> __device__ __forceinline__ void do_phase(const Params& p, char* shm) {
    char* ws = p.ws; char* epl = shm + SHM_B + 16;
    if (PH == 0) phase0(p, shm);
    if (PH == 1) {
        if (blockIdx.x & 1) phase0_rest(p, shm);
        run_gemm((const bf16_t*)(ws + OFF_XB), (const bf16_t*)(ws + OFF_WIN), MT, 2560, DM, shm, EpiIn{(const float*)(ws + OFF_RX), ws, epl});
        run_gemm((const bf16_t*)(ws + OFF_WIN) + (size_t)2560 * DM, (const bf16_t*)(ws + OFF_XB), 1024, MT, DM, shm, EpiVT{(const float*)(ws + OFF_RX), ws, epl});
        if (!(blockIdx.x & 1)) phase0_rest(p, shm);
    }
    if (PH == 2) { for (int u = blockIdx.x; u < 32 * HSEG; u += gridDim.x) if ((u & (HSEG - 1)) != HSEG - 1) phase_hgseg<false>(p, shm, u / HSEG, u & (HSEG - 1));
                   phase_attn(p, shm, (unsigned*)(ws + OFF_CNT) + 2 * 128 * 64); }
    if (PH == 3) { for (int u = blockIdx.x; u < 32 * HSEG; u += gridDim.x) phase_hgseg<true>(p, shm, u / HSEG, u & (HSEG - 1)); }
    if (PH == 5) run_gemm((const bf16_t*)(ws + OFF_AMIX), (const bf16_t*)(ws + OFF_WOUT), MT, DM, DM, shm,
                          EpiRes<1>{p.g_attn_post, (bf16_t*)(ws + OFF_XB), (float*)(ws + OFF_PART1), (unsigned*)(ws + OFF_CNT), (float*)(ws + OFF_PART2), epl, (const float*)(ws + OFF_DC)});
    if (PH == 7) {
        const bool ple_first = ((blockIdx.x >> 3) & 1) != 0;
        if (ple_first) run_gemm((const bf16_t*)(ws + OFF_PB), (const bf16_t*)(ws + OFF_WPP), MT, DM, PLE, shm, EpiBf16{(bf16_t*)(ws + OFF_PLE), DM});
        run_gemm((const bf16_t*)(ws + OFF_XB), (const bf16_t*)(ws + OFF_WGU), MT, 2 * DFF, DM, shm, EpiAct{(const float*)(ws + OFF_PART2), (bf16_t*)(ws + OFF_ACT), epl});
        if (!ple_first) run_gemm((const bf16_t*)(ws + OFF_PB), (const bf16_t*)(ws + OFF_WPP), MT, DM, PLE, shm, EpiBf16{(bf16_t*)(ws + OFF_PLE), DM});
    }
    if (PH == 8) run_gemm((const bf16_t*)(ws + OFF_ACT), (const bf16_t*)(ws + OFF_WDN), MT, DM, DFF, shm,
                          EpiRes<2>{p.g_ffn_post, (bf16_t*)(ws + OFF_XB), (float*)(ws + OFF_PART3), (unsigned*)(ws + OFF_CNT) + 128 * 64, nullptr, epl, nullptr});
    if (PH == 10) run_gemm((const bf16_t*)(ws + OFF_XB), (const bf16_t*)(ws + OFF_WPG), MT, DM, DM, shm, EpiFinal{p.out, (const bf16_t*)(ws + OFF_PLE), (const bf16_t*)(ws + OFF_XB)});
}
#if MEGA
__global__ __launch_bounds__(512) void k_mega(Params p) {
    extern __shared__ __attribute__((aligned(16))) char shm[];
    cg::grid_group grid = cg::this_grid();
    volatile LAS unsigned* st = (volatile LAS unsigned*)(shm + SHM_B);
    if (threadIdx.x < 2) st[threadIdx.x] = 0u;
    __syncthreads();
    const XcdBarrier xb = xcd_barrier_post((unsigned*)(p.ws + OFF_BAR), st);
    if (p.ws == nullptr) grid.sync();
    do_phase<0>(p, shm); xcd_barrier(xb);
    do_phase<1>(p, shm); xcd_barrier(xb);
    do_phase<2>(p, shm); xcd_barrier(xb);
    do_phase<3>(p, shm); xcd_barrier(xb);
    do_phase<5>(p, shm); xcd_barrier(xb);
    do_phase<7>(p, shm); xcd_barrier(xb);
    do_phase<8>(p, shm); xcd_barrier(xb);
    do_phase<10>(p, shm);
}
#else
template <int PH> __global__ __launch_bounds__(512) void k_phase(Params p) {
    extern __shared__ __attribute__((aligned(16))) char shm[];
    do_phase<PH>(p, shm);
}
template <int PH> static void launch_phase(const Params& p, hipStream_t s) {
    static bool attr = false;
    if (!attr) { (void)hipFuncSetAttribute((const void*)k_phase<PH>, hipFuncAttributeMaxDynamicSharedMemorySize, SHM_B); attr = true; }
    hipLaunchKernelGGL(k_phase<PH>, dim3(256), dim3(512), SHM_B, s, p);
}
#endif

extern "C" void kernel_launch(void* const* d_in, const int* in_sizes, int n_in, void* d_out, int out_size, void* d_ws, size_t ws_size, hipStream_t stream) {
    Params p{};
    p.x = (const float*)d_in[0]; p.p = (const float*)d_in[1]; p.g_attn_pre = (const float*)d_in[2]; p.w_in = (const float*)d_in[3]; p.gamma = (const float*)d_in[4];
    p.g_hg = (const float*)d_in[5]; p.g_sb = (const float*)d_in[6]; p.w_out = (const float*)d_in[7]; p.g_attn_post = (const float*)d_in[8]; p.g_ffn_pre = (const float*)d_in[9];
    p.w_gu = (const float*)d_in[10]; p.w_down = (const float*)d_in[11]; p.g_ffn_post = (const float*)d_in[12]; p.w_pp = (const float*)d_in[13]; p.w_pg = (const float*)d_in[14];
    p.out = (float*)d_out; p.ws = (char*)d_ws;
#if MEGA
    static int grid_blocks = 0;
    if (!grid_blocks) {
        int dev = 0, cus = 0, per_cu = 0;
        (void)hipGetDevice(&dev); (void)hipDeviceGetAttribute(&cus, hipDeviceAttributeMultiprocessorCount, dev);
        (void)hipFuncSetAttribute((const void*)k_mega, hipFuncAttributeMaxDynamicSharedMemorySize, LDS_TOTAL);
        (void)hipOccupancyMaxActiveBlocksPerMultiprocessor(&per_cu, (const void*)k_mega, 512, LDS_TOTAL);
        if (per_cu < 1) per_cu = 1;
        grid_blocks = cus * per_cu;
    }
    (void)hipMemsetAsync((char*)d_ws + OFF_BAR, 0, CTL_BYTES, stream);
    void* args[] = {&p};
    hipError_t e = hipLaunchCooperativeKernel((const void*)k_mega, dim3(grid_blocks), dim3(512), args, LDS_TOTAL, stream);
    if (e != hipSuccess) fprintf(stderr, "cooperative launch failed: %s (grid %d)\n", hipGetErrorString(e), grid_blocks);
#else
    launch_phase<0>(p, stream); launch_phase<1>(p, stream); launch_phase<2>(p, stream); launch_phase<3>(p, stream); launch_phase<5>(p, stream);
    launch_phase<7>(p, stream); launch_phase<8>(p, stream); launch_phase<10>(p, stream);
#endif
}
```

```cpp
#include <hip/hip_runtime.h>
#include <hip/hip_cooperative_groups.h>
#include <cstdio>
#include <cstdint>
namespace cg = cooperative_groups;

#ifndef MEGA
#define MEGA 1
#endif

typedef unsigned short bf16_t;
typedef short bf16x8 __attribute__((ext_vector_type(8)));
typedef float f32x4 __attribute__((ext_vector_type(4)));
typedef unsigned u32x4 __attribute__((ext_vector_type(4)));
typedef unsigned u32x2 __attribute__((ext_vector_type(2)));

constexpr int NB = 8, NT = 4096, DM = 1024, MT = NB * NT;
constexpr int NIN = 3584, DFF = 2816, PLE = 256;
constexpr float EPS = 1e-6f;
constexpr float LOG2E = 1.4426950408889634f;

constexpr size_t MiB = 1ull << 20;
constexpr size_t OFF_WIN = 0;
constexpr size_t OFF_WOUT = 7 * MiB;
constexpr size_t OFF_WGU = 9 * MiB;
constexpr size_t OFF_WDN = 20 * MiB;
constexpr size_t OFF_WPP = 26 * MiB;
constexpr size_t OFF_WPG = 27 * MiB;
constexpr size_t OFF_RX = 30 * MiB;
constexpr size_t OFF_RH1 = 31 * MiB;
constexpr size_t OFF_LB = 32 * MiB;
constexpr size_t OFF_PB = 40 * MiB;
constexpr size_t OFF_XB = 56 * MiB;
constexpr size_t OFF_SQ = 120 * MiB;
constexpr size_t OFF_Y = 56 * MiB;
constexpr size_t OFF_QT = 216 * MiB;
constexpr size_t OFF_BC = 344 * MiB;
constexpr size_t OFF_ACT = 216 * MiB;
constexpr size_t OFF_H2B = 216 * MiB;
constexpr size_t OFF_PLE = 408 * MiB;
constexpr size_t OFF_SLOC = 472 * MiB;
constexpr size_t OFF_AMIX = 408 * MiB;
constexpr size_t OFF_PART1 = 35 * MiB;
constexpr size_t OFF_PART2 = 36 * MiB;
constexpr size_t OFF_PART3 = 37 * MiB;
constexpr size_t OFF_CNT = 34 * MiB + 16384;
constexpr size_t CTL_BYTES = 16384 + 2 * 128 * 64 * 4 + 256;
constexpr size_t OFF_BAR = 34 * MiB;
constexpr size_t OFF_DC = 33 * MiB;
constexpr size_t OFF_U = 56 * MiB;
constexpr size_t OFF_SC = 120 * MiB;
constexpr size_t OFF_VHT = 216 * MiB + 2 * (32 * MiB);
constexpr size_t OFF_SVT = 120 * MiB + 2 * (32 * MiB);
constexpr size_t SZ_HALF = 32 * MiB;

struct Params {
    const float *x, *p, *g_attn_pre, *w_in, *gamma, *g_hg, *g_sb, *w_out, *g_attn_post, *g_ffn_pre, *w_gu, *w_down, *g_ffn_post, *w_pp, *w_pg;
    float* out; char* ws;
};

typedef __bf16 bf2_t __attribute__((ext_vector_type(2)));
typedef float f32x2 __attribute__((ext_vector_type(2)));
typedef float f32x16 __attribute__((ext_vector_type(16)));
__device__ __forceinline__ unsigned cvt_pk_bf16(float lo, float hi) { f32x2 v = {lo, hi}; return __builtin_bit_cast(unsigned, __builtin_convertvector(v, bf2_t)); }
__device__ __forceinline__ size_t vt_off(int ch, size_t tok) { return ((tok >> 6) * 512 + (size_t)ch) * 64 + (tok & 63); }
__device__ __forceinline__ float bf2f(bf16_t h) { return __uint_as_float(((unsigned)h) << 16); }
__device__ __forceinline__ float bflo(unsigned u) { return __uint_as_float(u << 16); }
__device__ __forceinline__ float bfhi(unsigned u) { return __uint_as_float(u & 0xffff0000u); }
__device__ __forceinline__ float fexp2(float x) { return __builtin_amdgcn_exp2f(x); }
__device__ __forceinline__ float frcp(float x) { return __builtin_amdgcn_rcpf(x); }
__device__ __forceinline__ float sigmoidf_(float x) { return frcp(1.0f + fexp2(-x * LOG2E)); }
__device__ __forceinline__ float siluf_(float x) { return x * sigmoidf_(x); }
__device__ __forceinline__ float wave_sum(float v) {
#pragma unroll
    for (int o = 32; o >= 1; o >>= 1) v += __shfl_xor(v, o);
    return v;
}

__device__ __forceinline__ int opaque_tid() { int t = threadIdx.x; asm volatile("" : "+v"(t)); return t; }

namespace pg8 {
#define PG8_LAS __attribute__((address_space(3)))
typedef unsigned short bf16_t;
typedef short bf16x8 __attribute__((ext_vector_type(8)));
typedef float f32x4 __attribute__((ext_vector_type(4)));
typedef unsigned u32x4 __attribute__((ext_vector_type(4)));
constexpr int BM = 256, BK = 64, HALF = 128, HTB = HALF * BK * 2  , STAGE_BYTES = 8 * HTB, NXCD = 8, WGM = 8;

__host__ __device__ __forceinline__ int lds_byte(int r, int c) { const int st = (r >> 4) * 2 + (c >> 5), rr = r & 15, cc = c & 31, ob = rr * 64 + cc * 2; return st * 1024 + (ob ^ (((ob >> 9) & 1) << 5)); }
__host__ __device__ __forceinline__ void stage_rc(int b, int& R, int& C) { const int st = b / 1024, sb = b % 1024, swz = sb ^ (((sb >> 9) & 1) << 5); R = (st >> 1) * 16 + swz / 64; C = (st & 1) * 32 + (swz % 64) / 2; }
__host__ __device__ __forceinline__ int perm32(int rho) { const int n = rho >> 4, i = rho & 15; return 8 * (i >> 2) + 4 * n + (i & 3); }

struct Unit { int pm, pn; };
struct Gemm { const bf16_t* A; const bf16_t* Bt; int M, N, K; };

struct StaticOrder {
    int nM, nN, nwg, G, c;
    __host__ __device__ void init(int M, int N, int G_, int c_) { nM = M / BM; nN = N / BM; nwg = nM * nN; G = G_; c = c_; }
    __host__ __device__ bool next(int i, Unit& u) const {
        const long L = (long)i * G + c; if (L >= nwg) return false;
        int wgid = (int)L; { const int q = nwg / NXCD, r = nwg % NXCD, xcd = wgid % NXCD, off = wgid / NXCD; wgid = (xcd < r ? xcd * (q + 1) : r * (q + 1) + (xcd - r) * q) + off; }
        const int nig = WGM * nN, gid = wgid / nig, fm = gid * WGM, gsz = (nM - fm) < WGM ? (nM - fm) : WGM;
        u.pm = fm + ((wgid % nig) % gsz); u.pn = (wgid % nig) / gsz; return true;
    }
    __device__ __forceinline__ void a_ready(const Unit&) const {}
    __device__ __forceinline__ void done(const Unit&) const {}
};
template <class Epi, class Sched, bool ALIGN_EPI = false, bool SP2 = false>
__device__ __forceinline__ void gemm_phase(PG8_LAS unsigned char* lds, const Gemm g, const Sched& S, const Epi& E) {
    const int tid = opaque_tid(), wid = __builtin_amdgcn_readfirstlane(tid >> 6), lane = tid & 63, wr = wid >> 2, wc = wid & 3, fr = lane & 15, fq = lane >> 4;
    const int K = g.K, nt = K / BK;
    unsigned voffA[2], voffB[2];
#pragma unroll
    for (int i = 0; i < 2; ++i) { int R, C; stage_rc(tid * 16 + i * 8192, R, C); const int Rb = Epi::PERM ? ((R & ~31) + perm32(R & 31)) : R;
        voffA[i] = (unsigned)(R * K + C) * 2u; voffB[i] = (unsigned)(Rb * K + C) * 2u; }
    const size_t kstep = (size_t)(BK * 2);
    const size_t hstep = (size_t)HALF * K * 2;
    const size_t tstep = 2 * hstep;
    const unsigned ldsw = (unsigned)wid * 1024u;
    const int aoff = lds_byte(wr * 64 + fr, fq * 8), boff = lds_byte(wc * 32 + fr, fq * 8);
#define PG8_SA(b, h) (((b) * 2 + (h)) * HTB)
#define PG8_SB(b, h) ((4 + (b) * 2 + (h)) * HTB)
#define PG8_STAGE(bufoff, gbase, voff) do { _Pragma("unroll") for (int _i = 0; _i < 2; ++_i) \
        __builtin_amdgcn_global_load_lds((const unsigned*)((const char*)(gbase) + (voff)[_i]), (PG8_LAS unsigned*)(lds + (bufoff) + ldsw + _i * 8192), 16, 0, 0); } while (0)
#define PG8_LDA(dst, b, h) do { _Pragma("unroll") for (int m = 0; m < 4; ++m) _Pragma("unroll") for (int k = 0; k < 2; ++k) dst[m][k] = *(const PG8_LAS bf16x8*)(lds + PG8_SA(b, h) + aoff + m * 2048 + k * 1024); } while (0)
#define PG8_LDB(dst, b, h) do { _Pragma("unroll") for (int n = 0; n < 2; ++n) _Pragma("unroll") for (int k = 0; k < 2; ++k) dst[n][k] = *(const PG8_LAS bf16x8*)(lds + PG8_SB(b, h) + boff + n * 2048 + k * 1024); } while (0)
#define PG8_MMA(ai, bj, At, Bt) do { __builtin_amdgcn_s_setprio(1); _Pragma("unroll") for (int m = 0; m < 4; ++m) _Pragma("unroll") for (int n = 0; n < 2; ++n) _Pragma("unroll") for (int k = 0; k < 2; ++k) \
        acc[ai][bj][m][n] = __builtin_amdgcn_mfma_f32_16x16x32_bf16(Bt[n][k], At[m][k], acc[ai][bj][m][n], 0, 0, 0); __builtin_amdgcn_s_setprio(0); } while (0)
#define PG8_WAIT_V(n) asm volatile("s_waitcnt vmcnt(" #n ")" ::: "memory")
#define PG8_WAIT_L(n) asm volatile("s_waitcnt lgkmcnt(" #n ")" ::: "memory")
#define PG8_BAR __builtin_amdgcn_s_barrier()
#define PG8_SCHED __builtin_amdgcn_sched_barrier(0)
    Unit cur, nxt; int ui = 0;
    if (!S.next(0, cur)) return;
    f32x4 acc[2][2][4][2];
#pragma unroll
    for (int a = 0; a < 2; ++a)
#pragma unroll
        for (int b = 0; b < 2; ++b)
#pragma unroll
            for (int m = 0; m < 4; ++m)
#pragma unroll
                for (int n = 0; n < 2; ++n) acc[a][b][m][n] = (f32x4){0.f, 0.f, 0.f, 0.f};
    bf16x8 At[4][2], B0[2][2], B1[2][2];
    const char* cA = (const char*)g.A + (size_t)cur.pm * tstep; const char* cB = (const char*)g.Bt + (size_t)cur.pn * tstep;
    S.a_ready(cur);
    if constexpr (Epi::MIDSCALE) E.load_mid(cur);
    typename Epi::Pre pre = {};
    if constexpr (Epi::ROWPRE) pre = E.pre_issue(cur);
    if constexpr (SP2) {
        PG8_STAGE(PG8_SB(0, 0), cB, voffB); PG8_STAGE(PG8_SB(0, 1), cB + hstep, voffB); PG8_STAGE(PG8_SA(0, 0), cA, voffA); PG8_STAGE(PG8_SA(0, 1), cA + hstep, voffA);
        if (wr == 1) PG8_BAR;
        PG8_WAIT_V(2); PG8_BAR;
        PG8_STAGE(PG8_SB(1, 0), cB + kstep, voffB); PG8_STAGE(PG8_SA(1, 0), cA + kstep, voffA); PG8_STAGE(PG8_SB(1, 1), cB + hstep + kstep, voffB);
        PG8_WAIT_V(6); PG8_BAR;
    } else {
        PG8_STAGE(PG8_SB(0, 0), cB, voffB); PG8_STAGE(PG8_SA(0, 0), cA, voffA); PG8_STAGE(PG8_SB(0, 1), cB + hstep, voffB); PG8_STAGE(PG8_SA(0, 1), cA + hstep, voffA);
        if (wr == 1) PG8_BAR;
        PG8_WAIT_V(4); PG8_BAR;
        PG8_STAGE(PG8_SB(1, 0), cB + kstep, voffB); PG8_STAGE(PG8_SA(1, 0), cA + kstep, voffA); PG8_STAGE(PG8_SB(1, 1), cB + hstep + kstep, voffB);
        PG8_WAIT_V(6); PG8_BAR;
    }
    for (;;) {
        const bool has_next = S.next(ui + 1, nxt);
        const char* nA = has_next ? (const char*)g.A + (size_t)nxt.pm * tstep : cA; const char* nB = has_next ? (const char*)g.Bt + (size_t)nxt.pn * tstep : cB;
        for (int t = 0; t < nt; t += 2) {
            const bool last = (t == nt - 2);
            const char* a1 = cA + (size_t)(t + 1) * kstep;
            const char* a2 = last ? nA : cA + (size_t)(t + 2) * kstep; const char* b2 = last ? nB : cB + (size_t)(t + 2) * kstep;
            const char* a3 = a2 + kstep; const char* b3 = b2 + kstep;
            if (last && has_next) S.a_ready(nxt);
            if constexpr (Epi::ROWPRE) { if (t == 8) E.pre_commit(pre); }
            if constexpr (Epi::MIDSCALE) { if (t == Epi::MID_T) {
_Pragma("unroll") for (int a = 0; a < 2; ++a) _Pragma("unroll") for (int m = 0; m < 4; ++m) { const float sc_ = E.mid_scale(a * HALF + wr * 64 + m * 16 + fr);
_Pragma("unroll") for (int b = 0; b < 2; ++b) _Pragma("unroll") for (int n = 0; n < 2; ++n) acc[a][b][m][n] = acc[a][b][m][n] * sc_; } } }
            if constexpr (SP2) {
            PG8_LDB(B0, 0, 0); PG8_LDB(B1, 0, 1); PG8_SCHED; PG8_LDA(At, 0, 0); PG8_STAGE(PG8_SA(1, 1), a1 + hstep, voffA);
            PG8_WAIT_V(8); PG8_WAIT_L(0); PG8_BAR; PG8_MMA(0, 0, At, B0); PG8_MMA(0, 1, At, B1); PG8_BAR; PG8_SCHED;
            PG8_LDA(At, 0, 1); PG8_STAGE(PG8_SB(0, 0), b2, voffB); PG8_STAGE(PG8_SB(0, 1), b2 + hstep, voffB); PG8_STAGE(PG8_SA(0, 0), a2, voffA);
            PG8_WAIT_V(8); PG8_WAIT_L(0); PG8_BAR; PG8_MMA(1, 0, At, B0); PG8_MMA(1, 1, At, B1); PG8_BAR; PG8_SCHED;
            PG8_LDB(B0, 1, 0); PG8_LDB(B1, 1, 1); PG8_SCHED; PG8_LDA(At, 1, 0); PG8_STAGE(PG8_SA(0, 1), a2 + hstep, voffA);
            PG8_WAIT_V(8); PG8_WAIT_L(0); PG8_BAR; PG8_MMA(0, 0, At, B0); PG8_MMA(0, 1, At, B1); PG8_BAR; PG8_SCHED;
            PG8_LDA(At, 1, 1); PG8_STAGE(PG8_SB(1, 0), b3, voffB); PG8_STAGE(PG8_SB(1, 1), b3 + hstep, voffB); PG8_STAGE(PG8_SA(1, 0), a3, voffA);
            PG8_WAIT_V(8); PG8_WAIT_L(0); PG8_BAR; PG8_MMA(1, 0, At, B0); PG8_MMA(1, 1, At, B1); PG8_BAR; PG8_SCHED;
            } else {
            PG8_LDB(B0, 0, 0); PG8_SCHED; PG8_LDA(At, 0, 0); PG8_STAGE(PG8_SA(1, 1), a1 + hstep, voffA);
            PG8_WAIT_L(8); PG8_BAR; PG8_WAIT_L(0); PG8_MMA(0, 0, At, B0); PG8_BAR; PG8_SCHED;
            PG8_LDB(B1, 0, 1); PG8_STAGE(PG8_SB(0, 0), b2, voffB);
            PG8_BAR; PG8_WAIT_L(0); PG8_MMA(0, 1, At, B1); PG8_BAR;
            PG8_LDA(At, 0, 1); PG8_STAGE(PG8_SA(0, 0), a2, voffA);
            PG8_BAR; PG8_WAIT_L(0); PG8_MMA(1, 0, At, B0); PG8_BAR; PG8_SCHED;
            PG8_STAGE(PG8_SB(0, 1), b2 + hstep, voffB);
            PG8_WAIT_V(6); PG8_BAR; PG8_MMA(1, 1, At, B1); PG8_BAR;
            PG8_LDB(B0, 1, 0); PG8_SCHED; PG8_LDA(At, 1, 0); PG8_STAGE(PG8_SA(0, 1), a2 + hstep, voffA);
            PG8_WAIT_L(8); PG8_BAR; PG8_WAIT_L(0); PG8_MMA(0, 0, At, B0); PG8_BAR; PG8_SCHED;
            PG8_LDB(B1, 1, 1); PG8_STAGE(PG8_SB(1, 0), b3, voffB);
            PG8_BAR; PG8_WAIT_L(0); PG8_MMA(0, 1, At, B1); PG8_BAR;
            PG8_LDA(At, 1, 1); PG8_STAGE(PG8_SA(1, 0), a3, voffA);
            PG8_BAR; PG8_WAIT_L(0); PG8_MMA(1, 0, At, B0); PG8_BAR; PG8_SCHED;
            PG8_STAGE(PG8_SB(1, 1), b3 + hstep, voffB);
            PG8_WAIT_V(6); PG8_BAR; PG8_MMA(1, 1, At, B1); PG8_BAR;
            }
        }
        if constexpr (ALIGN_EPI) { if (wr == 0) PG8_BAR; }
        if constexpr (!Epi::AFTER_DRAIN) { E(acc, cur, wr, wc, fr, fq); S.done(cur); }
        if (!has_next) break;
#pragma unroll
        for (int a = 0; a < 2; ++a)
#pragma unroll
            for (int b = 0; b < 2; ++b)
#pragma unroll
                for (int m = 0; m < 4; ++m)
#pragma unroll
                    for (int n = 0; n < 2; ++n) acc[a][b][m][n] = (f32x4){0.f, 0.f, 0.f, 0.f};
        cur = nxt; cA = nA; cB = nB; ++ui;
        if constexpr (Epi::MIDSCALE) E.load_mid(cur);
        if constexpr (Epi::ROWPRE) pre = E.pre_issue(cur);
        if constexpr (ALIGN_EPI) { if (wr == 1) PG8_BAR; }
    }
    PG8_WAIT_V(0);
    if constexpr (!ALIGN_EPI) { if (wr == 0) PG8_BAR; }
    PG8_BAR;
    if constexpr (Epi::AFTER_DRAIN) { E.fused(acc, cur, wr, wc, fr, fq, lds, wid, lane); S.done(cur); }
#undef PG8_SA
#undef PG8_SB
#undef PG8_STAGE
#undef PG8_LDA
#undef PG8_LDB
#undef PG8_MMA
#undef PG8_WAIT_V
#undef PG8_WAIT_L
#undef PG8_BAR
#undef PG8_SCHED
}
}

#define EPI_ARGS const f32x4 (&acc)[2][2][4][2], const pg8::Unit& u, int wr, int wc, int fr, int fq
#define EPI_HEAD static constexpr bool PERM = true, AFTER_DRAIN = false, MIDSCALE = false, ROWPRE = false; typedef int Pre;
#define EPI_HEAD_PRE(T) static constexpr bool PERM = true, AFTER_DRAIN = false, MIDSCALE = false, ROWPRE = true; typedef T Pre;
#define EPI_RC const int brow = u.pm * 256, bcol = u.pn * 256;
constexpr int HALF = 128, SHM_B = 131072, LDS_TOTAL = SHM_B + 16 + 4096 + 1024;
struct EpiIn {
    EPI_HEAD_PRE(float)
    const float* rx; char* ws; char* lds;
    __device__ __forceinline__ float pre_issue(const pg8::Unit& u) const { return threadIdx.x < 256 ? rx[u.pm * 256 + threadIdx.x] : 0.f; }
    __device__ __forceinline__ void pre_commit(float v) const { if (threadIdx.x < 256) ((float*)(lds + 4096))[threadIdx.x] = v; }
    __device__ __forceinline__ void operator()(EPI_ARGS) const { EPI_RC
        const int kind = bcol >> 9;
        const int lc0 = (bcol & 256) + wc * 32 + 8 * fq;
        bf16_t* dst = (bf16_t*)(ws + (kind == 0 ? OFF_QT : kind == 1 ? OFF_QT + SZ_HALF : kind == 2 ? OFF_QT + 3 * SZ_HALF : kind == 3 ? OFF_SQ : OFF_SQ + SZ_HALF));
        if (kind == 1) {
            float* dstf = (float*)(ws + OFF_BC); const float* lbp = (const float*)(ws + OFF_LB);
#pragma unroll
            for (int bj = 0; bj < 2; ++bj)
#pragma unroll
                for (int n = 0; n < 2; ++n) {
                    const f32x4 l0 = *(const f32x4*)(lbp + lc0 + bj * HALF + 4 * n), m0 = *(const f32x4*)(lbp + 512 + lc0 + bj * HALF + 4 * n);
                    float rsv[2][4];
#pragma unroll
                    for (int ai = 0; ai < 2; ++ai)
#pragma unroll
                        for (int m = 0; m < 4; ++m) rsv[ai][m] = ((const float*)(lds + 4096))[ai * HALF + wr * 64 + m * 16 + fr];
#pragma unroll
                    for (int ai = 0; ai < 2; ++ai)
#pragma unroll
                        for (int m = 0; m < 4; ++m) {
                            const int row = brow + ai * HALF + wr * 64 + m * 16 + fr; const float rs = rsv[ai][m];
                            const f32x4 z = acc[ai][bj][m][n] * rs; f32x4 lf;
#pragma unroll
                            for (int j = 0; j < 4; ++j) { const float s = sigmoidf_(z[j]); lf[j] = __builtin_amdgcn_logf(l0[j] + m0[j] * s)  ; }
                            const size_t o = (size_t)row * 512 + lc0 + bj * HALF + 4 * n;
                            *(f32x4*)(dstf + o) = lf;
                        }
                }
            return;
        }
        float rsv[2][4];
#pragma unroll
        for (int ai = 0; ai < 2; ++ai)
#pragma unroll
            for (int m = 0; m < 4; ++m) rsv[ai][m] = ((const float*)(lds + 4096))[ai * HALF + wr * 64 + m * 16 + fr] * (kind == 3 ? 0.125f * LOG2E : 1.0f);
#pragma unroll
        for (int ai = 0; ai < 2; ++ai)
#pragma unroll
            for (int m = 0; m < 4; ++m) {
                const int row = brow + ai * HALF + wr * 64 + m * 16 + fr;
                const float rs = rsv[ai][m];
#pragma unroll
                for (int bj = 0; bj < 2; ++bj) {
                    f32x4 v0 = acc[ai][bj][m][0] * rs, v1 = acc[ai][bj][m][1] * rs;
                    if (kind == 0 || kind == 2) {
#pragma unroll
                        for (int j = 0; j < 4; ++j) { v0[j] = siluf_(v0[j]); v1[j] = siluf_(v1[j]); }
                    }
                    u32x4 w; w.x = cvt_pk_bf16(v0[0], v0[1]); w.y = cvt_pk_bf16(v0[2], v0[3]); w.z = cvt_pk_bf16(v1[0], v1[1]); w.w = cvt_pk_bf16(v1[2], v1[3]);
                    *(u32x4*)(dst + (size_t)row * 512 + lc0 + bj * HALF) = w;
                }
            }
    }
};
struct EpiVT {
    EPI_HEAD_PRE(float)
    const float* rx; char* ws; char* lds;
    __device__ __forceinline__ float pre_issue(const pg8::Unit& u) const { return threadIdx.x < 256 ? rx[u.pn * 256 + threadIdx.x] : 0.f; }
    __device__ __forceinline__ void pre_commit(float v) const { if (threadIdx.x < 256) ((float*)(lds + 4096))[threadIdx.x] = v; }
    __device__ __forceinline__ void operator()(EPI_ARGS) const { EPI_RC
        bf16_t* dst = (bf16_t*)(ws + (brow < 512 ? OFF_VHT : OFF_SVT));
        const int r0 = (brow & 511) + wr * 64 + fr, c0 = bcol + wc * 32 + 8 * fq;
#pragma unroll
        for (int bj = 0; bj < 2; ++bj) {
            const f32x4 s0 = *(const f32x4*)((const float*)(lds + 4096) + wc * 32 + 8 * fq + bj * HALF), s1 = *(const f32x4*)((const float*)(lds + 4096) + wc * 32 + 8 * fq + bj * HALF + 4);
#pragma unroll
            for (int ai = 0; ai < 2; ++ai)
#pragma unroll
                for (int m = 0; m < 4; ++m) {
                    const f32x4 v0 = acc[ai][bj][m][0] * s0, v1 = acc[ai][bj][m][1] * s1;
                    u32x4 w; w.x = cvt_pk_bf16(v0[0], v0[1]); w.y = cvt_pk_bf16(v0[2], v0[3]); w.z = cvt_pk_bf16(v1[0], v1[1]); w.w = cvt_pk_bf16(v1[2], v1[3]);
                    *(u32x4*)(dst + vt_off(r0 + ai * HALF + m * 16, (size_t)(c0 + bj * HALF))) = w;
                }
        }
    }
};
struct EpiF32 {
    EPI_HEAD
    float* C; int ldc;
    __device__ __forceinline__ void operator()(EPI_ARGS) const { EPI_RC
#pragma unroll
        for (int ai = 0; ai < 2; ++ai)
#pragma unroll
            for (int m = 0; m < 4; ++m) {
                float* rp = C + (size_t)(brow + ai * HALF + wr * 64 + m * 16 + fr) * ldc + bcol + wc * 32 + 8 * fq;
#pragma unroll
                for (int bj = 0; bj < 2; ++bj) { *(f32x4*)(rp + bj * HALF) = acc[ai][bj][m][0]; *(f32x4*)(rp + bj * HALF + 4) = acc[ai][bj][m][1]; }
            }
    }
};
struct EpiBf16 {
    EPI_HEAD
    bf16_t* C; int ldc;
    __device__ __forceinline__ void operator()(EPI_ARGS) const { EPI_RC
#pragma unroll
        for (int ai = 0; ai < 2; ++ai)
#pragma unroll
            for (int m = 0; m < 4; ++m) {
                bf16_t* rp = C + (size_t)(brow + ai * HALF + wr * 64 + m * 16 + fr) * ldc + bcol + wc * 32 + 8 * fq;
#pragma unroll
                for (int bj = 0; bj < 2; ++bj) {
                    const f32x4 v0 = acc[ai][bj][m][0], v1 = acc[ai][bj][m][1];
                    u32x4 w; w.x = cvt_pk_bf16(v0[0], v0[1]); w.y = cvt_pk_bf16(v0[2], v0[3]); w.z = cvt_pk_bf16(v1[0], v1[1]); w.w = cvt_pk_bf16(v1[2], v1[3]);
                    *(u32x4*)(rp + bj * HALF) = w;
                }
            }
    }
};
struct EpiAct {
    EPI_HEAD_PRE(f32x4)
    const float* rh; bf16_t* act; char* lds;
    __device__ __forceinline__ f32x4 pre_issue(const pg8::Unit& u) const { return threadIdx.x < 256 ? *(const f32x4*)(rh + (size_t)(u.pm * 256 + threadIdx.x) * 4) : (f32x4){0.f, 0.f, 0.f, 0.f}; }
    __device__ __forceinline__ void pre_commit(f32x4 q) const { if (threadIdx.x < 256) ((float*)(lds + 4096))[threadIdx.x] = rsqrtf(((q[0] + q[1]) + (q[2] + q[3])) * (1.0f / DM) + EPS); }
    __device__ __forceinline__ void operator()(EPI_ARGS) const { EPI_RC
        const int c0 = (bcol >> 1) + wc * 32 + 8 * fq;
        float rsv[2][4];
#pragma unroll
        for (int ai = 0; ai < 2; ++ai)
#pragma unroll
            for (int m = 0; m < 4; ++m) rsv[ai][m] = ((const float*)(lds + 4096))[ai * HALF + wr * 64 + m * 16 + fr];
#pragma unroll
        for (int ai = 0; ai < 2; ++ai)
#pragma unroll
            for (int m = 0; m < 4; ++m) {
                const int row = brow + ai * HALF + wr * 64 + m * 16 + fr;
                const float rs = rsv[ai][m];
                float o[8];
#pragma unroll
                for (int n = 0; n < 2; ++n)
#pragma unroll
                    for (int j = 0; j < 4; ++j) { const float g = acc[ai][0][m][n][j] * rs, u = acc[ai][1][m][n][j] * rs; o[n * 4 + j] = siluf_(g) * u; }
                u32x4 w; w.x = cvt_pk_bf16(o[0], o[1]); w.y = cvt_pk_bf16(o[2], o[3]); w.z = cvt_pk_bf16(o[4], o[5]); w.w = cvt_pk_bf16(o[6], o[7]);
                *(u32x4*)(act + (size_t)row * DFF + c0) = w;
            }
    }
};
struct EpiFinal {
    EPI_HEAD
    float* out; const bf16_t* ple; const bf16_t* h2;
    __device__ __forceinline__ void operator()(EPI_ARGS) const { EPI_RC
#pragma unroll
        for (int ai = 0; ai < 2; ++ai)
#pragma unroll
            for (int mp = 0; mp < 1; ++mp) {
                u32x4 pv[4][2], hv[4][2];
#pragma unroll
                for (int mm = 0; mm < 4; ++mm)
#pragma unroll
                    for (int bj = 0; bj < 2; ++bj) {
                        const size_t ro = (size_t)(brow + ai * HALF + wr * 64 + (4 * mp + mm) * 16 + fr) * DM + bcol + wc * 32 + 8 * fq + bj * HALF;
                        pv[mm][bj] = *(const u32x4*)(ple + ro); hv[mm][bj] = *(const u32x4*)(h2 + ro);
                    }
#pragma unroll
                for (int mm = 0; mm < 4; ++mm)
#pragma unroll
                    for (int bj = 0; bj < 2; ++bj) {
                        const int m = 4 * mp + mm;
                        const size_t ro = (size_t)(brow + ai * HALF + wr * 64 + m * 16 + fr) * DM + bcol + wc * 32 + 8 * fq + bj * HALF;
                        const f32x4 a0 = acc[ai][bj][m][0], a1 = acc[ai][bj][m][1]; const u32x4 q = pv[mm][bj], hq = hv[mm][bj]; f32x4 x0, x1;
                        x0[0] = bflo(hq.x) + bflo(q.x) * sigmoidf_(a0[0]); x0[1] = bfhi(hq.x) + bfhi(q.x) * sigmoidf_(a0[1]); x0[2] = bflo(hq.y) + bflo(q.y) * sigmoidf_(a0[2]); x0[3] = bfhi(hq.y) + bfhi(q.y) * sigmoidf_(a0[3]);
                        x1[0] = bflo(hq.z) + bflo(q.z) * sigmoidf_(a1[0]); x1[1] = bfhi(hq.z) + bfhi(q.z) * sigmoidf_(a1[1]); x1[2] = bflo(hq.w) + bflo(q.w) * sigmoidf_(a1[2]); x1[3] = bfhi(hq.w) + bfhi(q.w) * sigmoidf_(a1[3]);
                        *(f32x4*)(out + ro) = x0; *(f32x4*)(out + ro + 4) = x1;
                    }
            }
    }
};

template <int WHICH> struct EpiRes {
    static constexpr bool PERM = true, AFTER_DRAIN = false, MIDSCALE = (WHICH == 1), ROWPRE = false; typedef int Pre; static constexpr int MID_T = 8;
    const float* gain; bf16_t* hb; float* part; unsigned* cnt; float* part2; char* lds; const float* parth;
    __device__ __forceinline__ void load_mid(const pg8::Unit& u) const {
        if (threadIdx.x < 256) { const f32x4 q = *(const f32x4*)(parth + (size_t)(u.pm * 256 + threadIdx.x) * 4); ((float*)(lds + 4096))[threadIdx.x] = rsqrtf(((q[0] + q[1]) + (q[2] + q[3])) * (1.0f / 512) + EPS); }
    }
    __device__ __forceinline__ float mid_scale(int r) const { return ((const float*)(lds + 4096))[r]; }
    __device__ __forceinline__ void operator()(EPI_ARGS) const { EPI_RC
        float* red = (float*)lds; const int tid = threadIdx.x;
#pragma unroll
        for (int ai = 0; ai < 2; ++ai)
#pragma unroll
            for (int m = 0; m < 4; ++m) {
                float s = 0.f;
#pragma unroll
                for (int bj = 0; bj < 2; ++bj)
#pragma unroll
                    for (int n = 0; n < 2; ++n) { const f32x4 v = acc[ai][bj][m][n]; s += (v[0] * v[0] + v[1] * v[1]) + (v[2] * v[2] + v[3] * v[3]); }
                s += __shfl_xor(s, 16); s += __shfl_xor(s, 32);
                if (fq == 0) red[(ai * HALF + wr * 64 + m * 16 + fr) * 4 + wc] = s;
            }
        f32x4 g[2][2]; u32x4 bv[4][2];
#pragma unroll
        for (int bj = 0; bj < 2; ++bj) { g[bj][0] = *(const f32x4*)(gain + bcol + bj * HALF + wc * 32 + 8 * fq); g[bj][1] = *(const f32x4*)(gain + bcol + bj * HALF + wc * 32 + 8 * fq + 4); }
#pragma unroll
        for (int m = 0; m < 4; ++m)
#pragma unroll
            for (int bj = 0; bj < 2; ++bj) bv[m][bj] = *(const u32x4*)(hb + (size_t)(brow + wr * 64 + m * 16 + fr) * DM + bcol + bj * HALF + wc * 32 + 8 * fq);
        __syncthreads();
        if (tid < 256) { const f32x4 v = *(const f32x4*)(red + tid * 4); __hip_atomic_store(part + (size_t)(brow + tid) * 4 + u.pn, (v[0] + v[1]) + (v[2] + v[3]), __ATOMIC_RELAXED, __HIP_MEMORY_SCOPE_AGENT); }
        asm volatile("s_waitcnt vmcnt(0)" ::: "memory");
        __syncthreads();
        if (tid == 0) {
            unsigned* c = cnt + u.pm * 64;
            __hip_atomic_fetch_add(c, 1u, __ATOMIC_RELAXED, __HIP_MEMORY_SCOPE_AGENT);
            unsigned sp = 0;
            while (__hip_atomic_load(c, __ATOMIC_RELAXED, __HIP_MEMORY_SCOPE_AGENT) < 4u && ++sp < (1u << 20)) __builtin_amdgcn_s_sleep(1);
        }
        __syncthreads();
#pragma unroll
        for (int ai = 0; ai < 2; ++ai) {
            float pq[4][4];
#pragma unroll
            for (int m = 0; m < 4; ++m) {
                const float* pp = part + (size_t)(brow + ai * HALF + wr * 64 + m * 16 + fr) * 4;
#pragma unroll
                for (int q = 0; q < 4; ++q) pq[m][q] = __hip_atomic_load(pp + q, __ATOMIC_RELAXED, __HIP_MEMORY_SCOPE_AGENT);
            }
            if (ai == 1) {
#pragma unroll
                for (int m = 0; m < 4; ++m)
#pragma unroll
                    for (int bj = 0; bj < 2; ++bj) bv[m][bj] = *(const u32x4*)(hb + (size_t)(brow + HALF + wr * 64 + m * 16 + fr) * DM + bcol + bj * HALF + wc * 32 + 8 * fq);
            }
#pragma unroll
            for (int m = 0; m < 4; ++m) {
                float s2 = 0.f; const float r = rsqrtf(((pq[m][0] + pq[m][1]) + (pq[m][2] + pq[m][3])) * (1.0f / DM) + EPS);
#pragma unroll
                for (int bj = 0; bj < 2; ++bj) { const size_t ro = (size_t)(brow + ai * HALF + wr * 64 + m * 16 + fr) * DM + bcol + bj * HALF + wc * 32 + 8 * fq;
                    const u32x4 q = bv[m][bj]; const f32x4 b0 = {bflo(q.x), bfhi(q.x), bflo(q.y), bfhi(q.y)}, b1 = {bflo(q.z), bfhi(q.z), bflo(q.w), bfhi(q.w)};
                    f32x4 h0, h1;
#pragma unroll
                    for (int j = 0; j < 4; ++j) { h0[j] = b0[j] + acc[ai][bj][m][0][j] * r * g[bj][0][j]; h1[j] = b1[j] + acc[ai][bj][m][1][j] * r * g[bj][1][j]; s2 += h0[j] * h0[j] + h1[j] * h1[j]; }
                    u32x4 w; w.x = cvt_pk_bf16(h0[0], h0[1]); w.y = cvt_pk_bf16(h0[2], h0[3]); w.z = cvt_pk_bf16(h1[0], h1[1]); w.w = cvt_pk_bf16(h1[2], h1[3]);
                    *(u32x4*)(hb + ro) = w; }
                if (WHICH == 1) { s2 += __shfl_xor(s2, 16); s2 += __shfl_xor(s2, 32); if (fq == 0) red[(ai * HALF + wr * 64 + m * 16 + fr) * 4 + wc] = s2; }
            }
        }
        if (WHICH == 1) {
            __syncthreads();
            if (tid < 256) { const f32x4 v = *(const f32x4*)(red + tid * 4); part2[(size_t)(brow + tid) * 4 + u.pn] = (v[0] + v[1]) + (v[2] + v[3]); }
        }
    }
};

template <class Epi>
__device__ __forceinline__ void run_gemm(const bf16_t* A, const bf16_t* Bt, int M, int N, int K, char* shm, const Epi& epi) {
    asm volatile("" : "+s"(K));
    pg8::Gemm g{A, Bt, M, N, K}; pg8::StaticOrder S; S.init(M, N, (int)gridDim.x, (int)blockIdx.x);
    pg8::gemm_phase<Epi, pg8::StaticOrder, true, true>((PG8_LAS unsigned char*)shm, g, S, epi);
}

__device__ __forceinline__ int src_col(int r, int mode) {
    if (mode == 0) return r;
    if (mode == 2) { const int g = r >> 9; const int sg = g == 0 ? 0 : g == 1 ? 1 : g == 2 ? 3 : g == 3 ? 4 : g == 4 ? 5 : g == 5 ? 2 : 6; return sg * 512 + (r & 511); }
    const int tile = r >> 8, w = r & 255, bj = w >> 7, j = w & 127;
    return bj * DFF + tile * 128 + j;
}
__device__ void conv_weight(const float* __restrict__ W, int K, int ldw, bf16_t* __restrict__ Wt, int Nrows, int mode, const float* __restrict__ gain, float* lds, int vb, int nvb) {
    const int nk = K / 64, nr = Nrows / 256, tid = threadIdx.x;
    for (int it = vb; it < nk * nr; it += nvb) {
        const int k0 = (it % nk) * 64, r0 = (it / nk) * 256;
        f32x4 v[8];
        const int sc = src_col(r0 + (tid & 63) * 4, mode);
#pragma unroll
        for (int i = 0; i < 8; ++i) v[i] = *(const f32x4*)(W + (size_t)(k0 + (tid >> 6) + 8 * i) * ldw + sc);
        __syncthreads();
#pragma unroll
        for (int i = 0; i < 8; ++i) *(f32x4*)(lds + ((tid >> 6) + 8 * i) * 260 + (tid & 63) * 4) = v[i];
        __syncthreads();
#pragma unroll
        for (int j = 0; j < 4; ++j) {
            const int e = tid + 512 * j, r = e & 255, kg = e >> 8;
            float f[8];
#pragma unroll
            for (int i = 0; i < 8; ++i) { f[i] = lds[(8 * kg + i) * 260 + r]; if (gain) f[i] *= gain[k0 + 8 * kg + i]; }
            u32x4 w; w.x = cvt_pk_bf16(f[0], f[1]); w.y = cvt_pk_bf16(f[2], f[3]); w.z = cvt_pk_bf16(f[4], f[5]); w.w = cvt_pk_bf16(f[6], f[7]);
            *(u32x4*)(Wt + (size_t)(r0 + r) * K + k0 + 8 * kg) = w;
        }
    }
}
__device__ void phase0_rest(const Params& p, char* shm) {
    float* lds = (float*)shm; char* ws = p.ws;
    const int vb = blockIdx.x, nvb = gridDim.x;
    conv_weight(p.w_out, DM, DM, (bf16_t*)(ws + OFF_WOUT), DM, 0, nullptr, lds, vb, nvb);
    conv_weight(p.w_gu, DM, 2 * DFF, (bf16_t*)(ws + OFF_WGU), 2 * DFF, 1, p.g_ffn_pre, lds, vb, nvb);
    conv_weight(p.w_down, DFF, DM, (bf16_t*)(ws + OFF_WDN), DM, 0, nullptr, lds, vb, nvb);
    conv_weight(p.w_pp, PLE, DM, (bf16_t*)(ws + OFF_WPP), DM, 0, nullptr, lds, vb, nvb);
    conv_weight(p.w_pg, DM, DM, (bf16_t*)(ws + OFF_WPG), DM, 0, nullptr, lds, vb, nvb);
    __syncthreads();
    bf16_t* pb = (bf16_t*)(ws + OFF_PB);
    for (size_t i0 = (size_t)blockIdx.x * 512 + threadIdx.x; i0 < (size_t)MT * PLE / 4; i0 += (size_t)gridDim.x * 512 * 4) {
        f32x4 v[4];
#pragma unroll
        for (int j = 0; j < 4; ++j) { const size_t i = i0 + (size_t)j * gridDim.x * 512; if (i < (size_t)MT * PLE / 4) v[j] = __builtin_nontemporal_load((const f32x4*)(p.p + i * 4)); }
#pragma unroll
        for (int j = 0; j < 4; ++j) { const size_t i = i0 + (size_t)j * gridDim.x * 512; if (i < (size_t)MT * PLE / 4) { u32x2 w; w.x = cvt_pk_bf16(v[j][0], v[j][1]); w.y = cvt_pk_bf16(v[j][2], v[j][3]); *(u32x2*)(pb + i * 4) = w; } }
    }
    __syncthreads();
}
__device__ void phase0(const Params& p, char* shm) {
    float* lds = (float*)shm; char* ws = p.ws;
    const int vb = blockIdx.x, nvb = gridDim.x;
    conv_weight(p.w_in, DM, NIN, (bf16_t*)(ws + OFF_WIN), NIN, 2, p.g_attn_pre, lds, vb, nvb);
    if (blockIdx.x == 0) { float* lb = (float*)(ws + OFF_LB); const int c = threadIdx.x; const float l = sigmoidf_(p.gamma[c] - p.gamma[512 + c]); lb[c] = l; lb[512 + c] = 1.0f - l; }
    const int wid = threadIdx.x >> 6, lane = threadIdx.x & 63;
    bf16_t* xb = (bf16_t*)(ws + OFF_XB); float* rx = (float*)(ws + OFF_RX);
    for (int row0 = (blockIdx.x * 8 + wid) * 4; row0 < MT; row0 += gridDim.x * 32) {
        f32x4 v[4][4];
#pragma unroll
        for (int r = 0; r < 4; ++r)
#pragma unroll
            for (int i = 0; i < 4; ++i) v[r][i] = __builtin_nontemporal_load((const f32x4*)(p.x + (size_t)(row0 + r) * DM + i * 256 + lane * 4));
#pragma unroll
        for (int r = 0; r < 4; ++r) {
            float ss = 0.f;
#pragma unroll
            for (int i = 0; i < 4; ++i) { const f32x4 t = v[r][i]; ss += t[0] * t[0] + t[1] * t[1] + t[2] * t[2] + t[3] * t[3];
                u32x2 w; w.x = cvt_pk_bf16(t[0], t[1]); w.y = cvt_pk_bf16(t[2], t[3]); *(u32x2*)(xb + (size_t)(row0 + r) * DM + i * 256 + lane * 4) = w; }
            ss = wave_sum(ss);
            if (lane == 0) rx[row0 + r] = rsqrtf(ss * (1.0f / DM) + EPS);
        }
    }
}

template <int WHICH>
__device__ void phase_res(const Params& p) {
    char* ws = p.ws; const int wid = threadIdx.x >> 6, lane = threadIdx.x & 63;
    const float* src = (const float*)(ws + (WHICH == 1 ? OFF_QT : OFF_Y)); const float* base = WHICH == 1 ? p.x : p.out; const float* gn = WHICH == 1 ? p.g_attn_post : p.g_ffn_post;
    bf16_t* hb = (bf16_t*)(ws + (WHICH == 1 ? OFF_XB : OFF_H2B)); float* rh = (float*)(ws + OFF_RH1);
    f32x4 g[4];
#pragma unroll
    for (int i = 0; i < 4; ++i) g[i] = *(const f32x4*)(gn + i * 256 + lane * 4);
    for (int row0 = (blockIdx.x * 8 + wid) * 2; row0 < MT; row0 += gridDim.x * 16) {
        f32x4 mv[2][4], xv[2][4];
#pragma unroll
        for (int r = 0; r < 2; ++r)
#pragma unroll
            for (int i = 0; i < 4; ++i) { mv[r][i] = __builtin_nontemporal_load((const f32x4*)(src + (size_t)(row0 + r) * DM + i * 256 + lane * 4)); xv[r][i] = __builtin_nontemporal_load((const f32x4*)(base + (size_t)(row0 + r) * DM + i * 256 + lane * 4)); }
#pragma unroll
        for (int r = 0; r < 2; ++r) {
            float ss = 0.f;
#pragma unroll
            for (int i = 0; i < 4; ++i) ss += mv[r][i][0] * mv[r][i][0] + mv[r][i][1] * mv[r][i][1] + mv[r][i][2] * mv[r][i][2] + mv[r][i][3] * mv[r][i][3];
            ss = wave_sum(ss); const float rr = rsqrtf(ss * (1.0f / DM) + EPS); float s2 = 0.f;
#pragma unroll
            for (int i = 0; i < 4; ++i) { const int c = i * 256 + lane * 4; f32x4 h;
#pragma unroll
                for (int j = 0; j < 4; ++j) { h[j] = xv[r][i][j] + mv[r][i][j] * rr * g[i][j]; s2 += h[j] * h[j]; }
                *(f32x4*)(p.out + (size_t)(row0 + r) * DM + c) = h; u32x2 w; w.x = cvt_pk_bf16(h[0], h[1]); w.y = cvt_pk_bf16(h[2], h[3]); *(u32x2*)(hb + (size_t)(row0 + r) * DM + c) = w; }
            if (WHICH == 1) { s2 = wave_sum(s2); if (lane == 0) rh[row0 + r] = rsqrtf(s2 * (1.0f / DM) + EPS); }
        }
    }
}

#define MFMA32(a, b, c) __builtin_amdgcn_mfma_f32_32x32x16_bf16((a), (b), (c), 0, 0, 0)
#define MFMA16(a, b, c) __builtin_amdgcn_mfma_f32_16x16x32_bf16((a), (b), (c), 0, 0, 0)
__device__ __forceinline__ bf16x8 mk8(u32x2 a, u32x2 b) { u32x4 t; t.x = a.x; t.y = a.y; t.z = b.x; t.w = b.y; return __builtin_bit_cast(bf16x8, t); }
__device__ void phase_attn(const Params& p, char* shm, unsigned* queue) {
    char* ws = p.ws; const int tid = opaque_tid(), h = tid >> 6, lane = tid & 63, n = lane & 31, hh = lane >> 5;
    const bf16_t* SQ = (const bf16_t*)(ws + OFF_SQ); const bf16_t* SK = (const bf16_t*)(ws + OFF_SQ + SZ_HALF); const bf16_t* SVT = (const bf16_t*)(ws + OFF_SVT);
    bf16_t* am = (bf16_t*)(ws + OFF_AMIX); float* red = (float*)shm;
    int* itp = (int*)(shm + 2048);
    unsigned nxt_it = 0;
    if (threadIdx.x == 0) nxt_it = __hip_atomic_fetch_add(queue, 1u, __ATOMIC_RELAXED, __HIP_MEMORY_SCOPE_AGENT);
    for (;;) {
        __syncthreads();
        if (threadIdx.x == 0) { *itp = (int)nxt_it; if (nxt_it < NB * 128) nxt_it = __hip_atomic_fetch_add(queue, 1u, __ATOMIC_RELAXED, __HIP_MEMORY_SCOPE_AGENT); }
        __syncthreads();
        const int it0 = *itp; if (it0 >= NB * 128) break;
        const int it = NB * 128 - 1 - it0;
        const int b = it >> 7, qb = it & 127, t0 = qb * 32;
        const size_t tokq = (size_t)b * NT + t0 + n;
        bf16x8 qf[4];
#pragma unroll
        for (int ks = 0; ks < 4; ++ks) qf[ks] = *(const bf16x8*)(SQ + tokq * 512 + h * 64 + 16 * ks + 8 * hh);
        f32x16 o0, o1;
#pragma unroll
        for (int r = 0; r < 16; ++r) { o0[r] = 0.f; o1[r] = 0.f; }
        float R = 1.0f;
        bf16x8 kf[4]; u32x2 vf[2][2][2];
        const bf16_t* vbase = SVT + (size_t)(h * 64 + n) * 64 + 4 * hh;
        {
            const size_t tk = (size_t)b * NT + t0 + n;
#pragma unroll
            for (int ks = 0; ks < 4; ++ks) kf[ks] = *(const bf16x8*)(SK + tk * 512 + h * 64 + 16 * ks + 8 * hh);
#pragma unroll
            for (int db = 0; db < 2; ++db)
#pragma unroll
                for (int s = 0; s < 2; ++s)
#pragma unroll
                    for (int hf = 0; hf < 2; ++hf) vf[db][s][hf] = *(const u32x2*)(vbase + vt_off(0, (size_t)b * NT + t0) + db * 32 * 64 + 16 * s + 8 * hf);
        }
        for (int kb = qb; kb >= 0; --kb) {
            const int s1 = (kb > 0 ? kb - 1 : 0) * 32;
            bf16x8 kn[4]; u32x2 vn[2][2][2];
            {
                const size_t tk = (size_t)b * NT + s1 + n;
#pragma unroll
                for (int ks = 0; ks < 4; ++ks) kn[ks] = *(const bf16x8*)(SK + tk * 512 + h * 64 + 16 * ks + 8 * hh);
#pragma unroll
                for (int db = 0; db < 2; ++db)
#pragma unroll
                    for (int s = 0; s < 2; ++s)
#pragma unroll
                        for (int hf = 0; hf < 2; ++hf) vn[db][s][hf] = *(const u32x2*)(vbase + vt_off(0, (size_t)b * NT + s1) + db * 32 * 64 + 16 * s + 8 * hf);
            }
            f32x16 st;
#pragma unroll
            for (int r = 0; r < 16; ++r) st[r] = 0.f;
#pragma unroll
            for (int ks = 0; ks < 4; ++ks) st = MFMA32(kf[ks], qf[ks], st);
            float mm[16], be[16];
#pragma unroll
            for (int r = 0; r < 16; ++r) { const float e = fexp2(st[r]); mm[r] = frcp(1.0f + e); be[r] = 1.0f - mm[r]; }
            if (kb == qb) {
#pragma unroll
                for (int r = 0; r < 16; ++r) { const bool act = ((r & 3) + 8 * (r >> 2) + 4 * hh) < n; mm[r] = act ? mm[r] : 1.0f; be[r] = act ? be[r] : 0.0f; }
            }
            float go[4], gp[4], T[4];
#pragma unroll
            for (int g = 0; g < 4; ++g) { go[g] = (mm[4 * g] * mm[4 * g + 1]) * (mm[4 * g + 2] * mm[4 * g + 3]); gp[g] = __shfl_xor(go[g], 32); }
            T[3] = 1.0f; T[2] = go[3] * gp[3]; T[1] = T[2] * (go[2] * gp[2]); T[0] = T[1] * (go[1] * gp[1]);
            const float tot = T[0] * (go[0] * gp[0]);
            float aa[16];
#pragma unroll
            for (int g = 0; g < 4; ++g) {
                float x = R * T[g] * (hh == 0 ? gp[g] : 1.0f);
                aa[4 * g + 3] = be[4 * g + 3] * x; x *= mm[4 * g + 3];
                aa[4 * g + 2] = be[4 * g + 2] * x; x *= mm[4 * g + 2];
                aa[4 * g + 1] = be[4 * g + 1] * x; x *= mm[4 * g + 1];
                aa[4 * g + 0] = be[4 * g + 0] * x;
            }
            u32x4 p0, p1;
            p0.x = cvt_pk_bf16(aa[0], aa[1]); p0.y = cvt_pk_bf16(aa[2], aa[3]); p0.z = cvt_pk_bf16(aa[4], aa[5]); p0.w = cvt_pk_bf16(aa[6], aa[7]);
            p1.x = cvt_pk_bf16(aa[8], aa[9]); p1.y = cvt_pk_bf16(aa[10], aa[11]); p1.z = cvt_pk_bf16(aa[12], aa[13]); p1.w = cvt_pk_bf16(aa[14], aa[15]);
            const bf16x8 pf0 = __builtin_bit_cast(bf16x8, p0), pf1 = __builtin_bit_cast(bf16x8, p1);
            o0 = MFMA32(mk8(vf[0][0][0], vf[0][0][1]), pf0, o0); o0 = MFMA32(mk8(vf[0][1][0], vf[0][1][1]), pf1, o0);
            o1 = MFMA32(mk8(vf[1][0][0], vf[1][0][1]), pf0, o1); o1 = MFMA32(mk8(vf[1][1][0], vf[1][1][1]), pf1, o1);
            R *= tot;
            if (__ballot(R > 0.0f) == 0ull) break;
#pragma unroll
            for (int ks = 0; ks < 4; ++ks) kf[ks] = kn[ks];
#pragma unroll
            for (int db = 0; db < 2; ++db)
#pragma unroll
                for (int s = 0; s < 2; ++s) { vf[db][s][0] = vn[db][s][0]; vf[db][s][1] = vn[db][s][1]; }
        }
        float ss = 0.f;
#pragma unroll
        for (int r = 0; r < 16; ++r) ss += o0[r] * o0[r] + o1[r] * o1[r];
        ss += __shfl_xor(ss, 32);
        __syncthreads();
        if (hh == 0) red[h * 32 + n] = ss;
        __syncthreads();
        float tsum = 0.f;
#pragma unroll
        for (int w = 0; w < 8; ++w) tsum += red[w * 32 + n];
        const float rr = rsqrtf(tsum * (1.0f / 512) + EPS);
        f32x4 gwv[2][4];
#pragma unroll
        for (int db = 0; db < 2; ++db)
#pragma unroll
            for (int g = 0; g < 4; ++g) gwv[db][g] = *(const f32x4*)(p.g_sb + h * 64 + 32 * db + 8 * g + 4 * hh);
#pragma unroll
        for (int db = 0; db < 2; ++db)
#pragma unroll
            for (int g = 0; g < 4; ++g) {
                const int d0 = 32 * db + 8 * g + 4 * hh; const f32x4 gw = gwv[db][g];
                float v[4];
#pragma unroll
                for (int j = 0; j < 4; ++j) v[j] = (db == 0 ? o0[4 * g + j] : o1[4 * g + j]) * rr * gw[j];
                u32x2 w; w.x = cvt_pk_bf16(v[0], v[1]); w.y = cvt_pk_bf16(v[2], v[3]);
                *(u32x2*)(am + tokq * DM + 512 + h * 64 + d0) = w;
            }
    }
}

#define LDS_BAR() do { asm volatile("s_waitcnt lgkmcnt(0)" ::: "memory"); __builtin_amdgcn_s_barrier(); asm volatile("" ::: "memory"); } while (0)
constexpr int HSEG = 8, HCH = 64 / HSEG;
template <bool FULL>
__device__ void phase_hgseg(const Params& p, char* shm, int bh, int seg) {
    char* ws = p.ws; const int tid = opaque_tid(), w = tid >> 6, lane = tid & 63, fr = lane & 15, fq = lane >> 4, kp = tid & 63, r8 = tid >> 6;
    const int b = bh >> 2, h = bh & 3;
    const float* LF = (const float*)(ws + OFF_BC); const bf16_t* KK = (const bf16_t*)(ws + OFF_QT + SZ_HALF); const bf16_t* QT = (const bf16_t*)(ws + OFF_QT);
    const bf16_t* G = (const bf16_t*)(ws + OFF_QT + 3 * SZ_HALF); const bf16_t* VHT = (const bf16_t*)(ws + OFF_VHT);
    bf16_t* am = (bf16_t*)(ws + OFF_AMIX); float* parth = (float*)(ws + OFF_DC); float* SLOC = (float*)(ws + OFF_SLOC); float* DSEG = (float*)(ws + OFF_SLOC + 32 * MiB);
    float* qs = (float*)shm; float* dvec = (float*)(shm + 4096); float* red = (float*)(shm + 4608);
    char* sQs = shm + 8192; char* sQd = sQs + 17408; char* sKd = sQd + 17408; char* sP = sKd + 17408; char* keT = sP + 9216;
    f32x4 S[8];
#pragma unroll
    for (int kb = 0; kb < 8; ++kb) S[kb] = (f32x4){0.f, 0.f, 0.f, 0.f};
    f32x2 lfn[8]; unsigned qn[8]; bf16x8 vn[2]; u32x2 gn[4];
#define HG_LOAD(cc) do { const size_t _t0 = (size_t)b * NT + 64 * (cc); \
        _Pragma("unroll") for (int i = 0; i < 8; ++i) { const size_t a_ = (_t0 + 8 * r8 + i) * 512 + h * 128 + 2 * kp; lfn[i] = *(const f32x2*)(LF + a_); if (FULL) qn[i] = *(const unsigned*)(QT + a_); } \
        _Pragma("unroll") for (int ks = 0; ks < 2; ++ks) vn[ks] = *(const bf16x8*)(VHT + vt_off(h * 128 + 16 * w + fr, _t0) + 32 * ks + 8 * fq); \
        if (FULL) { _Pragma("unroll") for (int tb = 0; tb < 4; ++tb) gn[tb] = *(const u32x2*)(G + (_t0 + 16 * tb + fr) * 512 + h * 128 + 16 * w + 4 * fq); } } while (0)
    const int c0 = seg * HCH;
    HG_LOAD(c0);
    if (FULL) {
        for (int s = 0; s < seg; ++s) {
            const float* sl = SLOC + ((size_t)(bh * HSEG + s) * 128 + 16 * w + fr) * 128 + 4 * fq; const float* ds = DSEG + (size_t)(bh * HSEG + s) * 128 + 4 * fq;
            f32x4 lv[8], dv[8];
#pragma unroll
            for (int kb = 0; kb < 8; ++kb) { lv[kb] = *(const f32x4*)(sl + 16 * kb); dv[kb] = *(const f32x4*)(ds + 16 * kb); }
#pragma unroll
            for (int kb = 0; kb < 8; ++kb) S[kb] = S[kb] * dv[kb] + lv[kb];
        }
    }
    f32x4 gw = {0.f, 0.f, 0.f, 0.f};
    if (FULL) gw = *(const f32x4*)(p.g_hg + h * 128 + 16 * w + 4 * fq);
    float dsum0 = 0.f, dsum1 = 0.f;
    for (int ci = 0; ci < HCH; ++ci) {
        const int c = c0 + ci; const size_t tok0 = (size_t)b * NT + 64 * c;
        f32x2 lfv[8], kkv[8]; unsigned qv[8]; bf16x8 vfr[2]; u32x2 gv[4];
#pragma unroll
        for (int i = 0; i < 8; ++i) { lfv[i] = lfn[i]; kkv[i].x = 1.0f - fexp2(lfn[i].x); kkv[i].y = 1.0f - fexp2(lfn[i].y); if (FULL) qv[i] = qn[i]; }
        vfr[0] = vn[0]; vfr[1] = vn[1];
        if (FULL) {
#pragma unroll
            for (int tb = 0; tb < 4; ++tb) gv[tb] = gn[tb];
        }
        { const int cn = ci < HCH - 1 ? c + 1 : c; HG_LOAD(cn); }
        f32x2 run = {0.f, 0.f};
#pragma unroll
        for (int i = 0; i < 8; ++i) { run += lfv[i]; lfv[i] = run; }
        *(f32x2*)(qs + r8 * 128 + 2 * kp) = run;
        LDS_BAR();
        if (FULL && ci > 0 && tid < 64) { float s = 0.f;
#pragma unroll
            for (int ww = 0; ww < 8; ++ww) s += red[ww * 64 + tid];
            parth[(tok0 - 64 + tid) * 4 + h] = s; }
        f32x2 off = {0.f, 0.f}, bmid = {0.f, 0.f}, blast = {0.f, 0.f};
#pragma unroll
        for (int j = 0; j < 8; ++j) { const f32x2 q = *(const f32x2*)(qs + j * 128 + 2 * kp); if (j < r8) off += q; if (j < 4) bmid += q; blast += q; }
        if (r8 == 0) { f32x2 d; d.x = fexp2(blast.x); d.y = fexp2(blast.y); *(f32x2*)(dvec + 2 * kp) = d; dsum0 += blast.x; dsum1 += blast.y; }
        f32x2 emid, elast;
        emid.x = fexp2(bmid.x); emid.y = fexp2(bmid.y); elast.x = fexp2(blast.x - bmid.x); elast.y = fexp2(blast.y - bmid.y);
        float ke0[8], ke1[8];
#pragma unroll
        for (int i = 0; i < 8; ++i) {
            const int t = 8 * r8 + i; const f32x2 bb = off + lfv[i];
            const float k0 = kkv[i].x, k1 = kkv[i].y;
            const float f0 = fexp2(bmid.x - bb.x), f1 = fexp2(bmid.y - bb.y);
            const float kd0 = k0 * f0, kd1 = k1 * f1;
            ke0[i] = kd0 * elast.x; ke1[i] = kd1 * elast.y;
            if (FULL) {
                const float e0 = fexp2(bb.x - bmid.x), e1 = fexp2(bb.y - bmid.y);
                const float qd0 = bflo(qv[i]) * e0, qd1 = bfhi(qv[i]) * e1;
                *(unsigned*)(sQd + t * 272 + kp * 4) = cvt_pk_bf16(qd0, qd1);
                *(unsigned*)(sQs + t * 272 + kp * 4) = cvt_pk_bf16(qd0 * emid.x, qd1 * emid.y);
                *(unsigned*)(sKd + t * 272 + kp * 4) = cvt_pk_bf16(kd0, kd1);
            }
        }
        { u32x4 a0, a1;
          a0.x = cvt_pk_bf16(ke0[0], ke0[1]); a0.y = cvt_pk_bf16(ke0[2], ke0[3]); a0.z = cvt_pk_bf16(ke0[4], ke0[5]); a0.w = cvt_pk_bf16(ke0[6], ke0[7]);
          a1.x = cvt_pk_bf16(ke1[0], ke1[1]); a1.y = cvt_pk_bf16(ke1[2], ke1[3]); a1.z = cvt_pk_bf16(ke1[4], ke1[5]); a1.w = cvt_pk_bf16(ke1[6], ke1[7]);
          *(u32x4*)(keT + (2 * kp) * 144 + r8 * 16) = a0; *(u32x4*)(keT + (2 * kp + 1) * 144 + r8 * 16) = a1; }
        LDS_BAR();
        if (FULL) {
            {
                const int tb = w >> 1;
                bf16x8 qf[4], kf[2][4];
#pragma unroll
                for (int ks = 0; ks < 4; ++ks) { qf[ks] = *(const bf16x8*)(sQd + (16 * tb + fr) * 272 + 64 * ks + 16 * fq);
#pragma unroll
                    for (int u = 0; u < 2; ++u) kf[u][ks] = *(const bf16x8*)(sKd + (16 * (2 * (w & 1) + u) + fr) * 272 + 64 * ks + 16 * fq); }
                __builtin_amdgcn_sched_barrier(0);
#pragma unroll
                for (int u = 0; u < 2; ++u) {
                    const int sb = 2 * (w & 1) + u;
                    f32x4 acc = {0.f, 0.f, 0.f, 0.f};
                    if (sb <= tb) {
#pragma unroll
                        for (int ks = 0; ks < 4; ++ks) acc = MFMA16(kf[u][ks], qf[ks], acc);
                    }
                    const int t = 16 * tb + fr, s0 = 16 * sb + 4 * fq;
#pragma unroll
                    for (int j = 0; j < 4; ++j) acc[j] = (s0 + j <= t) ? acc[j] : 0.f;
                    u32x2 o; o.x = cvt_pk_bf16(acc[0], acc[1]); o.y = cvt_pk_bf16(acc[2], acc[3]);
                    *(u32x2*)(sP + t * 144 + s0 * 2) = o;
                }
            }
            LDS_BAR();
            bf16x8 sb16[4];
#pragma unroll
            for (int ks = 0; ks < 4; ++ks) { u32x4 t4; t4.x = cvt_pk_bf16(S[2 * ks][0], S[2 * ks][1]); t4.y = cvt_pk_bf16(S[2 * ks][2], S[2 * ks][3]); t4.z = cvt_pk_bf16(S[2 * ks + 1][0], S[2 * ks + 1][1]); t4.w = cvt_pk_bf16(S[2 * ks + 1][2], S[2 * ks + 1][3]); sb16[ks] = __builtin_bit_cast(bf16x8, t4); }
            bf16x8 qsf[4][4], pf[4][2];
#pragma unroll
            for (int tb = 0; tb < 4; ++tb) {
#pragma unroll
                for (int ks = 0; ks < 4; ++ks) { const u32x2 lo = *(const u32x2*)(sQs + (16 * tb + fr) * 272 + (32 * ks + 4 * fq) * 2), hi = *(const u32x2*)(sQs + (16 * tb + fr) * 272 + (32 * ks + 16 + 4 * fq) * 2); qsf[tb][ks] = mk8(lo, hi); }
#pragma unroll
                for (int ks = 0; ks < 2; ++ks) pf[tb][ks] = *(const bf16x8*)(sP + (16 * tb + fr) * 144 + 64 * ks + 16 * fq);
            }
            __builtin_amdgcn_sched_barrier(0);
#pragma unroll
            for (int tb = 0; tb < 4; ++tb) {
                f32x4 acc = {0.f, 0.f, 0.f, 0.f};
#pragma unroll
                for (int ks = 0; ks < 4; ++ks) acc = MFMA16(sb16[ks], qsf[tb][ks], acc);
#pragma unroll
                for (int ks = 0; ks < 2; ++ks) acc = MFMA16(vfr[ks], pf[tb][ks], acc);
                float s = (acc[0] * acc[0] + acc[1] * acc[1]) + (acc[2] * acc[2] + acc[3] * acc[3]);
                s += __shfl_xor(s, 16); s += __shfl_xor(s, 32);
                if (fq == 0) red[w * 64 + 16 * tb + fr] = s;
                const u32x2 g2 = gv[tb];
                u32x2 o; o.x = cvt_pk_bf16(acc[0] * gw[0] * bflo(g2.x), acc[1] * gw[1] * bfhi(g2.x)); o.y = cvt_pk_bf16(acc[2] * gw[2] * bflo(g2.y), acc[3] * gw[3] * bfhi(g2.y));
                *(u32x2*)(am + (tok0 + 16 * tb + fr) * DM + h * 128 + 16 * w + 4 * fq) = o;
            }
        }
#pragma unroll
        for (int kg = 0; kg < 2; ++kg) {
            f32x4 dd[4]; bf16x8 kf[4][2];
#pragma unroll
            for (int q = 0; q < 4; ++q) { const int kb = 4 * kg + q; dd[q] = *(const f32x4*)(dvec + 16 * kb + 4 * fq);
#pragma unroll
                for (int ks = 0; ks < 2; ++ks) kf[q][ks] = *(const bf16x8*)(keT + (16 * kb + fr) * 144 + 64 * ks + 16 * fq); }
            __builtin_amdgcn_sched_barrier(0);
#pragma unroll
            for (int q = 0; q < 4; ++q) { const int kb = 4 * kg + q;
                f32x4 acc = S[kb] * dd[q];
#pragma unroll
                for (int ks = 0; ks < 2; ++ks) acc = MFMA16(kf[q][ks], vfr[ks], acc);
                S[kb] = acc; }
        }
    }
    if (FULL) {
        __syncthreads();
        if (tid < 64) { float s = 0.f;
#pragma unroll
            for (int ww = 0; ww < 8; ++ww) s += red[ww * 64 + tid];
            parth[((size_t)b * NT + 64 * (c0 + HCH - 1) + tid) * 4 + h] = s; }
    } else {
#pragma unroll
        for (int kb = 0; kb < 8; ++kb) *(f32x4*)(SLOC + ((size_t)(bh * HSEG + seg) * 128 + 16 * w + fr) * 128 + 16 * kb + 4 * fq) = S[kb];
        if (r8 == 0) { f32x2 d; d.x = fexp2(dsum0); d.y = fexp2(dsum1); *(f32x2*)(DSEG + (size_t)(bh * HSEG + seg) * 128 + 2 * kp) = d; }
    }
    __syncthreads();
#undef HG_LOAD
}

#define XB_TMO      128
#define XB_XCNT(j)  (256  + 64 * (j))
#define XB_XSUB(j)  (1280 + 64 * (j))
#define XB_XGEN(j)  (2304 + 64 * (j))
#define XB_TOP      3328
#define XB_TOPGEN   3392
#define XCD_BAR_WORDS 3456
#define XB_SPIN_CAP (1u << 18)
#define LAS __attribute__((address_space(3)))

__device__ __forceinline__ unsigned xb_ld(unsigned* p)              { return __hip_atomic_load(p, __ATOMIC_RELAXED, __HIP_MEMORY_SCOPE_AGENT); }
__device__ __forceinline__ unsigned xb_add(unsigned* p, unsigned v) { return __hip_atomic_fetch_add(p, v, __ATOMIC_RELAXED, __HIP_MEMORY_SCOPE_AGENT); }
__device__ __forceinline__ unsigned xb_xcc_id() { return (unsigned)__builtin_amdgcn_s_getreg((3 << 11) | 20) & 0xFu; }
#define XB_SPIN(cond, bar) do { unsigned _sp = 0; while (cond) { __builtin_amdgcn_s_sleep(1); \
    if ((++_sp & 255u) == 0u) { if (xb_ld(&(bar)[XB_TMO])) break; if (_sp > XB_SPIN_CAP) { atomicAdd(&(bar)[XB_TMO], 1u); break; } } } } while (0)

struct XcdBarrier {
    unsigned* bar; unsigned x;
    volatile LAS unsigned* st;
};

__device__ __forceinline__ XcdBarrier xcd_barrier_post(unsigned* bar, volatile LAS unsigned* st) {
    XcdBarrier b; b.bar = bar; b.x = xb_xcc_id(); b.st = st;
    if (threadIdx.x == 0) (void)xb_add(&bar[XB_XCNT(b.x)], 1u);
    return b;
}
__device__ __forceinline__ void xcd_barrier_complete(unsigned* bar, unsigned x, unsigned& nloc, unsigned& nx) {
    const unsigned G = gridDim.x * gridDim.y * gridDim.z;
    unsigned sum, cnt, mine, sp = 0u;
    for (;;) {
        sum = 0u; cnt = 0u; mine = 0u;
#pragma unroll
        for (unsigned j = 0; j < 16; ++j) { const unsigned c = xb_ld(&bar[XB_XCNT(j)]); sum += c; cnt += (c > 0u) ? 1u : 0u; mine = (j == x) ? c : mine; }
        if (sum == G) break;
        __builtin_amdgcn_s_sleep(1);
        if ((++sp & 255u) == 0u) { if (xb_ld(&bar[XB_TMO])) break; if (sp > XB_SPIN_CAP) { atomicAdd(&bar[XB_TMO], 1u); break; } }
    }
    nloc = mine > 0u ? mine : 1u; nx = cnt > 0u ? cnt : 1u;
}

__device__ __forceinline__ void xcd_barrier(const XcdBarrier& b) {
    asm volatile("s_waitcnt vmcnt(0)" ::: "memory");
    __syncthreads();
    if (threadIdx.x == 0) {
        unsigned* bar = b.bar;
        __builtin_amdgcn_s_waitcnt(0);
        unsigned nloc = b.st[0], nx = b.st[1];
        if (nloc == 0u) { xcd_barrier_complete(bar, b.x, nloc, nx); b.st[0] = nloc; b.st[1] = nx; }
        const unsigned old = xb_add(&bar[XB_XSUB(b.x)], 1u);
        const unsigned gen = old / nloc;
        if (old + 1u == (gen + 1u) * nloc) {
            __builtin_amdgcn_fence(__ATOMIC_RELEASE, "agent");
            asm volatile("s_waitcnt vmcnt(0)" ::: "memory");
            const unsigned og = xb_add(&bar[XB_TOP], 1u);
            const unsigned tg = og / nx;
            if (og + 1u == (tg + 1u) * nx) xb_add(&bar[XB_TOPGEN], 1u);
            else XB_SPIN(xb_ld(&bar[XB_TOPGEN]) == tg, bar);
            __builtin_amdgcn_fence(__ATOMIC_ACQUIRE, "agent");
            xb_add(&bar[XB_XGEN(b.x)], 1u);
            asm volatile("s_waitcnt vmcnt(0)" ::: "memory");
        } else {
            XB_SPIN(xb_ld(&bar[XB_XGEN(b.x)]) == gen, bar);
            __builtin_amdgcn_fence(__ATOMIC_ACQUIRE, "agent");
            asm volatile("s_waitcnt vmcnt(0)" ::: "memory");
        }
    }
    __syncthreads();
}


template <int PH> __device__ __forceinline__ void do_phase(const Params& p, char* shm) {
    char* ws = p.ws; char* epl = shm + SHM_B + 16;
    if (PH == 0) phase0(p, shm);
    if (PH == 1) {
        if (blockIdx.x & 1) phase0_rest(p, shm);
        run_gemm((const bf16_t*)(ws + OFF_XB), (const bf16_t*)(ws + OFF_WIN), MT, 2560, DM, shm, EpiIn{(const float*)(ws + OFF_RX), ws, epl});
        run_gemm((const bf16_t*)(ws + OFF_WIN) + (size_t)2560 * DM, (const bf16_t*)(ws + OFF_XB), 1024, MT, DM, shm, EpiVT{(const float*)(ws + OFF_RX), ws, epl});
        if (!(blockIdx.x & 1)) phase0_rest(p, shm);
    }
    if (PH == 2) { for (int u = blockIdx.x; u < 32 * HSEG; u += gridDim.x) if ((u & (HSEG - 1)) != HSEG - 1) phase_hgseg<false>(p, shm, u / HSEG, u & (HSEG - 1));
                   phase_attn(p, shm, (unsigned*)(ws + OFF_CNT) + 2 * 128 * 64); }
    if (PH == 3) { for (int u = blockIdx.x; u < 32 * HSEG; u += gridDim.x) phase_hgseg<true>(p, shm, u / HSEG, u & (HSEG - 1)); }
    if (PH == 5) run_gemm((const bf16_t*)(ws + OFF_AMIX), (const bf16_t*)(ws + OFF_WOUT), MT, DM, DM, shm,
                          EpiRes<1>{p.g_attn_post, (bf16_t*)(ws + OFF_XB), (float*)(ws + OFF_PART1), (unsigned*)(ws + OFF_CNT), (float*)(ws + OFF_PART2), epl, (const float*)(ws + OFF_DC)});
    if (PH == 7) {
        const bool ple_first = ((blockIdx.x >> 3) & 1) != 0;
        if (ple_first) run_gemm((const bf16_t*)(ws + OFF_PB), (const bf16_t*)(ws + OFF_WPP), MT, DM, PLE, shm, EpiBf16{(bf16_t*)(ws + OFF_PLE), DM});
        run_gemm((const bf16_t*)(ws + OFF_XB), (const bf16_t*)(ws + OFF_WGU), MT, 2 * DFF, DM, shm, EpiAct{(const float*)(ws + OFF_PART2), (bf16_t*)(ws + OFF_ACT), epl});
        if (!ple_first) run_gemm((const bf16_t*)(ws + OFF_PB), (const bf16_t*)(ws + OFF_WPP), MT, DM, PLE, shm, EpiBf16{(bf16_t*)(ws + OFF_PLE), DM});
    }
    if (PH == 8) run_gemm((const bf16_t*)(ws + OFF_ACT), (const bf16_t*)(ws + OFF_WDN), MT, DM, DFF, shm,
                          EpiRes<2>{p.g_ffn_post, (bf16_t*)(ws + OFF_XB), (float*)(ws + OFF_PART3), (unsigned*)(ws + OFF_CNT) + 128 * 64, nullptr, epl, nullptr});
    if (PH == 10) run_gemm((const bf16_t*)(ws + OFF_XB), (const bf16_t*)(ws + OFF_WPG), MT, DM, DM, shm, EpiFinal{p.out, (const bf16_t*)(ws + OFF_PLE), (const bf16_t*)(ws + OFF_XB)});
}
#if MEGA
__global__ __launch_bounds__(512) void k_mega(Params p) {
    extern __shared__ __attribute__((aligned(16))) char shm[];
    cg::grid_group grid = cg::this_grid();
    volatile LAS unsigned* st = (volatile LAS unsigned*)(shm + SHM_B);
    if (threadIdx.x < 2) st[threadIdx.x] = 0u;
    __syncthreads();
    const XcdBarrier xb = xcd_barrier_post((unsigned*)(p.ws + OFF_BAR), st);
    if (p.ws == nullptr) grid.sync();
    do_phase<0>(p, shm); xcd_barrier(xb);
    do_phase<1>(p, shm); xcd_barrier(xb);
    do_phase<2>(p, shm); xcd_barrier(xb);
    do_phase<3>(p, shm); xcd_barrier(xb);
    do_phase<5>(p, shm); xcd_barrier(xb);
    do_phase<7>(p, shm); xcd_barrier(xb);
    do_phase<8>(p, shm); xcd_barrier(xb);
    do_phase<10>(p, shm);
}
#else
template <int PH> __global__ __launch_bounds__(512) void k_phase(Params p) {
    extern __shared__ __attribute__((aligned(16))) char shm[];
    do_phase<PH>(p, shm);
}
template <int PH> static void launch_phase(const Params& p, hipStream_t s) {
    static bool attr = false;
    if (!attr) { (void)hipFuncSetAttribute((const void*)k_phase<PH>, hipFuncAttributeMaxDynamicSharedMemorySize, SHM_B); attr = true; }
    hipLaunchKernelGGL(k_phase<PH>, dim3(256), dim3(512), SHM_B, s, p);
}
#endif

extern "C" void kernel_launch(void* const* d_in, const int* in_sizes, int n_in, void* d_out, int out_size, void* d_ws, size_t ws_size, hipStream_t stream) {
    Params p{};
    p.x = (const float*)d_in[0]; p.p = (const float*)d_in[1]; p.g_attn_pre = (const float*)d_in[2]; p.w_in = (const float*)d_in[3]; p.gamma = (const float*)d_in[4];
    p.g_hg = (const float*)d_in[5]; p.g_sb = (const float*)d_in[6]; p.w_out = (const float*)d_in[7]; p.g_attn_post = (const float*)d_in[8]; p.g_ffn_pre = (const float*)d_in[9];
    p.w_gu = (const float*)d_in[10]; p.w_down = (const float*)d_in[11]; p.g_ffn_post = (const float*)d_in[12]; p.w_pp = (const float*)d_in[13]; p.w_pg = (const float*)d_in[14];
    p.out = (float*)d_out; p.ws = (char*)d_ws;
#if MEGA
    static int grid_blocks = 0;
    if (!grid_blocks) {
        int dev = 0, cus = 0, per_cu = 0;
        (void)hipGetDevice(&dev); (void)hipDeviceGetAttribute(&cus, hipDeviceAttributeMultiprocessorCount, dev);
        (void)hipFuncSetAttribute((const void*)k_mega, hipFuncAttributeMaxDynamicSharedMemorySize, LDS_TOTAL);
        (void)hipOccupancyMaxActiveBlocksPerMultiprocessor(&per_cu, (const void*)k_mega, 512, LDS_TOTAL);
        if (per_cu < 1) per_cu = 1;
        grid_blocks = cus * per_cu;
    }
    (void)hipMemsetAsync((char*)d_ws + OFF_BAR, 0, CTL_BYTES, stream);
    void* args[] = {&p};
    hipError_t e = hipLaunchCooperativeKernel((const void*)k_mega, dim3(grid_blocks), dim3(512), args, LDS_TOTAL, stream);
    if (e != hipSuccess) fprintf(stderr, "cooperative launch failed: %s (grid %d)\n", hipGetErrorString(e), grid_blocks);
#else
    launch_phase<0>(p, stream); launch_phase<1>(p, stream); launch_phase<2>(p, stream); launch_phase<3>(p, stream); launch_phase<5>(p, stream);
    launch_phase<7>(p, stream); launch_phase<8>(p, stream); launch_phase<10>(p, stream);
#endif
}
```

```cpp
#include <hip/hip_runtime.h>
#include <hip/hip_cooperative_groups.h>
#include <cstdio>
#include <cstdint>
namespace cg = cooperative_groups;

#ifndef MEGA
#define MEGA 1
#endif

typedef unsigned short bf16_t;
typedef short bf16x8 __attribute__((ext_vector_type(8)));
typedef float f32x4 __attribute__((ext_vector_type(4)));
typedef unsigned u32x4 __attribute__((ext_vector_type(4)));
typedef unsigned u32x2 __attribute__((ext_vector_type(2)));

constexpr int NB = 8, NT = 4096, DM = 1024, MT = NB * NT;
constexpr int NIN = 3584, DFF = 2816, PLE = 256;
constexpr float EPS = 1e-6f;
constexpr float LOG2E = 1.4426950408889634f;

constexpr size_t MiB = 1ull << 20;
constexpr size_t OFF_WIN = 0;
constexpr size_t OFF_WOUT = 7 * MiB;
constexpr size_t OFF_WGU = 9 * MiB;
constexpr size_t OFF_WDN = 20 * MiB;
constexpr size_t OFF_WPP = 26 * MiB;
constexpr size_t OFF_WPG = 27 * MiB;
constexpr size_t OFF_RX = 30 * MiB;
constexpr size_t OFF_RH1 = 31 * MiB;
constexpr size_t OFF_LB = 32 * MiB;
constexpr size_t OFF_PB = 40 * MiB;
constexpr size_t OFF_XB = 56 * MiB;
constexpr size_t OFF_SQ = 120 * MiB;
constexpr size_t OFF_Y = 56 * MiB;
constexpr size_t OFF_QT = 216 * MiB;
constexpr size_t OFF_BC = 344 * MiB;
constexpr size_t OFF_ACT = 216 * MiB;
constexpr size_t OFF_H2B = 216 * MiB;
constexpr size_t OFF_PLE = 408 * MiB;
constexpr size_t OFF_SLOC = 472 * MiB;
constexpr size_t OFF_AMIX = 408 * MiB;
constexpr size_t OFF_PART1 = 35 * MiB;
constexpr size_t OFF_PART2 = 36 * MiB;
constexpr size_t OFF_PART3 = 37 * MiB;
constexpr size_t OFF_CNT = 34 * MiB + 16384;
constexpr size_t CTL_BYTES = 16384 + 2 * 128 * 64 * 4 + 256;
constexpr size_t OFF_BAR = 34 * MiB;
constexpr size_t OFF_DC = 33 * MiB;
constexpr size_t OFF_U = 56 * MiB;
constexpr size_t OFF_SC = 120 * MiB;
constexpr size_t OFF_VHT = 216 * MiB + 2 * (32 * MiB);
constexpr size_t OFF_SVT = 120 * MiB + 2 * (32 * MiB);
constexpr size_t SZ_HALF = 32 * MiB;

struct Params {
    const float *x, *p, *g_attn_pre, *w_in, *gamma, *g_hg, *g_sb, *w_out, *g_attn_post, *g_ffn_pre, *w_gu, *w_down, *g_ffn_post, *w_pp, *w_pg;
    float* out; char* ws;
};

typedef __bf16 bf2_t __attribute__((ext_vector_type(2)));
typedef float f32x2 __attribute__((ext_vector_type(2)));
typedef float f32x16 __attribute__((ext_vector_type(16)));
typedef _Float16 h16x2 __attribute__((ext_vector_type(2)));
__device__ __forceinline__ unsigned cvt_pk_f16(float lo, float hi) { f32x2 v = {lo, hi}; return __builtin_bit_cast(unsigned, __builtin_convertvector(v, h16x2)); }
__device__ __forceinline__ f32x2 unpk_f16(unsigned u) { return __builtin_convertvector(__builtin_bit_cast(h16x2, u), f32x2); }
__device__ __forceinline__ unsigned cvt_pk_bf16(float lo, float hi) { f32x2 v = {lo, hi}; return __builtin_bit_cast(unsigned, __builtin_convertvector(v, bf2_t)); }
__device__ __forceinline__ size_t vt_off(int ch, size_t tok) { return ((tok >> 6) * 512 + (size_t)ch) * 64 + (tok & 63); }
__device__ __forceinline__ float bf2f(bf16_t h) { return __uint_as_float(((unsigned)h) << 16); }
__device__ __forceinline__ float bflo(unsigned u) { return __uint_as_float(u << 16); }
__device__ __forceinline__ float bfhi(unsigned u) { return __uint_as_float(u & 0xffff0000u); }
__device__ __forceinline__ float fexp2(float x) { return __builtin_amdgcn_exp2f(x); }
__device__ __forceinline__ float frcp(float x) { return __builtin_amdgcn_rcpf(x); }
__device__ __forceinline__ float sigmoidf_(float x) { return frcp(1.0f + fexp2(-x * LOG2E)); }
__device__ __forceinline__ float siluf_(float x) { return x * sigmoidf_(x); }
__device__ __forceinline__ float wave_sum(float v) {
#pragma unroll
    for (int o = 32; o >= 1; o >>= 1) v += __shfl_xor(v, o);
    return v;
}

__device__ __forceinline__ int opaque_tid() { int t = threadIdx.x; asm volatile("" : "+v"(t)); return t; }

namespace pg8 {
#define PG8_LAS __attribute__((address_space(3)))
typedef unsigned short bf16_t;
typedef short bf16x8 __attribute__((ext_vector_type(8)));
typedef float f32x4 __attribute__((ext_vector_type(4)));
typedef unsigned u32x4 __attribute__((ext_vector_type(4)));
constexpr int BM = 256, BK = 64, HALF = 128, HTB = HALF * BK * 2  , STAGE_BYTES = 8 * HTB, NXCD = 8, WGM = 8;

__host__ __device__ __forceinline__ int lds_byte(int r, int c) { const int st = (r >> 4) * 2 + (c >> 5), rr = r & 15, cc = c & 31, ob = rr * 64 + cc * 2; return st * 1024 + (ob ^ (((ob >> 9) & 1) << 5)); }
__host__ __device__ __forceinline__ void stage_rc(int b, int& R, int& C) { const int st = b / 1024, sb = b % 1024, swz = sb ^ (((sb >> 9) & 1) << 5); R = (st >> 1) * 16 + swz / 64; C = (st & 1) * 32 + (swz % 64) / 2; }
__host__ __device__ __forceinline__ int perm32(int rho) { const int n = rho >> 4, i = rho & 15; return 8 * (i >> 2) + 4 * n + (i & 3); }

struct Unit { int pm, pn; };
struct Gemm { const bf16_t* A; const bf16_t* Bt; int M, N, K; };

struct StaticOrder {
    int nM, nN, nwg, G, c;
    __host__ __device__ void init(int M, int N, int G_, int c_) { nM = M / BM; nN = N / BM; nwg = nM * nN; G = G_; c = c_; }
    __host__ __device__ bool next(int i, Unit& u) const {
        const long L = (long)i * G + c; if (L >= nwg) return false;
        int wgid = (int)L; { const int q = nwg / NXCD, r = nwg % NXCD, xcd = wgid % NXCD, off = wgid / NXCD; wgid = (xcd < r ? xcd * (q + 1) : r * (q + 1) + (xcd - r) * q) + off; }
        const int nig = WGM * nN, gid = wgid / nig, fm = gid * WGM, gsz = (nM - fm) < WGM ? (nM - fm) : WGM;
        u.pm = fm + ((wgid % nig) % gsz); u.pn = (wgid % nig) / gsz; return true;
    }
    __device__ __forceinline__ void a_ready(const Unit&) const {}
    __device__ __forceinline__ void done(const Unit&) const {}
};
template <class Epi, class Sched, bool ALIGN_EPI = false, bool SP2 = false>
__device__ __forceinline__ void gemm_phase(PG8_LAS unsigned char* lds, const Gemm g, const Sched& S, const Epi& E) {
    const int tid = opaque_tid(), wid = __builtin_amdgcn_readfirstlane(tid >> 6), lane = tid & 63, wr = wid >> 2, wc = wid & 3, fr = lane & 15, fq = lane >> 4;
    const int K = g.K, nt = K / BK;
    unsigned voffA[2], voffB[2];
#pragma unroll
    for (int i = 0; i < 2; ++i) { int R, C; stage_rc(tid * 16 + i * 8192, R, C); const int Rb = Epi::PERM ? ((R & ~31) + perm32(R & 31)) : R;
        voffA[i] = (unsigned)(R * K + C) * 2u; voffB[i] = (unsigned)(Rb * K + C) * 2u; }
    const size_t kstep = (size_t)(BK * 2);
    const size_t hstep = (size_t)HALF * K * 2;
    const size_t tstep = 2 * hstep;
    const unsigned ldsw = (unsigned)wid * 1024u;
    const int aoff = lds_byte(wr * 64 + fr, fq * 8), boff = lds_byte(wc * 32 + fr, fq * 8);
#define PG8_SA(b, h) (((b) * 2 + (h)) * HTB)
#define PG8_SB(b, h) ((4 + (b) * 2 + (h)) * HTB)
#define PG8_STAGE(bufoff, gbase, voff) do { _Pragma("unroll") for (int _i = 0; _i < 2; ++_i) \
        __builtin_amdgcn_global_load_lds((const unsigned*)((const char*)(gbase) + (voff)[_i]), (PG8_LAS unsigned*)(lds + (bufoff) + ldsw + _i * 8192), 16, 0, 0); } while (0)
#define PG8_LDA(dst, b, h) do { _Pragma("unroll") for (int m = 0; m < 4; ++m) _Pragma("unroll") for (int k = 0; k < 2; ++k) dst[m][k] = *(const PG8_LAS bf16x8*)(lds + PG8_SA(b, h) + aoff + m * 2048 + k * 1024); } while (0)
#define PG8_LDB(dst, b, h) do { _Pragma("unroll") for (int n = 0; n < 2; ++n) _Pragma("unroll") for (int k = 0; k < 2; ++k) dst[n][k] = *(const PG8_LAS bf16x8*)(lds + PG8_SB(b, h) + boff + n * 2048 + k * 1024); } while (0)
#define PG8_MMA(ai, bj, At, Bt) do { __builtin_amdgcn_s_setprio(1); _Pragma("unroll") for (int m = 0; m < 4; ++m) _Pragma("unroll") for (int n = 0; n < 2; ++n) _Pragma("unroll") for (int k = 0; k < 2; ++k) \
        acc[ai][bj][m][n] = __builtin_amdgcn_mfma_f32_16x16x32_bf16(Bt[n][k], At[m][k], acc[ai][bj][m][n], 0, 0, 0); __builtin_amdgcn_s_setprio(0); } while (0)
#define PG8_WAIT_V(n) asm volatile("s_waitcnt vmcnt(" #n ")" ::: "memory")
#define PG8_WAIT_L(n) asm volatile("s_waitcnt lgkmcnt(" #n ")" ::: "memory")
#define PG8_BAR __builtin_amdgcn_s_barrier()
#define PG8_SCHED __builtin_amdgcn_sched_barrier(0)
    Unit cur, nxt; int ui = 0;
    if (!S.next(0, cur)) return;
    f32x4 acc[2][2][4][2];
#pragma unroll
    for (int a = 0; a < 2; ++a)
#pragma unroll
        for (int b = 0; b < 2; ++b)
#pragma unroll
            for (int m = 0; m < 4; ++m)
#pragma unroll
                for (int n = 0; n < 2; ++n) acc[a][b][m][n] = (f32x4){0.f, 0.f, 0.f, 0.f};
    bf16x8 At[4][2], B0[2][2], B1[2][2];
    const char* cA = (const char*)g.A + (size_t)cur.pm * tstep; const char* cB = (const char*)g.Bt + (size_t)cur.pn * tstep;
    S.a_ready(cur);
    if constexpr (Epi::MIDSCALE) E.load_mid(cur);
    typename Epi::Pre pre = {};
    if constexpr (Epi::ROWPRE) pre = E.pre_issue(cur);
    if constexpr (SP2) {
        PG8_STAGE(PG8_SB(0, 0), cB, voffB); PG8_STAGE(PG8_SB(0, 1), cB + hstep, voffB); PG8_STAGE(PG8_SA(0, 0), cA, voffA); PG8_STAGE(PG8_SA(0, 1), cA + hstep, voffA);
        if (wr == 1) PG8_BAR;
        PG8_WAIT_V(2); PG8_BAR;
        PG8_STAGE(PG8_SB(1, 0), cB + kstep, voffB); PG8_STAGE(PG8_SA(1, 0), cA + kstep, voffA); PG8_STAGE(PG8_SB(1, 1), cB + hstep + kstep, voffB);
        PG8_WAIT_V(6); PG8_BAR;
    } else {
        PG8_STAGE(PG8_SB(0, 0), cB, voffB); PG8_STAGE(PG8_SA(0, 0), cA, voffA); PG8_STAGE(PG8_SB(0, 1), cB + hstep, voffB); PG8_STAGE(PG8_SA(0, 1), cA + hstep, voffA);
        if (wr == 1) PG8_BAR;
        PG8_WAIT_V(4); PG8_BAR;
        PG8_STAGE(PG8_SB(1, 0), cB + kstep, voffB); PG8_STAGE(PG8_SA(1, 0), cA + kstep, voffA); PG8_STAGE(PG8_SB(1, 1), cB + hstep + kstep, voffB);
        PG8_WAIT_V(6); PG8_BAR;
    }
    for (;;) {
        const bool has_next = S.next(ui + 1, nxt);
        const char* nA = has_next ? (const char*)g.A + (size_t)nxt.pm * tstep : cA; const char* nB = has_next ? (const char*)g.Bt + (size_t)nxt.pn * tstep : cB;
        for (int t = 0; t < nt; t += 2) {
            const bool last = (t == nt - 2);
            const char* a1 = cA + (size_t)(t + 1) * kstep;
            const char* a2 = last ? nA : cA + (size_t)(t + 2) * kstep; const char* b2 = last ? nB : cB + (size_t)(t + 2) * kstep;
            const char* a3 = a2 + kstep; const char* b3 = b2 + kstep;
            if (last && has_next) S.a_ready(nxt);
            if constexpr (Epi::ROWPRE) { if (t == 8) E.pre_commit(pre); }
            if constexpr (Epi::MIDSCALE) { if (t == Epi::MID_T) {
_Pragma("unroll") for (int a = 0; a < 2; ++a) _Pragma("unroll") for (int m = 0; m < 4; ++m) { const float sc_ = E.mid_scale(a * HALF + wr * 64 + m * 16 + fr);
_Pragma("unroll") for (int b = 0; b < 2; ++b) _Pragma("unroll") for (int n = 0; n < 2; ++n) acc[a][b][m][n] = acc[a][b][m][n] * sc_; } } }
            if constexpr (SP2) {
            PG8_LDB(B0, 0, 0); PG8_LDB(B1, 0, 1); PG8_SCHED; PG8_LDA(At, 0, 0); PG8_STAGE(PG8_SA(1, 1), a1 + hstep, voffA);
            PG8_WAIT_V(8); PG8_WAIT_L(0); PG8_BAR; PG8_MMA(0, 0, At, B0); PG8_MMA(0, 1, At, B1); PG8_BAR; PG8_SCHED;
            PG8_LDA(At, 0, 1); PG8_STAGE(PG8_SB(0, 0), b2, voffB); PG8_STAGE(PG8_SB(0, 1), b2 + hstep, voffB); PG8_STAGE(PG8_SA(0, 0), a2, voffA);
            PG8_WAIT_V(8); PG8_WAIT_L(0); PG8_BAR; PG8_MMA(1, 0, At, B0); PG8_MMA(1, 1, At, B1); PG8_BAR; PG8_SCHED;
            PG8_LDB(B0, 1, 0); PG8_LDB(B1, 1, 1); PG8_SCHED; PG8_LDA(At, 1, 0); PG8_STAGE(PG8_SA(0, 1), a2 + hstep, voffA);
            PG8_WAIT_V(8); PG8_WAIT_L(0); PG8_BAR; PG8_MMA(0, 0, At, B0); PG8_MMA(0, 1, At, B1); PG8_BAR; PG8_SCHED;
            PG8_LDA(At, 1, 1); PG8_STAGE(PG8_SB(1, 0), b3, voffB); PG8_STAGE(PG8_SB(1, 1), b3 + hstep, voffB); PG8_STAGE(PG8_SA(1, 0), a3, voffA);
            PG8_WAIT_V(8); PG8_WAIT_L(0); PG8_BAR; PG8_MMA(1, 0, At, B0); PG8_MMA(1, 1, At, B1); PG8_BAR; PG8_SCHED;
            } else {
            PG8_LDB(B0, 0, 0); PG8_SCHED; PG8_LDA(At, 0, 0); PG8_STAGE(PG8_SA(1, 1), a1 + hstep, voffA);
            PG8_WAIT_L(8); PG8_BAR; PG8_WAIT_L(0); PG8_MMA(0, 0, At, B0); PG8_BAR; PG8_SCHED;
            PG8_LDB(B1, 0, 1); PG8_STAGE(PG8_SB(0, 0), b2, voffB);
            PG8_BAR; PG8_WAIT_L(0); PG8_MMA(0, 1, At, B1); PG8_BAR;
            PG8_LDA(At, 0, 1); PG8_STAGE(PG8_SA(0, 0), a2, voffA);
            PG8_BAR; PG8_WAIT_L(0); PG8_MMA(1, 0, At, B0); PG8_BAR; PG8_SCHED;
            PG8_STAGE(PG8_SB(0, 1), b2 + hstep, voffB);
            PG8_WAIT_V(6); PG8_BAR; PG8_MMA(1, 1, At, B1); PG8_BAR;
            PG8_LDB(B0, 1, 0); PG8_SCHED; PG8_LDA(At, 1, 0); PG8_STAGE(PG8_SA(0, 1), a2 + hstep, voffA);
            PG8_WAIT_L(8); PG8_BAR; PG8_WAIT_L(0); PG8_MMA(0, 0, At, B0); PG8_BAR; PG8_SCHED;
            PG8_LDB(B1, 1, 1); PG8_STAGE(PG8_SB(1, 0), b3, voffB);
            PG8_BAR; PG8_WAIT_L(0); PG8_MMA(0, 1, At, B1); PG8_BAR;
            PG8_LDA(At, 1, 1); PG8_STAGE(PG8_SA(1, 0), a3, voffA);
            PG8_BAR; PG8_WAIT_L(0); PG8_MMA(1, 0, At, B0); PG8_BAR; PG8_SCHED;
            PG8_STAGE(PG8_SB(1, 1), b3 + hstep, voffB);
            PG8_WAIT_V(6); PG8_BAR; PG8_MMA(1, 1, At, B1); PG8_BAR;
            }
        }
        if constexpr (ALIGN_EPI) { if (wr == 0) PG8_BAR; }
        if constexpr (!Epi::AFTER_DRAIN) { E(acc, cur, wr, wc, fr, fq); S.done(cur); }
        if (!has_next) break;
#pragma unroll
        for (int a = 0; a < 2; ++a)
#pragma unroll
            for (int b = 0; b < 2; ++b)
#pragma unroll
                for (int m = 0; m < 4; ++m)
#pragma unroll
                    for (int n = 0; n < 2; ++n) acc[a][b][m][n] = (f32x4){0.f, 0.f, 0.f, 0.f};
        cur = nxt; cA = nA; cB = nB; ++ui;
        if constexpr (Epi::MIDSCALE) E.load_mid(cur);
        if constexpr (Epi::ROWPRE) pre = E.pre_issue(cur);
        if constexpr (ALIGN_EPI) { if (wr == 1) PG8_BAR; }
    }
    PG8_WAIT_V(0);
    if constexpr (!ALIGN_EPI) { if (wr == 0) PG8_BAR; }
    PG8_BAR;
    if constexpr (Epi::AFTER_DRAIN) { E.fused(acc, cur, wr, wc, fr, fq, lds, wid, lane); S.done(cur); }
#undef PG8_SA
#undef PG8_SB
#undef PG8_STAGE
#undef PG8_LDA
#undef PG8_LDB
#undef PG8_MMA
#undef PG8_WAIT_V
#undef PG8_WAIT_L
#undef PG8_BAR
#undef PG8_SCHED
}
}

#define EPI_ARGS const f32x4 (&acc)[2][2][4][2], const pg8::Unit& u, int wr, int wc, int fr, int fq
#define EPI_HEAD static constexpr bool PERM = true, AFTER_DRAIN = false, MIDSCALE = false, ROWPRE = false; typedef int Pre;
#define EPI_HEAD_PRE(T) static constexpr bool PERM = true, AFTER_DRAIN = false, MIDSCALE = false, ROWPRE = true; typedef T Pre;
#define EPI_RC const int brow = u.pm * 256, bcol = u.pn * 256;
constexpr int HALF = 128, SHM_B = 131072, LDS_TOTAL = SHM_B + 16 + 4096 + 1024;
struct EpiIn {
    EPI_HEAD_PRE(float)
    const float* rx; char* ws; char* lds;
    __device__ __forceinline__ float pre_issue(const pg8::Unit& u) const { return threadIdx.x < 256 ? rx[u.pm * 256 + threadIdx.x] : 0.f; }
    __device__ __forceinline__ void pre_commit(float v) const { if (threadIdx.x < 256) ((float*)(lds + 4096))[threadIdx.x] = v; }
    __device__ __forceinline__ void operator()(EPI_ARGS) const { EPI_RC
        const int kind = bcol >> 9;
        const int lc0 = (bcol & 256) + wc * 32 + 8 * fq;
        bf16_t* dst = (bf16_t*)(ws + (kind == 0 ? OFF_QT : kind == 1 ? OFF_QT + SZ_HALF : kind == 2 ? OFF_QT + 3 * SZ_HALF : kind == 3 ? OFF_SQ : OFF_SQ + SZ_HALF));
        if (kind == 1) {
            float* dstf = (float*)(ws + OFF_BC); const float* lbp = (const float*)(ws + OFF_LB);
#pragma unroll
            for (int bj = 0; bj < 2; ++bj)
#pragma unroll
                for (int n = 0; n < 2; ++n) {
                    const f32x4 l0 = *(const f32x4*)(lbp + lc0 + bj * HALF + 4 * n), m0 = *(const f32x4*)(lbp + 512 + lc0 + bj * HALF + 4 * n);
                    float rsv[2][4];
#pragma unroll
                    for (int ai = 0; ai < 2; ++ai)
#pragma unroll
                        for (int m = 0; m < 4; ++m) rsv[ai][m] = ((const float*)(lds + 4096))[ai * HALF + wr * 64 + m * 16 + fr];
#pragma unroll
                    for (int ai = 0; ai < 2; ++ai)
#pragma unroll
                        for (int m = 0; m < 4; ++m) {
                            const int row = brow + ai * HALF + wr * 64 + m * 16 + fr; const float rs = rsv[ai][m];
                            const f32x4 z = acc[ai][bj][m][n] * rs; f32x4 lf;
#pragma unroll
                            for (int j = 0; j < 4; ++j) { const float s = sigmoidf_(z[j]); lf[j] = __builtin_amdgcn_logf(l0[j] + m0[j] * s)  ; }
                            const size_t o = (size_t)row * 512 + lc0 + bj * HALF + 4 * n;
                            u32x2 w; w.x = cvt_pk_f16(lf[0], lf[1]); w.y = cvt_pk_f16(lf[2], lf[3]); *(u32x2*)((unsigned short*)dstf + o) = w;
                        }
                }
            return;
        }
        float rsv[2][4];
#pragma unroll
        for (int ai = 0; ai < 2; ++ai)
#pragma unroll
            for (int m = 0; m < 4; ++m) rsv[ai][m] = ((const float*)(lds + 4096))[ai * HALF + wr * 64 + m * 16 + fr] * (kind == 3 ? 0.125f * LOG2E : 1.0f);
#pragma unroll
        for (int ai = 0; ai < 2; ++ai)
#pragma unroll
            for (int m = 0; m < 4; ++m) {
                const int row = brow + ai * HALF + wr * 64 + m * 16 + fr;
                const float rs = rsv[ai][m];
#pragma unroll
                for (int bj = 0; bj < 2; ++bj) {
                    f32x4 v0 = acc[ai][bj][m][0] * rs, v1 = acc[ai][bj][m][1] * rs;
                    if (kind == 0 || kind == 2) {
#pragma unroll
                        for (int j = 0; j < 4; ++j) { v0[j] = siluf_(v0[j]); v1[j] = siluf_(v1[j]); }
                    }
                    u32x4 w; w.x = cvt_pk_bf16(v0[0], v0[1]); w.y = cvt_pk_bf16(v0[2], v0[3]); w.z = cvt_pk_bf16(v1[0], v1[1]); w.w = cvt_pk_bf16(v1[2], v1[3]);
                    *(u32x4*)(dst + (size_t)row * 512 + lc0 + bj * HALF) = w;
                }
            }
    }
};
struct EpiVT {
    EPI_HEAD_PRE(float)
    const float* rx; char* ws; char* lds;
    __device__ __forceinline__ float pre_issue(const pg8::Unit& u) const { return threadIdx.x < 256 ? rx[u.pn * 256 + threadIdx.x] : 0.f; }
    __device__ __forceinline__ void pre_commit(float v) const { if (threadIdx.x < 256) ((float*)(lds + 4096))[threadIdx.x] = v; }
    __device__ __forceinline__ void operator()(EPI_ARGS) const { EPI_RC
        bf16_t* dst = (bf16_t*)(ws + (brow < 512 ? OFF_VHT : OFF_SVT));
        const int r0 = (brow & 511) + wr * 64 + fr, c0 = bcol + wc * 32 + 8 * fq;
#pragma unroll
        for (int bj = 0; bj < 2; ++bj) {
            const f32x4 s0 = *(const f32x4*)((const float*)(lds + 4096) + wc * 32 + 8 * fq + bj * HALF), s1 = *(const f32x4*)((const float*)(lds + 4096) + wc * 32 + 8 * fq + bj * HALF + 4);
#pragma unroll
            for (int ai = 0; ai < 2; ++ai)
#pragma unroll
                for (int m = 0; m < 4; ++m) {
                    const f32x4 v0 = acc[ai][bj][m][0] * s0, v1 = acc[ai][bj][m][1] * s1;
                    u32x4 w; w.x = cvt_pk_bf16(v0[0], v0[1]); w.y = cvt_pk_bf16(v0[2], v0[3]); w.z = cvt_pk_bf16(v1[0], v1[1]); w.w = cvt_pk_bf16(v1[2], v1[3]);
                    *(u32x4*)(dst + vt_off(r0 + ai * HALF + m * 16, (size_t)(c0 + bj * HALF))) = w;
                }
        }
    }
};
struct EpiF32 {
    EPI_HEAD
    float* C; int ldc;
    __device__ __forceinline__ void operator()(EPI_ARGS) const { EPI_RC
#pragma unroll
        for (int ai = 0; ai < 2; ++ai)
#pragma unroll
            for (int m = 0; m < 4; ++m) {
                float* rp = C + (size_t)(brow + ai * HALF + wr * 64 + m * 16 + fr) * ldc + bcol + wc * 32 + 8 * fq;
#pragma unroll
                for (int bj = 0; bj < 2; ++bj) { *(f32x4*)(rp + bj * HALF) = acc[ai][bj][m][0]; *(f32x4*)(rp + bj * HALF + 4) = acc[ai][bj][m][1]; }
            }
    }
};
struct EpiBf16 {
    EPI_HEAD
    bf16_t* C; int ldc;
    __device__ __forceinline__ void operator()(EPI_ARGS) const { EPI_RC
#pragma unroll
        for (int ai = 0; ai < 2; ++ai)
#pragma unroll
            for (int m = 0; m < 4; ++m) {
                bf16_t* rp = C + (size_t)(brow + ai * HALF + wr * 64 + m * 16 + fr) * ldc + bcol + wc * 32 + 8 * fq;
#pragma unroll
                for (int bj = 0; bj < 2; ++bj) {
                    const f32x4 v0 = acc[ai][bj][m][0], v1 = acc[ai][bj][m][1];
                    u32x4 w; w.x = cvt_pk_bf16(v0[0], v0[1]); w.y = cvt_pk_bf16(v0[2], v0[3]); w.z = cvt_pk_bf16(v1[0], v1[1]); w.w = cvt_pk_bf16(v1[2], v1[3]);
                    *(u32x4*)(rp + bj * HALF) = w;
                }
            }
    }
};
struct EpiAct {
    EPI_HEAD_PRE(f32x4)
    const float* rh; bf16_t* act; char* lds;
    __device__ __forceinline__ f32x4 pre_issue(const pg8::Unit& u) const { return threadIdx.x < 256 ? *(const f32x4*)(rh + (size_t)(u.pm * 256 + threadIdx.x) * 4) : (f32x4){0.f, 0.f, 0.f, 0.f}; }
    __device__ __forceinline__ void pre_commit(f32x4 q) const { if (threadIdx.x < 256) ((float*)(lds + 4096))[threadIdx.x] = rsqrtf(((q[0] + q[1]) + (q[2] + q[3])) * (1.0f / DM) + EPS); }
    __device__ __forceinline__ void operator()(EPI_ARGS) const { EPI_RC
        const int c0 = (bcol >> 1) + wc * 32 + 8 * fq;
        float rsv[2][4];
#pragma unroll
        for (int ai = 0; ai < 2; ++ai)
#pragma unroll
            for (int m = 0; m < 4; ++m) rsv[ai][m] = ((const float*)(lds + 4096))[ai * HALF + wr * 64 + m * 16 + fr];
#pragma unroll
        for (int ai = 0; ai < 2; ++ai)
#pragma unroll
            for (int m = 0; m < 4; ++m) {
                const int row = brow + ai * HALF + wr * 64 + m * 16 + fr;
                const float rs = rsv[ai][m];
                float o[8];
#pragma unroll
                for (int n = 0; n < 2; ++n)
#pragma unroll
                    for (int j = 0; j < 4; ++j) { const float g = acc[ai][0][m][n][j] * rs, u = acc[ai][1][m][n][j] * rs; o[n * 4 + j] = siluf_(g) * u; }
                u32x4 w; w.x = cvt_pk_bf16(o[0], o[1]); w.y = cvt_pk_bf16(o[2], o[3]); w.z = cvt_pk_bf16(o[4], o[5]); w.w = cvt_pk_bf16(o[6], o[7]);
                *(u32x4*)(act + (size_t)row * DFF + c0) = w;
            }
    }
};
struct EpiFinal {
    EPI_HEAD
    float* out; const bf16_t* ple; const bf16_t* h2;
    __device__ __forceinline__ void operator()(EPI_ARGS) const { EPI_RC
#pragma unroll
        for (int ai = 0; ai < 2; ++ai)
#pragma unroll
            for (int mp = 0; mp < 1; ++mp) {
                u32x4 pv[4][2], hv[4][2];
#pragma unroll
                for (int mm = 0; mm < 4; ++mm)
#pragma unroll
                    for (int bj = 0; bj < 2; ++bj) {
                        const size_t ro = (size_t)(brow + ai * HALF + wr * 64 + (4 * mp + mm) * 16 + fr) * DM + bcol + wc * 32 + 8 * fq + bj * HALF;
                        pv[mm][bj] = *(const u32x4*)(ple + ro); hv[mm][bj] = *(const u32x4*)(h2 + ro);
                    }
#pragma unroll
                for (int mm = 0; mm < 4; ++mm)
#pragma unroll
                    for (int bj = 0; bj < 2; ++bj) {
                        const int m = 4 * mp + mm;
                        const size_t ro = (size_t)(brow + ai * HALF + wr * 64 + m * 16 + fr) * DM + bcol + wc * 32 + 8 * fq + bj * HALF;
                        const f32x4 a0 = acc[ai][bj][m][0], a1 = acc[ai][bj][m][1]; const u32x4 q = pv[mm][bj], hq = hv[mm][bj]; f32x4 x0, x1;
                        x0[0] = bflo(hq.x) + bflo(q.x) * sigmoidf_(a0[0]); x0[1] = bfhi(hq.x) + bfhi(q.x) * sigmoidf_(a0[1]); x0[2] = bflo(hq.y) + bflo(q.y) * sigmoidf_(a0[2]); x0[3] = bfhi(hq.y) + bfhi(q.y) * sigmoidf_(a0[3]);
                        x1[0] = bflo(hq.z) + bflo(q.z) * sigmoidf_(a1[0]); x1[1] = bfhi(hq.z) + bfhi(q.z) * sigmoidf_(a1[1]); x1[2] = bflo(hq.w) + bflo(q.w) * sigmoidf_(a1[2]); x1[3] = bfhi(hq.w) + bfhi(q.w) * sigmoidf_(a1[3]);
                        *(f32x4*)(out + ro) = x0; *(f32x4*)(out + ro + 4) = x1;
                    }
            }
    }
};

template <int WHICH> struct EpiRes {
    static constexpr bool PERM = true, AFTER_DRAIN = false, MIDSCALE = (WHICH == 1), ROWPRE = false; typedef int Pre; static constexpr int MID_T = 8;
    const float* gain; bf16_t* hb; float* part; unsigned* cnt; float* part2; char* lds; const float* parth;
    __device__ __forceinline__ void load_mid(const pg8::Unit& u) const {
        if (threadIdx.x < 256) { const f32x4 q = *(const f32x4*)(parth + (size_t)(u.pm * 256 + threadIdx.x) * 4); ((float*)(lds + 4096))[threadIdx.x] = rsqrtf(((q[0] + q[1]) + (q[2] + q[3])) * (1.0f / 512) + EPS); }
    }
    __device__ __forceinline__ float mid_scale(int r) const { return ((const float*)(lds + 4096))[r]; }
    __device__ __forceinline__ void operator()(EPI_ARGS) const { EPI_RC
        float* red = (float*)lds; const int tid = threadIdx.x;
#pragma unroll
        for (int ai = 0; ai < 2; ++ai)
#pragma unroll
            for (int m = 0; m < 4; ++m) {
                float s = 0.f;
#pragma unroll
                for (int bj = 0; bj < 2; ++bj)
#pragma unroll
                    for (int n = 0; n < 2; ++n) { const f32x4 v = acc[ai][bj][m][n]; s += (v[0] * v[0] + v[1] * v[1]) + (v[2] * v[2] + v[3] * v[3]); }
                s += __shfl_xor(s, 16); s += __shfl_xor(s, 32);
                if (fq == 0) red[(ai * HALF + wr * 64 + m * 16 + fr) * 4 + wc] = s;
            }
        f32x4 g[2][2]; u32x4 bv[4][2];
#pragma unroll
        for (int bj = 0; bj < 2; ++bj) { g[bj][0] = *(const f32x4*)(gain + bcol + bj * HALF + wc * 32 + 8 * fq); g[bj][1] = *(const f32x4*)(gain + bcol + bj * HALF + wc * 32 + 8 * fq + 4); }
#pragma unroll
        for (int m = 0; m < 4; ++m)
#pragma unroll
            for (int bj = 0; bj < 2; ++bj) bv[m][bj] = *(const u32x4*)(hb + (size_t)(brow + wr * 64 + m * 16 + fr) * DM + bcol + bj * HALF + wc * 32 + 8 * fq);
        __syncthreads();
        if (tid < 256) { const f32x4 v = *(const f32x4*)(red + tid * 4); __hip_atomic_store(part + (size_t)(brow + tid) * 4 + u.pn, (v[0] + v[1]) + (v[2] + v[3]), __ATOMIC_RELAXED, __HIP_MEMORY_SCOPE_AGENT); }
        asm volatile("s_waitcnt vmcnt(0)" ::: "memory");
        __syncthreads();
        if (tid == 0) {
            unsigned* c = cnt + u.pm * 64;
            __hip_atomic_fetch_add(c, 1u, __ATOMIC_RELAXED, __HIP_MEMORY_SCOPE_AGENT);
            unsigned sp = 0;
            while (__hip_atomic_load(c, __ATOMIC_RELAXED, __HIP_MEMORY_SCOPE_AGENT) < 4u && ++sp < (1u << 20)) __builtin_amdgcn_s_sleep(1);
        }
        __syncthreads();
#pragma unroll
        for (int ai = 0; ai < 2; ++ai) {
            float pq[4][4];
#pragma unroll
            for (int m = 0; m < 4; ++m) {
                const float* pp = part + (size_t)(brow + ai * HALF + wr * 64 + m * 16 + fr) * 4;
#pragma unroll
                for (int q = 0; q < 4; ++q) pq[m][q] = __hip_atomic_load(pp + q, __ATOMIC_RELAXED, __HIP_MEMORY_SCOPE_AGENT);
            }
            if (ai == 1) {
#pragma unroll
                for (int m = 0; m < 4; ++m)
#pragma unroll
                    for (int bj = 0; bj < 2; ++bj) bv[m][bj] = *(const u32x4*)(hb + (size_t)(brow + HALF + wr * 64 + m * 16 + fr) * DM + bcol + bj * HALF + wc * 32 + 8 * fq);
            }
#pragma unroll
            for (int m = 0; m < 4; ++m) {
                float s2 = 0.f; const float r = rsqrtf(((pq[m][0] + pq[m][1]) + (pq[m][2] + pq[m][3])) * (1.0f / DM) + EPS);
#pragma unroll
                for (int bj = 0; bj < 2; ++bj) { const size_t ro = (size_t)(brow + ai * HALF + wr * 64 + m * 16 + fr) * DM + bcol + bj * HALF + wc * 32 + 8 * fq;
                    const u32x4 q = bv[m][bj]; const f32x4 b0 = {bflo(q.x), bfhi(q.x), bflo(q.y), bfhi(q.y)}, b1 = {bflo(q.z), bfhi(q.z), bflo(q.w), bfhi(q.w)};
                    f32x4 h0, h1;
#pragma unroll
                    for (int j = 0; j < 4; ++j) { h0[j] = b0[j] + acc[ai][bj][m][0][j] * r * g[bj][0][j]; h1[j] = b1[j] + acc[ai][bj][m][1][j] * r * g[bj][1][j]; s2 += h0[j] * h0[j] + h1[j] * h1[j]; }
                    u32x4 w; w.x = cvt_pk_bf16(h0[0], h0[1]); w.y = cvt_pk_bf16(h0[2], h0[3]); w.z = cvt_pk_bf16(h1[0], h1[1]); w.w = cvt_pk_bf16(h1[2], h1[3]);
                    *(u32x4*)(hb + ro) = w; }
                if (WHICH == 1) { s2 += __shfl_xor(s2, 16); s2 += __shfl_xor(s2, 32); if (fq == 0) red[(ai * HALF + wr * 64 + m * 16 + fr) * 4 + wc] = s2; }
            }
        }
        if (WHICH == 1) {
            __syncthreads();
            if (tid < 256) { const f32x4 v = *(const f32x4*)(red + tid * 4); part2[(size_t)(brow + tid) * 4 + u.pn] = (v[0] + v[1]) + (v[2] + v[3]); }
        }
    }
};

template <class Epi>
__device__ __forceinline__ void run_gemm(const bf16_t* A, const bf16_t* Bt, int M, int N, int K, char* shm, const Epi& epi) {
    asm volatile("" : "+s"(K));
    pg8::Gemm g{A, Bt, M, N, K}; pg8::StaticOrder S; S.init(M, N, (int)gridDim.x, (int)blockIdx.x);
    pg8::gemm_phase<Epi, pg8::StaticOrder, true, true>((PG8_LAS unsigned char*)shm, g, S, epi);
}

__device__ __forceinline__ int src_col(int r, int mode) {
    if (mode == 0) return r;
    if (mode == 2) { const int g = r >> 9; const int sg = g == 0 ? 0 : g == 1 ? 1 : g == 2 ? 3 : g == 3 ? 4 : g == 4 ? 5 : g == 5 ? 2 : 6; return sg * 512 + (r & 511); }
    const int tile = r >> 8, w = r & 255, bj = w >> 7, j = w & 127;
    return bj * DFF + tile * 128 + j;
}
__device__ void conv_weight(const float* __restrict__ W, int K, int ldw, bf16_t* __restrict__ Wt, int Nrows, int mode, const float* __restrict__ gain, float* lds, int vb, int nvb) {
    const int nk = K / 64, nr = Nrows / 256, tid = threadIdx.x;
    for (int it = vb; it < nk * nr; it += nvb) {
        const int k0 = (it % nk) * 64, r0 = (it / nk) * 256;
        f32x4 v[8];
        const int sc = src_col(r0 + (tid & 63) * 4, mode);
#pragma unroll
        for (int i = 0; i < 8; ++i) v[i] = *(const f32x4*)(W + (size_t)(k0 + (tid >> 6) + 8 * i) * ldw + sc);
        __syncthreads();
#pragma unroll
        for (int i = 0; i < 8; ++i) *(f32x4*)(lds + ((tid >> 6) + 8 * i) * 260 + (tid & 63) * 4) = v[i];
        __syncthreads();
#pragma unroll
        for (int j = 0; j < 4; ++j) {
            const int e = tid + 512 * j, r = e & 255, kg = e >> 8;
            float f[8];
#pragma unroll
            for (int i = 0; i < 8; ++i) { f[i] = lds[(8 * kg + i) * 260 + r]; if (gain) f[i] *= gain[k0 + 8 * kg + i]; }
            u32x4 w; w.x = cvt_pk_bf16(f[0], f[1]); w.y = cvt_pk_bf16(f[2], f[3]); w.z = cvt_pk_bf16(f[4], f[5]); w.w = cvt_pk_bf16(f[6], f[7]);
            *(u32x4*)(Wt + (size_t)(r0 + r) * K + k0 + 8 * kg) = w;
        }
    }
}
__device__ void phase0_rest(const Params& p, char* shm) {
    float* lds = (float*)shm; char* ws = p.ws;
    const int vb = blockIdx.x, nvb = gridDim.x;
    conv_weight(p.w_out, DM, DM, (bf16_t*)(ws + OFF_WOUT), DM, 0, nullptr, lds, vb, nvb);
    conv_weight(p.w_gu, DM, 2 * DFF, (bf16_t*)(ws + OFF_WGU), 2 * DFF, 1, p.g_ffn_pre, lds, vb, nvb);
    conv_weight(p.w_down, DFF, DM, (bf16_t*)(ws + OFF_WDN), DM, 0, nullptr, lds, vb, nvb);
    conv_weight(p.w_pp, PLE, DM, (bf16_t*)(ws + OFF_WPP), DM, 0, nullptr, lds, vb, nvb);
    conv_weight(p.w_pg, DM, DM, (bf16_t*)(ws + OFF_WPG), DM, 0, nullptr, lds, vb, nvb);
    __syncthreads();
    bf16_t* pb = (bf16_t*)(ws + OFF_PB);
    for (size_t i0 = (size_t)blockIdx.x * 512 + threadIdx.x; i0 < (size_t)MT * PLE / 4; i0 += (size_t)gridDim.x * 512 * 4) {
        f32x4 v[4];
#pragma unroll
        for (int j = 0; j < 4; ++j) { const size_t i = i0 + (size_t)j * gridDim.x * 512; if (i < (size_t)MT * PLE / 4) v[j] = __builtin_nontemporal_load((const f32x4*)(p.p + i * 4)); }
#pragma unroll
        for (int j = 0; j < 4; ++j) { const size_t i = i0 + (size_t)j * gridDim.x * 512; if (i < (size_t)MT * PLE / 4) { u32x2 w; w.x = cvt_pk_bf16(v[j][0], v[j][1]); w.y = cvt_pk_bf16(v[j][2], v[j][3]); *(u32x2*)(pb + i * 4) = w; } }
    }
    __syncthreads();
}
__device__ void phase0(const Params& p, char* shm) {
    float* lds = (float*)shm; char* ws = p.ws;
    const int vb = blockIdx.x, nvb = gridDim.x;
    conv_weight(p.w_in, DM, NIN, (bf16_t*)(ws + OFF_WIN), NIN, 2, p.g_attn_pre, lds, vb, nvb);
    if (blockIdx.x == 0) { float* lb = (float*)(ws + OFF_LB); const int c = threadIdx.x; const float l = sigmoidf_(p.gamma[c] - p.gamma[512 + c]); lb[c] = l; lb[512 + c] = 1.0f - l; }
    const int wid = threadIdx.x >> 6, lane = threadIdx.x & 63;
    bf16_t* xb = (bf16_t*)(ws + OFF_XB); float* rx = (float*)(ws + OFF_RX);
    for (int row0 = (blockIdx.x * 8 + wid) * 4; row0 < MT; row0 += gridDim.x * 32) {
        f32x4 v[4][4];
#pragma unroll
        for (int r = 0; r < 4; ++r)
#pragma unroll
            for (int i = 0; i < 4; ++i) v[r][i] = __builtin_nontemporal_load((const f32x4*)(p.x + (size_t)(row0 + r) * DM + i * 256 + lane * 4));
#pragma unroll
        for (int r = 0; r < 4; ++r) {
            float ss = 0.f;
#pragma unroll
            for (int i = 0; i < 4; ++i) { const f32x4 t = v[r][i]; ss += t[0] * t[0] + t[1] * t[1] + t[2] * t[2] + t[3] * t[3];
                u32x2 w; w.x = cvt_pk_bf16(t[0], t[1]); w.y = cvt_pk_bf16(t[2], t[3]); *(u32x2*)(xb + (size_t)(row0 + r) * DM + i * 256 + lane * 4) = w; }
            ss = wave_sum(ss);
            if (lane == 0) rx[row0 + r] = rsqrtf(ss * (1.0f / DM) + EPS);
        }
    }
}

template <int WHICH>
__device__ void phase_res(const Params& p) {
    char* ws = p.ws; const int wid = threadIdx.x >> 6, lane = threadIdx.x & 63;
    const float* src = (const float*)(ws + (WHICH == 1 ? OFF_QT : OFF_Y)); const float* base = WHICH == 1 ? p.x : p.out; const float* gn = WHICH == 1 ? p.g_attn_post : p.g_ffn_post;
    bf16_t* hb = (bf16_t*)(ws + (WHICH == 1 ? OFF_XB : OFF_H2B)); float* rh = (float*)(ws + OFF_RH1);
    f32x4 g[4];
#pragma unroll
    for (int i = 0; i < 4; ++i) g[i] = *(const f32x4*)(gn + i * 256 + lane * 4);
    for (int row0 = (blockIdx.x * 8 + wid) * 2; row0 < MT; row0 += gridDim.x * 16) {
        f32x4 mv[2][4], xv[2][4];
#pragma unroll
        for (int r = 0; r < 2; ++r)
#pragma unroll
            for (int i = 0; i < 4; ++i) { mv[r][i] = __builtin_nontemporal_load((const f32x4*)(src + (size_t)(row0 + r) * DM + i * 256 + lane * 4)); xv[r][i] = __builtin_nontemporal_load((const f32x4*)(base + (size_t)(row0 + r) * DM + i * 256 + lane * 4)); }
#pragma unroll
        for (int r = 0; r < 2; ++r) {
            float ss = 0.f;
#pragma unroll
            for (int i = 0; i < 4; ++i) ss += mv[r][i][0] * mv[r][i][0] + mv[r][i][1] * mv[r][i][1] + mv[r][i][2] * mv[r][i][2] + mv[r][i][3] * mv[r][i][3];
            ss = wave_sum(ss); const float rr = rsqrtf(ss * (1.0f / DM) + EPS); float s2 = 0.f;
#pragma unroll
            for (int i = 0; i < 4; ++i) { const int c = i * 256 + lane * 4; f32x4 h;
#pragma unroll
                for (int j = 0; j < 4; ++j) { h[j] = xv[r][i][j] + mv[r][i][j] * rr * g[i][j]; s2 += h[j] * h[j]; }
                *(f32x4*)(p.out + (size_t)(row0 + r) * DM + c) = h; u32x2 w; w.x = cvt_pk_bf16(h[0], h[1]); w.y = cvt_pk_bf16(h[2], h[3]); *(u32x2*)(hb + (size_t)(row0 + r) * DM + c) = w; }
            if (WHICH == 1) { s2 = wave_sum(s2); if (lane == 0) rh[row0 + r] = rsqrtf(s2 * (1.0f / DM) + EPS); }
        }
    }
}

#define MFMA32(a, b, c) __builtin_amdgcn_mfma_f32_32x32x16_bf16((a), (b), (c), 0, 0, 0)
#define MFMA16(a, b, c) __builtin_amdgcn_mfma_f32_16x16x32_bf16((a), (b), (c), 0, 0, 0)
__device__ __forceinline__ bf16x8 mk8(u32x2 a, u32x2 b) { u32x4 t; t.x = a.x; t.y = a.y; t.z = b.x; t.w = b.y; return __builtin_bit_cast(bf16x8, t); }
__device__ void phase_attn(const Params& p, char* shm, unsigned* queue) {
    char* ws = p.ws; const int tid = opaque_tid(), h = tid >> 6, lane = tid & 63, n = lane & 31, hh = lane >> 5;
    const bf16_t* SQ = (const bf16_t*)(ws + OFF_SQ); const bf16_t* SK = (const bf16_t*)(ws + OFF_SQ + SZ_HALF); const bf16_t* SVT = (const bf16_t*)(ws + OFF_SVT);
    bf16_t* am = (bf16_t*)(ws + OFF_AMIX); float* red = (float*)shm;
    int* itp = (int*)(shm + 2048);
    unsigned nxt_it = 0;
    if (threadIdx.x == 0) nxt_it = __hip_atomic_fetch_add(queue, 1u, __ATOMIC_RELAXED, __HIP_MEMORY_SCOPE_AGENT);
    for (;;) {
        __syncthreads();
        if (threadIdx.x == 0) { *itp = (int)nxt_it; if (nxt_it < NB * 128) nxt_it = __hip_atomic_fetch_add(queue, 1u, __ATOMIC_RELAXED, __HIP_MEMORY_SCOPE_AGENT); }
        __syncthreads();
        const int it0 = *itp; if (it0 >= NB * 128) break;
        const int it = NB * 128 - 1 - it0;
        const int b = it >> 7, qb = it & 127, t0 = qb * 32;
        const size_t tokq = (size_t)b * NT + t0 + n;
        bf16x8 qf[4];
#pragma unroll
        for (int ks = 0; ks < 4; ++ks) qf[ks] = *(const bf16x8*)(SQ + tokq * 512 + h * 64 + 16 * ks + 8 * hh);
        f32x16 o0, o1;
#pragma unroll
        for (int r = 0; r < 16; ++r) { o0[r] = 0.f; o1[r] = 0.f; }
        float R = 1.0f;
        bf16x8 kf[4]; u32x2 vf[2][2][2];
        const bf16_t* vbase = SVT + (size_t)(h * 64 + n) * 64 + 4 * hh;
        {
            const size_t tk = (size_t)b * NT + t0 + n;
#pragma unroll
            for (int ks = 0; ks < 4; ++ks) kf[ks] = *(const bf16x8*)(SK + tk * 512 + h * 64 + 16 * ks + 8 * hh);
#pragma unroll
            for (int db = 0; db < 2; ++db)
#pragma unroll
                for (int s = 0; s < 2; ++s)
#pragma unroll
                    for (int hf = 0; hf < 2; ++hf) vf[db][s][hf] = *(const u32x2*)(vbase + vt_off(0, (size_t)b * NT + t0) + db * 32 * 64 + 16 * s + 8 * hf);
        }
        for (int kb = qb; kb >= 0; --kb) {
            const int s1 = (kb > 0 ? kb - 1 : 0) * 32;
            bf16x8 kn[4]; u32x2 vn[2][2][2];
            {
                const size_t tk = (size_t)b * NT + s1 + n;
#pragma unroll
                for (int ks = 0; ks < 4; ++ks) kn[ks] = *(const bf16x8*)(SK + tk * 512 + h * 64 + 16 * ks + 8 * hh);
#pragma unroll
                for (int db = 0; db < 2; ++db)
#pragma unroll
                    for (int s = 0; s < 2; ++s)
#pragma unroll
                        for (int hf = 0; hf < 2; ++hf) vn[db][s][hf] = *(const u32x2*)(vbase + vt_off(0, (size_t)b * NT + s1) + db * 32 * 64 + 16 * s + 8 * hf);
            }
            f32x16 st;
#pragma unroll
            for (int r = 0; r < 16; ++r) st[r] = 0.f;
#pragma unroll
            for (int ks = 0; ks < 4; ++ks) st = MFMA32(kf[ks], qf[ks], st);
            float mm[16], be[16];
#pragma unroll
            for (int r = 0; r < 16; ++r) { const float e = fexp2(st[r]); mm[r] = frcp(1.0f + e); be[r] = 1.0f - mm[r]; }
            if (kb == qb) {
#pragma unroll
                for (int r = 0; r < 16; ++r) { const bool act = ((r & 3) + 8 * (r >> 2) + 4 * hh) < n; mm[r] = act ? mm[r] : 1.0f; be[r] = act ? be[r] : 0.0f; }
            }
            float go[4], gp[4], T[4];
#pragma unroll
            for (int g = 0; g < 4; ++g) { go[g] = (mm[4 * g] * mm[4 * g + 1]) * (mm[4 * g + 2] * mm[4 * g + 3]); gp[g] = __shfl_xor(go[g], 32); }
            T[3] = 1.0f; T[2] = go[3] * gp[3]; T[1] = T[2] * (go[2] * gp[2]); T[0] = T[1] * (go[1] * gp[1]);
            const float tot = T[0] * (go[0] * gp[0]);
            float aa[16];
#pragma unroll
            for (int g = 0; g < 4; ++g) {
                float x = R * T[g] * (hh == 0 ? gp[g] : 1.0f);
                aa[4 * g + 3] = be[4 * g + 3] * x; x *= mm[4 * g + 3];
                aa[4 * g + 2] = be[4 * g + 2] * x; x *= mm[4 * g + 2];
                aa[4 * g + 1] = be[4 * g + 1] * x; x *= mm[4 * g + 1];
                aa[4 * g + 0] = be[4 * g + 0] * x;
            }
            u32x4 p0, p1;
            p0.x = cvt_pk_bf16(aa[0], aa[1]); p0.y = cvt_pk_bf16(aa[2], aa[3]); p0.z = cvt_pk_bf16(aa[4], aa[5]); p0.w = cvt_pk_bf16(aa[6], aa[7]);
            p1.x = cvt_pk_bf16(aa[8], aa[9]); p1.y = cvt_pk_bf16(aa[10], aa[11]); p1.z = cvt_pk_bf16(aa[12], aa[13]); p1.w = cvt_pk_bf16(aa[14], aa[15]);
            const bf16x8 pf0 = __builtin_bit_cast(bf16x8, p0), pf1 = __builtin_bit_cast(bf16x8, p1);
            o0 = MFMA32(mk8(vf[0][0][0], vf[0][0][1]), pf0, o0); o0 = MFMA32(mk8(vf[0][1][0], vf[0][1][1]), pf1, o0);
            o1 = MFMA32(mk8(vf[1][0][0], vf[1][0][1]), pf0, o1); o1 = MFMA32(mk8(vf[1][1][0], vf[1][1][1]), pf1, o1);
            R *= tot;
            if (__ballot(R > 0.0f) == 0ull) break;
#pragma unroll
            for (int ks = 0; ks < 4; ++ks) kf[ks] = kn[ks];
#pragma unroll
            for (int db = 0; db < 2; ++db)
#pragma unroll
                for (int s = 0; s < 2; ++s) { vf[db][s][0] = vn[db][s][0]; vf[db][s][1] = vn[db][s][1]; }
        }
        float ss = 0.f;
#pragma unroll
        for (int r = 0; r < 16; ++r) ss += o0[r] * o0[r] + o1[r] * o1[r];
        ss += __shfl_xor(ss, 32);
        __syncthreads();
        if (hh == 0) red[h * 32 + n] = ss;
        __syncthreads();
        float tsum = 0.f;
#pragma unroll
        for (int w = 0; w < 8; ++w) tsum += red[w * 32 + n];
        const float rr = rsqrtf(tsum * (1.0f / 512) + EPS);
        f32x4 gwv[2][4];
#pragma unroll
        for (int db = 0; db < 2; ++db)
#pragma unroll
            for (int g = 0; g < 4; ++g) gwv[db][g] = *(const f32x4*)(p.g_sb + h * 64 + 32 * db + 8 * g + 4 * hh);
#pragma unroll
        for (int db = 0; db < 2; ++db)
#pragma unroll
            for (int g = 0; g < 4; ++g) {
                const int d0 = 32 * db + 8 * g + 4 * hh; const f32x4 gw = gwv[db][g];
                float v[4];
#pragma unroll
                for (int j = 0; j < 4; ++j) v[j] = (db == 0 ? o0[4 * g + j] : o1[4 * g + j]) * rr * gw[j];
                u32x2 w; w.x = cvt_pk_bf16(v[0], v[1]); w.y = cvt_pk_bf16(v[2], v[3]);
                *(u32x2*)(am + tokq * DM + 512 + h * 64 + d0) = w;
            }
    }
}

#define LDS_BAR() do { asm volatile("s_waitcnt lgkmcnt(0)" ::: "memory"); __builtin_amdgcn_s_barrier(); asm volatile("" ::: "memory"); } while (0)
constexpr int HSEG = 8, HCH = 64 / HSEG;
template <bool FULL>
__device__ void phase_hgseg(const Params& p, char* shm, int bh, int seg) {
    char* ws = p.ws; const int tid = opaque_tid(), w = tid >> 6, lane = tid & 63, fr = lane & 15, fq = lane >> 4, kp = tid & 63, r8 = tid >> 6;
    const int b = bh >> 2, h = bh & 3;
    const unsigned short* LF = (const unsigned short*)(ws + OFF_BC); const bf16_t* QT = (const bf16_t*)(ws + OFF_QT);
    const bf16_t* G = (const bf16_t*)(ws + OFF_QT + 3 * SZ_HALF); const bf16_t* VHT = (const bf16_t*)(ws + OFF_VHT);
    bf16_t* am = (bf16_t*)(ws + OFF_AMIX); float* parth = (float*)(ws + OFF_DC); float* SLOC = (float*)(ws + OFF_SLOC); float* DSEG = (float*)(ws + OFF_SLOC + 32 * MiB);
    float* qs = (float*)shm; float* dvec = (float*)(shm + 4096); float* red = (float*)(shm + 4608);
    char* sQs = shm + 8192; char* sQd = sQs + 17408; char* sKd = sQd + 17408; char* sP = sKd + 17408; char* keT = sP + 9216;
    f32x4 S[8];
#pragma unroll
    for (int kb = 0; kb < 8; ++kb) S[kb] = (f32x4){0.f, 0.f, 0.f, 0.f};
    f32x2 lfn[8]; unsigned qn[8]; bf16x8 vn[2]; u32x2 gn[4];
#define HG_LOAD(cc) do { const size_t _t0 = (size_t)b * NT + 64 * (cc); \
        _Pragma("unroll") for (int i = 0; i < 8; ++i) { const size_t a_ = (_t0 + 8 * r8 + i) * 512 + h * 128 + 2 * kp; lfn[i] = unpk_f16(*(const unsigned*)(LF + a_)); if (FULL) qn[i] = *(const unsigned*)(QT + a_); } \
        _Pragma("unroll") for (int ks = 0; ks < 2; ++ks) vn[ks] = *(const bf16x8*)(VHT + vt_off(h * 128 + 16 * w + fr, _t0) + 32 * ks + 8 * fq); \
        if (FULL) { _Pragma("unroll") for (int tb = 0; tb < 4; ++tb) gn[tb] = *(const u32x2*)(G + (_t0 + 16 * tb + fr) * 512 + h * 128 + 16 * w + 4 * fq); } } while (0)
    const int c0 = seg * HCH;
    HG_LOAD(c0);
    if (FULL) {
        for (int s = 0; s < seg; ++s) {
            const float* sl = SLOC + ((size_t)(bh * HSEG + s) * 128 + 16 * w + fr) * 128 + 4 * fq; const float* ds = DSEG + (size_t)(bh * HSEG + s) * 128 + 4 * fq;
            f32x4 lv[8], dv[8];
#pragma unroll
            for (int kb = 0; kb < 8; ++kb) { lv[kb] = *(const f32x4*)(sl + 16 * kb); dv[kb] = *(const f32x4*)(ds + 16 * kb); }
#pragma unroll
            for (int kb = 0; kb < 8; ++kb) S[kb] = S[kb] * dv[kb] + lv[kb];
        }
    }
    f32x4 gw = {0.f, 0.f, 0.f, 0.f};
    if (FULL) gw = *(const f32x4*)(p.g_hg + h * 128 + 16 * w + 4 * fq);
    float dsum0 = 0.f, dsum1 = 0.f;
    for (int ci = 0; ci < HCH; ++ci) {
        const int c = c0 + ci; const size_t tok0 = (size_t)b * NT + 64 * c;
        f32x2 lfv[8], kkv[8]; unsigned qv[8]; bf16x8 vfr[2]; u32x2 gv[4];
#pragma unroll
        for (int i = 0; i < 8; ++i) { lfv[i] = lfn[i]; kkv[i].x = 1.0f - fexp2(lfn[i].x); kkv[i].y = 1.0f - fexp2(lfn[i].y); if (FULL) qv[i] = qn[i]; }
        vfr[0] = vn[0]; vfr[1] = vn[1];
        if (FULL) {
#pragma unroll
            for (int tb = 0; tb < 4; ++tb) gv[tb] = gn[tb];
        }
        { const int cn = ci < HCH - 1 ? c + 1 : c; HG_LOAD(cn); }
        f32x2 run = {0.f, 0.f};
#pragma unroll
        for (int i = 0; i < 8; ++i) { run += lfv[i]; lfv[i] = run; }
        *(f32x2*)(qs + r8 * 128 + 2 * kp) = run;
        LDS_BAR();
        if (FULL && ci > 0 && tid < 64) { float s = 0.f;
#pragma unroll
            for (int ww = 0; ww < 8; ++ww) s += red[ww * 64 + tid];
            parth[(tok0 - 64 + tid) * 4 + h] = s; }
        f32x2 off = {0.f, 0.f}, bmid = {0.f, 0.f}, blast = {0.f, 0.f};
#pragma unroll
        for (int j = 0; j < 8; ++j) { const f32x2 q = *(const f32x2*)(qs + j * 128 + 2 * kp); if (j < r8) off += q; if (j < 4) bmid += q; blast += q; }
        if (r8 == 0) { f32x2 d; d.x = fexp2(blast.x); d.y = fexp2(blast.y); *(f32x2*)(dvec + 2 * kp) = d; dsum0 += blast.x; dsum1 += blast.y; }
        f32x2 emid, elast;
        emid.x = fexp2(bmid.x); emid.y = fexp2(bmid.y); elast.x = fexp2(blast.x - bmid.x); elast.y = fexp2(blast.y - bmid.y);
        float ke0[8], ke1[8];
#pragma unroll
        for (int i = 0; i < 8; ++i) {
            const int t = 8 * r8 + i; const f32x2 bb = off + lfv[i];
            const float k0 = kkv[i].x, k1 = kkv[i].y;
            const float f0 = fexp2(bmid.x - bb.x), f1 = fexp2(bmid.y - bb.y);
            const float kd0 = k0 * f0, kd1 = k1 * f1;
            ke0[i] = kd0 * elast.x; ke1[i] = kd1 * elast.y;
            if (FULL) {
                const float e0 = fexp2(bb.x - bmid.x), e1 = fexp2(bb.y - bmid.y);
                const float qd0 = bflo(qv[i]) * e0, qd1 = bfhi(qv[i]) * e1;
                *(unsigned*)(sQd + t * 272 + kp * 4) = cvt_pk_bf16(qd0, qd1);
                *(unsigned*)(sQs + t * 272 + kp * 4) = cvt_pk_bf16(qd0 * emid.x, qd1 * emid.y);
                *(unsigned*)(sKd + t * 272 + kp * 4) = cvt_pk_bf16(kd0, kd1);
            }
        }
        { u32x4 a0, a1;
          a0.x = cvt_pk_bf16(ke0[0], ke0[1]); a0.y = cvt_pk_bf16(ke0[2], ke0[3]); a0.z = cvt_pk_bf16(ke0[4], ke0[5]); a0.w = cvt_pk_bf16(ke0[6], ke0[7]);
          a1.x = cvt_pk_bf16(ke1[0], ke1[1]); a1.y = cvt_pk_bf16(ke1[2], ke1[3]); a1.z = cvt_pk_bf16(ke1[4], ke1[5]); a1.w = cvt_pk_bf16(ke1[6], ke1[7]);
          *(u32x4*)(keT + (2 * kp) * 144 + r8 * 16) = a0; *(u32x4*)(keT + (2 * kp + 1) * 144 + r8 * 16) = a1; }
        LDS_BAR();
        if (FULL) {
            {
                const int tb = w >> 1;
                bf16x8 qf[4], kf[2][4];
#pragma unroll
                for (int ks = 0; ks < 4; ++ks) { qf[ks] = *(const bf16x8*)(sQd + (16 * tb + fr) * 272 + 64 * ks + 16 * fq);
#pragma unroll
                    for (int u = 0; u < 2; ++u) kf[u][ks] = *(const bf16x8*)(sKd + (16 * (2 * (w & 1) + u) + fr) * 272 + 64 * ks + 16 * fq); }
                __builtin_amdgcn_sched_barrier(0);
#pragma unroll
                for (int u = 0; u < 2; ++u) {
                    const int sb = 2 * (w & 1) + u;
                    f32x4 acc = {0.f, 0.f, 0.f, 0.f};
                    if (sb <= tb) {
#pragma unroll
                        for (int ks = 0; ks < 4; ++ks) acc = MFMA16(kf[u][ks], qf[ks], acc);
                    }
                    const int t = 16 * tb + fr, s0 = 16 * sb + 4 * fq;
#pragma unroll
                    for (int j = 0; j < 4; ++j) acc[j] = (s0 + j <= t) ? acc[j] : 0.f;
                    u32x2 o; o.x = cvt_pk_bf16(acc[0], acc[1]); o.y = cvt_pk_bf16(acc[2], acc[3]);
                    *(u32x2*)(sP + t * 144 + s0 * 2) = o;
                }
            }
            LDS_BAR();
            bf16x8 sb16[4];
#pragma unroll
            for (int ks = 0; ks < 4; ++ks) { u32x4 t4; t4.x = cvt_pk_bf16(S[2 * ks][0], S[2 * ks][1]); t4.y = cvt_pk_bf16(S[2 * ks][2], S[2 * ks][3]); t4.z = cvt_pk_bf16(S[2 * ks + 1][0], S[2 * ks + 1][1]); t4.w = cvt_pk_bf16(S[2 * ks + 1][2], S[2 * ks + 1][3]); sb16[ks] = __builtin_bit_cast(bf16x8, t4); }
            bf16x8 qsf[4][4], pf[4][2];
#pragma unroll
            for (int tb = 0; tb < 4; ++tb) {
#pragma unroll
                for (int ks = 0; ks < 4; ++ks) { const u32x2 lo = *(const u32x2*)(sQs + (16 * tb + fr) * 272 + (32 * ks + 4 * fq) * 2), hi = *(const u32x2*)(sQs + (16 * tb + fr) * 272 + (32 * ks + 16 + 4 * fq) * 2); qsf[tb][ks] = mk8(lo, hi); }
#pragma unroll
                for (int ks = 0; ks < 2; ++ks) pf[tb][ks] = *(const bf16x8*)(sP + (16 * tb + fr) * 144 + 64 * ks + 16 * fq);
            }
            __builtin_amdgcn_sched_barrier(0);
#pragma unroll
            for (int tb = 0; tb < 4; ++tb) {
                f32x4 acc = {0.f, 0.f, 0.f, 0.f};
#pragma unroll
                for (int ks = 0; ks < 4; ++ks) acc = MFMA16(sb16[ks], qsf[tb][ks], acc);
#pragma unroll
                for (int ks = 0; ks < 2; ++ks) acc = MFMA16(vfr[ks], pf[tb][ks], acc);
                float s = (acc[0] * acc[0] + acc[1] * acc[1]) + (acc[2] * acc[2] + acc[3] * acc[3]);
                s += __shfl_xor(s, 16); s += __shfl_xor(s, 32);
                if (fq == 0) red[w * 64 + 16 * tb + fr] = s;
                const u32x2 g2 = gv[tb];
                u32x2 o; o.x = cvt_pk_bf16(acc[0] * gw[0] * bflo(g2.x), acc[1] * gw[1] * bfhi(g2.x)); o.y = cvt_pk_bf16(acc[2] * gw[2] * bflo(g2.y), acc[3] * gw[3] * bfhi(g2.y));
                *(u32x2*)(am + (tok0 + 16 * tb + fr) * DM + h * 128 + 16 * w + 4 * fq) = o;
            }
        }
#pragma unroll
        for (int kg = 0; kg < 2; ++kg) {
            f32x4 dd[4]; bf16x8 kf[4][2];
#pragma unroll
            for (int q = 0; q < 4; ++q) { const int kb = 4 * kg + q; dd[q] = *(const f32x4*)(dvec + 16 * kb + 4 * fq);
#pragma unroll
                for (int ks = 0; ks < 2; ++ks) kf[q][ks] = *(const bf16x8*)(keT + (16 * kb + fr) * 144 + 64 * ks + 16 * fq); }
            __builtin_amdgcn_sched_barrier(0);
#pragma unroll
            for (int q = 0; q < 4; ++q) { const int kb = 4 * kg + q;
                f32x4 acc = S[kb] * dd[q];
#pragma unroll
                for (int ks = 0; ks < 2; ++ks) acc = MFMA16(kf[q][ks], vfr[ks], acc);
                S[kb] = acc; }
        }
    }
    if (FULL) {
        __syncthreads();
        if (tid < 64) { float s = 0.f;
#pragma unroll
            for (int ww = 0; ww < 8; ++ww) s += red[ww * 64 + tid];
            parth[((size_t)b * NT + 64 * (c0 + HCH - 1) + tid) * 4 + h] = s; }
    } else {
#pragma unroll
        for (int kb = 0; kb < 8; ++kb) *(f32x4*)(SLOC + ((size_t)(bh * HSEG + seg) * 128 + 16 * w + fr) * 128 + 16 * kb + 4 * fq) = S[kb];
        if (r8 == 0) { f32x2 d; d.x = fexp2(dsum0); d.y = fexp2(dsum1); *(f32x2*)(DSEG + (size_t)(bh * HSEG + seg) * 128 + 2 * kp) = d; }
    }
    __syncthreads();
#undef HG_LOAD
}

#define XB_TMO      128
#define XB_XCNT(j)  (256  + 64 * (j))
#define XB_XSUB(j)  (1280 + 64 * (j))
#define XB_XGEN(j)  (2304 + 64 * (j))
#define XB_TOP      3328
#define XB_TOPGEN   3392
#define XCD_BAR_WORDS 3456
#define XB_SPIN_CAP (1u << 18)
#define LAS __attribute__((address_space(3)))

__device__ __forceinline__ unsigned xb_ld(unsigned* p)              { return __hip_atomic_load(p, __ATOMIC_RELAXED, __HIP_MEMORY_SCOPE_AGENT); }
__device__ __forceinline__ unsigned xb_add(unsigned* p, unsigned v) { return __hip_atomic_fetch_add(p, v, __ATOMIC_RELAXED, __HIP_MEMORY_SCOPE_AGENT); }
__device__ __forceinline__ unsigned xb_xcc_id() { return (unsigned)__builtin_amdgcn_s_getreg((3 << 11) | 20) & 0xFu; }
#define XB_SPIN(cond, bar) do { unsigned _sp = 0; while (cond) { __builtin_amdgcn_s_sleep(1); \
    if ((++_sp & 255u) == 0u) { if (xb_ld(&(bar)[XB_TMO])) break; if (_sp > XB_SPIN_CAP) { atomicAdd(&(bar)[XB_TMO], 1u); break; } } } } while (0)

struct XcdBarrier {
    unsigned* bar; unsigned x;
    volatile LAS unsigned* st;
};

__device__ __forceinline__ XcdBarrier xcd_barrier_post(unsigned* bar, volatile LAS unsigned* st) {
    XcdBarrier b; b.bar = bar; b.x = xb_xcc_id(); b.st = st;
    if (threadIdx.x == 0) (void)xb_add(&bar[XB_XCNT(b.x)], 1u);
    return b;
}
__device__ __forceinline__ void xcd_barrier_complete(unsigned* bar, unsigned x, unsigned& nloc, unsigned& nx) {
    const unsigned G = gridDim.x * gridDim.y * gridDim.z;
    unsigned sum, cnt, mine, sp = 0u;
    for (;;) {
        sum = 0u; cnt = 0u; mine = 0u;
#pragma unroll
        for (unsigned j = 0; j < 16; ++j) { const unsigned c = xb_ld(&bar[XB_XCNT(j)]); sum += c; cnt += (c > 0u) ? 1u : 0u; mine = (j == x) ? c : mine; }
        if (sum == G) break;
        __builtin_amdgcn_s_sleep(1);
        if ((++sp & 255u) == 0u) { if (xb_ld(&bar[XB_TMO])) break; if (sp > XB_SPIN_CAP) { atomicAdd(&bar[XB_TMO], 1u); break; } }
    }
    nloc = mine > 0u ? mine : 1u; nx = cnt > 0u ? cnt : 1u;
}

__device__ __forceinline__ void xcd_barrier(const XcdBarrier& b) {
    asm volatile("s_waitcnt vmcnt(0)" ::: "memory");
    __syncthreads();
    if (threadIdx.x == 0) {
        unsigned* bar = b.bar;
        __builtin_amdgcn_s_waitcnt(0);
        unsigned nloc = b.st[0], nx = b.st[1];
        if (nloc == 0u) { xcd_barrier_complete(bar, b.x, nloc, nx); b.st[0] = nloc; b.st[1] = nx; }
        const unsigned old = xb_add(&bar[XB_XSUB(b.x)], 1u);
        const unsigned gen = old / nloc;
        if (old + 1u == (gen + 1u) * nloc) {
            __builtin_amdgcn_fence(__ATOMIC_RELEASE, "agent");
            asm volatile("s_waitcnt vmcnt(0)" ::: "memory");
            const unsigned og = xb_add(&bar[XB_TOP], 1u);
            const unsigned tg = og / nx;
            if (og + 1u == (tg + 1u) * nx) xb_add(&bar[XB_TOPGEN], 1u);
            else XB_SPIN(xb_ld(&bar[XB_TOPGEN]) == tg, bar);
            __builtin_amdgcn_fence(__ATOMIC_ACQUIRE, "agent");
            xb_add(&bar[XB_XGEN(b.x)], 1u);
            asm volatile("s_waitcnt vmcnt(0)" ::: "memory");
        } else {
            XB_SPIN(xb_ld(&bar[XB_XGEN(b.x)]) == gen, bar);
            __builtin_amdgcn_fence(__ATOMIC_ACQUIRE, "agent");
            asm volatile("s_waitcnt vmcnt(0)" ::: "memory");
        }
    }
    __syncthreads();
}


template <int PH> __device__ __forceinline__ void do_phase(const Params& p, char* shm) {
    char* ws = p.ws; char* epl = shm + SHM_B + 16;
    if (PH == 0) phase0(p, shm);
    if (PH == 1) {
        if (blockIdx.x & 1) phase0_rest(p, shm);
        run_gemm((const bf16_t*)(ws + OFF_XB), (const bf16_t*)(ws + OFF_WIN), MT, 2560, DM, shm, EpiIn{(const float*)(ws + OFF_RX), ws, epl});
        run_gemm((const bf16_t*)(ws + OFF_WIN) + (size_t)2560 * DM, (const bf16_t*)(ws + OFF_XB), 1024, MT, DM, shm, EpiVT{(const float*)(ws + OFF_RX), ws, epl});
        if (!(blockIdx.x & 1)) phase0_rest(p, shm);
    }
    if (PH == 2) { for (int u = blockIdx.x; u < 32 * HSEG; u += gridDim.x) if ((u & (HSEG - 1)) != HSEG - 1) phase_hgseg<false>(p, shm, u / HSEG, u & (HSEG - 1));
                   phase_attn(p, shm, (unsigned*)(ws + OFF_CNT) + 2 * 128 * 64); }
    if (PH == 3) { for (int u = blockIdx.x; u < 32 * HSEG; u += gridDim.x) phase_hgseg<true>(p, shm, u / HSEG, u & (HSEG - 1)); }
    if (PH == 5) run_gemm((const bf16_t*)(ws + OFF_AMIX), (const bf16_t*)(ws + OFF_WOUT), MT, DM, DM, shm,
                          EpiRes<1>{p.g_attn_post, (bf16_t*)(ws + OFF_XB), (float*)(ws + OFF_PART1), (unsigned*)(ws + OFF_CNT), (float*)(ws + OFF_PART2), epl, (const float*)(ws + OFF_DC)});
    if (PH == 7) {
        const bool ple_first = ((blockIdx.x >> 3) & 1) != 0;
        if (ple_first) run_gemm((const bf16_t*)(ws + OFF_PB), (const bf16_t*)(ws + OFF_WPP), MT, DM, PLE, shm, EpiBf16{(bf16_t*)(ws + OFF_PLE), DM});
        run_gemm((const bf16_t*)(ws + OFF_XB), (const bf16_t*)(ws + OFF_WGU), MT, 2 * DFF, DM, shm, EpiAct{(const float*)(ws + OFF_PART2), (bf16_t*)(ws + OFF_ACT), epl});
        if (!ple_first) run_gemm((const bf16_t*)(ws + OFF_PB), (const bf16_t*)(ws + OFF_WPP), MT, DM, PLE, shm, EpiBf16{(bf16_t*)(ws + OFF_PLE), DM});
    }
    if (PH == 8) run_gemm((const bf16_t*)(ws + OFF_ACT), (const bf16_t*)(ws + OFF_WDN), MT, DM, DFF, shm,
                          EpiRes<2>{p.g_ffn_post, (bf16_t*)(ws + OFF_XB), (float*)(ws + OFF_PART3), (unsigned*)(ws + OFF_CNT) + 128 * 64, nullptr, epl, nullptr});
    if (PH == 10) run_gemm((const bf16_t*)(ws + OFF_XB), (const bf16_t*)(ws + OFF_WPG), MT, DM, DM, shm, EpiFinal{p.out, (const bf16_t*)(ws + OFF_PLE), (const bf16_t*)(ws + OFF_XB)});
}
#if MEGA
__global__ __launch_bounds__(512) void k_mega(Params p) {
    extern __shared__ __attribute__((aligned(16))) char shm[];
    cg::grid_group grid = cg::this_grid();
    volatile LAS unsigned* st = (volatile LAS unsigned*)(shm + SHM_B);
    if (threadIdx.x < 2) st[threadIdx.x] = 0u;
    __syncthreads();
    const XcdBarrier xb = xcd_barrier_post((unsigned*)(p.ws + OFF_BAR), st);
    if (p.ws == nullptr) grid.sync();
    do_phase<0>(p, shm); xcd_barrier(xb);
    do_phase<1>(p, shm); xcd_barrier(xb);
    do_phase<2>(p, shm); xcd_barrier(xb);
    do_phase<3>(p, shm); xcd_barrier(xb);
    do_phase<5>(p, shm); xcd_barrier(xb);
    do_phase<7>(p, shm); xcd_barrier(xb);
    do_phase<8>(p, shm); xcd_barrier(xb);
    do_phase<10>(p, shm);
}
#else
template <int PH> __global__ __launch_bounds__(512) void k_phase(Params p) {
    extern __shared__ __attribute__((aligned(16))) char shm[];
    do_phase<PH>(p, shm);
}
template <int PH> static void launch_phase(const Params& p, hipStream_t s) {
    static bool attr = false;
    if (!attr) { (void)hipFuncSetAttribute((const void*)k_phase<PH>, hipFuncAttributeMaxDynamicSharedMemorySize, SHM_B); attr = true; }
    hipLaunchKernelGGL(k_phase<PH>, dim3(256), dim3(512), SHM_B, s, p);
}
#endif

extern "C" void kernel_launch(void* const* d_in, const int* in_sizes, int n_in, void* d_out, int out_size, void* d_ws, size_t ws_size, hipStream_t stream) {
    Params p{};
    p.x = (const float*)d_in[0]; p.p = (const float*)d_in[1]; p.g_attn_pre = (const float*)d_in[2]; p.w_in = (const float*)d_in[3]; p.gamma = (const float*)d_in[4];
    p.g_hg = (const float*)d_in[5]; p.g_sb = (const float*)d_in[6]; p.w_out = (const float*)d_in[7]; p.g_attn_post = (const float*)d_in[8]; p.g_ffn_pre = (const float*)d_in[9];
    p.w_gu = (const float*)d_in[10]; p.w_down = (const float*)d_in[11]; p.g_ffn_post = (const float*)d_in[12]; p.w_pp = (const float*)d_in[13]; p.w_pg = (const float*)d_in[14];
    p.out = (float*)d_out; p.ws = (char*)d_ws;
#if MEGA
    static int grid_blocks = 0;
    if (!grid_blocks) {
        int dev = 0, cus = 0, per_cu = 0;
        (void)hipGetDevice(&dev); (void)hipDeviceGetAttribute(&cus, hipDeviceAttributeMultiprocessorCount, dev);
        (void)hipFuncSetAttribute((const void*)k_mega, hipFuncAttributeMaxDynamicSharedMemorySize, LDS_TOTAL);
        (void)hipOccupancyMaxActiveBlocksPerMultiprocessor(&per_cu, (const void*)k_mega, 512, LDS_TOTAL);
        if (per_cu < 1) per_cu = 1;
        grid_blocks = cus * per_cu;
    }
    (void)hipMemsetAsync((char*)d_ws + OFF_BAR, 0, CTL_BYTES, stream);
    void* args[] = {&p};
    hipError_t e = hipLaunchCooperativeKernel((const void*)k_mega, dim3(grid_blocks), dim3(512), args, LDS_TOTAL, stream);
    if (e != hipSuccess) fprintf(stderr, "cooperative launch failed: %s (grid %d)\n", hipGetErrorString(e), grid_blocks);
#else
    launch_phase<0>(p, stream); launch_phase<1>(p, stream); launch_phase<2>(p, stream); launch_phase<3>(p, stream); launch_phase<5>(p, stream);
    launch_phase<7>(p, stream); launch_phase<8>(p, stream); launch_phase<10>(p, stream);
#endif
}
```

```cpp
#include <hip/hip_runtime.h>
#include <hip/hip_cooperative_groups.h>
#include <cstdio>
#include <cstdint>
namespace cg = cooperative_groups;

#ifndef MEGA
#define MEGA 1
#endif

typedef unsigned short bf16_t;
typedef short bf16x8 __attribute__((ext_vector_type(8)));
typedef float f32x4 __attribute__((ext_vector_type(4)));
typedef unsigned u32x4 __attribute__((ext_vector_type(4)));
typedef unsigned u32x2 __attribute__((ext_vector_type(2)));

constexpr int NB = 8, NT = 4096, DM = 1024, MT = NB * NT;
constexpr int NIN = 3584, DFF = 2816, PLE = 256;
constexpr float EPS = 1e-6f;
constexpr float LOG2E = 1.4426950408889634f;

constexpr size_t MiB = 1ull << 20;
constexpr size_t OFF_WIN = 0;
constexpr size_t OFF_WOUT = 7 * MiB;
constexpr size_t OFF_WGU = 9 * MiB;
constexpr size_t OFF_WDN = 20 * MiB;
constexpr size_t OFF_WPP = 26 * MiB;
constexpr size_t OFF_WPG = 27 * MiB;
constexpr size_t OFF_RX = 30 * MiB;
constexpr size_t OFF_RH1 = 31 * MiB;
constexpr size_t OFF_LB = 32 * MiB;
constexpr size_t OFF_PB = 40 * MiB;
constexpr size_t OFF_XB = 56 * MiB;
constexpr size_t OFF_SQ = 120 * MiB;
constexpr size_t OFF_Y = 56 * MiB;
constexpr size_t OFF_QT = 216 * MiB;
constexpr size_t OFF_BC = 344 * MiB;
constexpr size_t OFF_ACT = 216 * MiB;
constexpr size_t OFF_H2B = 216 * MiB;
constexpr size_t OFF_PLE = 408 * MiB;
constexpr size_t OFF_SLOC = 472 * MiB;
constexpr size_t OFF_AMIX = 408 * MiB;
constexpr size_t OFF_PART1 = 35 * MiB;
constexpr size_t OFF_PART2 = 36 * MiB;
constexpr size_t OFF_PART3 = 37 * MiB;
constexpr size_t OFF_CNT = 34 * MiB + 16384;
constexpr size_t CTL_BYTES = 16384 + 2 * 128 * 64 * 4 + 256;
constexpr size_t OFF_BAR = 34 * MiB;
constexpr size_t OFF_DC = 33 * MiB;
constexpr size_t OFF_U = 56 * MiB;
constexpr size_t OFF_SC = 120 * MiB;
constexpr size_t OFF_VHT = 216 * MiB + 2 * (32 * MiB);
constexpr size_t OFF_SVT = 120 * MiB + 2 * (32 * MiB);
constexpr size_t SZ_HALF = 32 * MiB;

struct Params {
    const float *x, *p, *g_attn_pre, *w_in, *gamma, *g_hg, *g_sb, *w_out, *g_attn_post, *g_ffn_pre, *w_gu, *w_down, *g_ffn_post, *w_pp, *w_pg;
    float* out; char* ws;
};

typedef __bf16 bf2_t __attribute__((ext_vector_type(2)));
typedef float f32x2 __attribute__((ext_vector_type(2)));
typedef float f32x16 __attribute__((ext_vector_type(16)));
typedef _Float16 h16x2 __attribute__((ext_vector_type(2)));
__device__ __forceinline__ unsigned cvt_pk_f16(float lo, float hi) { f32x2 v = {lo, hi}; return __builtin_bit_cast(unsigned, __builtin_convertvector(v, h16x2)); }
__device__ __forceinline__ f32x2 unpk_f16(unsigned u) { return __builtin_convertvector(__builtin_bit_cast(h16x2, u), f32x2); }
__device__ __forceinline__ unsigned cvt_pk_bf16(float lo, float hi) { f32x2 v = {lo, hi}; return __builtin_bit_cast(unsigned, __builtin_convertvector(v, bf2_t)); }
__device__ __forceinline__ size_t vt_off(int ch, size_t tok) { return ((tok >> 6) * 512 + (size_t)ch) * 64 + (tok & 63); }
__device__ __forceinline__ float bf2f(bf16_t h) { return __uint_as_float(((unsigned)h) << 16); }
__device__ __forceinline__ float bflo(unsigned u) { return __uint_as_float(u << 16); }
__device__ __forceinline__ float bfhi(unsigned u) { return __uint_as_float(u & 0xffff0000u); }
__device__ __forceinline__ float fexp2(float x) { return __builtin_amdgcn_exp2f(x); }
__device__ __forceinline__ float frcp(float x) { return __builtin_amdgcn_rcpf(x); }
__device__ __forceinline__ float sigmoidf_(float x) { return frcp(1.0f + fexp2(-x * LOG2E)); }
__device__ __forceinline__ float siluf_(float x) { return x * sigmoidf_(x); }
__device__ __forceinline__ float wave_sum(float v) {
#pragma unroll
    for (int o = 32; o >= 1; o >>= 1) v += __shfl_xor(v, o);
    return v;
}

__device__ __forceinline__ int opaque_tid() { int t = threadIdx.x; asm volatile("" : "+v"(t)); return t; }

namespace pg8 {
#define PG8_LAS __attribute__((address_space(3)))
typedef unsigned short bf16_t;
typedef short bf16x8 __attribute__((ext_vector_type(8)));
typedef float f32x4 __attribute__((ext_vector_type(4)));
typedef unsigned u32x4 __attribute__((ext_vector_type(4)));
constexpr int BM = 256, BK = 64, HALF = 128, HTB = HALF * BK * 2  , STAGE_BYTES = 8 * HTB, NXCD = 8, WGM = 8;

__host__ __device__ __forceinline__ int lds_byte(int r, int c) { const int st = (r >> 4) * 2 + (c >> 5), rr = r & 15, cc = c & 31, ob = rr * 64 + cc * 2; return st * 1024 + (ob ^ (((ob >> 9) & 1) << 5)); }
__host__ __device__ __forceinline__ void stage_rc(int b, int& R, int& C) { const int st = b / 1024, sb = b % 1024, swz = sb ^ (((sb >> 9) & 1) << 5); R = (st >> 1) * 16 + swz / 64; C = (st & 1) * 32 + (swz % 64) / 2; }
__host__ __device__ __forceinline__ int perm32(int rho) { const int n = rho >> 4, i = rho & 15; return 8 * (i >> 2) + 4 * n + (i & 3); }

struct Unit { int pm, pn; };
struct Gemm { const bf16_t* A; const bf16_t* Bt; int M, N, K; };

struct StaticOrder {
    int nM, nN, nwg, G, c;
    __host__ __device__ void init(int M, int N, int G_, int c_) { nM = M / BM; nN = N / BM; nwg = nM * nN; G = G_; c = c_; }
    __host__ __device__ bool next(int i, Unit& u) const {
        const long L = (long)i * G + c; if (L >= nwg) return false;
        int wgid = (int)L; { const int q = nwg / NXCD, r = nwg % NXCD, xcd = wgid % NXCD, off = wgid / NXCD; wgid = (xcd < r ? xcd * (q + 1) : r * (q + 1) + (xcd - r) * q) + off; }
        const int nig = WGM * nN, gid = wgid / nig, fm = gid * WGM, gsz = (nM - fm) < WGM ? (nM - fm) : WGM;
        u.pm = fm + ((wgid % nig) % gsz); u.pn = (wgid % nig) / gsz; return true;
    }
    __device__ __forceinline__ void a_ready(const Unit&) const {}
    __device__ __forceinline__ void done(const Unit&) const {}
};
template <class Epi, class Sched, bool ALIGN_EPI = false, bool SP2 = false>
__device__ __forceinline__ void gemm_phase(PG8_LAS unsigned char* lds, const Gemm g, const Sched& S, const Epi& E) {
    const int tid = opaque_tid(), wid = __builtin_amdgcn_readfirstlane(tid >> 6), lane = tid & 63, wr = wid >> 2, wc = wid & 3, fr = lane & 15, fq = lane >> 4;
    const int K = g.K, nt = K / BK;
    unsigned voffA[2], voffB[2];
#pragma unroll
    for (int i = 0; i < 2; ++i) { int R, C; stage_rc(tid * 16 + i * 8192, R, C); const int Rb = Epi::PERM ? ((R & ~31) + perm32(R & 31)) : R;
        voffA[i] = (unsigned)(R * K + C) * 2u; voffB[i] = (unsigned)(Rb * K + C) * 2u; }
    const size_t kstep = (size_t)(BK * 2);
    const size_t hstep = (size_t)HALF * K * 2;
    const size_t tstep = 2 * hstep;
    const unsigned ldsw = (unsigned)wid * 1024u;
    const int aoff = lds_byte(wr * 64 + fr, fq * 8), boff = lds_byte(wc * 32 + fr, fq * 8);
#define PG8_SA(b, h) (((b) * 2 + (h)) * HTB)
#define PG8_SB(b, h) ((4 + (b) * 2 + (h)) * HTB)
#define PG8_STAGE(bufoff, gbase, voff) do { _Pragma("unroll") for (int _i = 0; _i < 2; ++_i) \
        __builtin_amdgcn_global_load_lds((const unsigned*)((const char*)(gbase) + (voff)[_i]), (PG8_LAS unsigned*)(lds + (bufoff) + ldsw + _i * 8192), 16, 0, 0); } while (0)
#define PG8_LDA(dst, b, h) do { _Pragma("unroll") for (int m = 0; m < 4; ++m) _Pragma("unroll") for (int k = 0; k < 2; ++k) dst[m][k] = *(const PG8_LAS bf16x8*)(lds + PG8_SA(b, h) + aoff + m * 2048 + k * 1024); } while (0)
#define PG8_LDB(dst, b, h) do { _Pragma("unroll") for (int n = 0; n < 2; ++n) _Pragma("unroll") for (int k = 0; k < 2; ++k) dst[n][k] = *(const PG8_LAS bf16x8*)(lds + PG8_SB(b, h) + boff + n * 2048 + k * 1024); } while (0)
#define PG8_MMA(ai, bj, At, Bt) do { __builtin_amdgcn_s_setprio(1); _Pragma("unroll") for (int m = 0; m < 4; ++m) _Pragma("unroll") for (int n = 0; n < 2; ++n) _Pragma("unroll") for (int k = 0; k < 2; ++k) \
        acc[ai][bj][m][n] = __builtin_amdgcn_mfma_f32_16x16x32_bf16(Bt[n][k], At[m][k], acc[ai][bj][m][n], 0, 0, 0); __builtin_amdgcn_s_setprio(0); } while (0)
#define PG8_WAIT_V(n) asm volatile("s_waitcnt vmcnt(" #n ")" ::: "memory")
#define PG8_WAIT_L(n) asm volatile("s_waitcnt lgkmcnt(" #n ")" ::: "memory")
#define PG8_BAR __builtin_amdgcn_s_barrier()
#define PG8_SCHED __builtin_amdgcn_sched_barrier(0)
    Unit cur, nxt; int ui = 0;
    if (!S.next(0, cur)) return;
    f32x4 acc[2][2][4][2];
#pragma unroll
    for (int a = 0; a < 2; ++a)
#pragma unroll
        for (int b = 0; b < 2; ++b)
#pragma unroll
            for (int m = 0; m < 4; ++m)
#pragma unroll
                for (int n = 0; n < 2; ++n) acc[a][b][m][n] = (f32x4){0.f, 0.f, 0.f, 0.f};
    bf16x8 At[4][2], B0[2][2], B1[2][2];
    const char* cA = (const char*)g.A + (size_t)cur.pm * tstep; const char* cB = (const char*)g.Bt + (size_t)cur.pn * tstep;
    S.a_ready(cur);
    if constexpr (Epi::MIDSCALE) E.load_mid(cur);
    typename Epi::Pre pre = {};
    if constexpr (Epi::ROWPRE) pre = E.pre_issue(cur);
    if constexpr (SP2) {
        PG8_STAGE(PG8_SB(0, 0), cB, voffB); PG8_STAGE(PG8_SB(0, 1), cB + hstep, voffB); PG8_STAGE(PG8_SA(0, 0), cA, voffA); PG8_STAGE(PG8_SA(0, 1), cA + hstep, voffA);
        if (wr == 1) PG8_BAR;
        PG8_WAIT_V(2); PG8_BAR;
        PG8_STAGE(PG8_SB(1, 0), cB + kstep, voffB); PG8_STAGE(PG8_SA(1, 0), cA + kstep, voffA); PG8_STAGE(PG8_SB(1, 1), cB + hstep + kstep, voffB);
        PG8_WAIT_V(6); PG8_BAR;
    } else {
        PG8_STAGE(PG8_SB(0, 0), cB, voffB); PG8_STAGE(PG8_SA(0, 0), cA, voffA); PG8_STAGE(PG8_SB(0, 1), cB + hstep, voffB); PG8_STAGE(PG8_SA(0, 1), cA + hstep, voffA);
        if (wr == 1) PG8_BAR;
        PG8_WAIT_V(4); PG8_BAR;
        PG8_STAGE(PG8_SB(1, 0), cB + kstep, voffB); PG8_STAGE(PG8_SA(1, 0), cA + kstep, voffA); PG8_STAGE(PG8_SB(1, 1), cB + hstep + kstep, voffB);
        PG8_WAIT_V(6); PG8_BAR;
    }
    for (;;) {
        const bool has_next = S.next(ui + 1, nxt);
        const char* nA = has_next ? (const char*)g.A + (size_t)nxt.pm * tstep : cA; const char* nB = has_next ? (const char*)g.Bt + (size_t)nxt.pn * tstep : cB;
        for (int t = 0; t < nt; t += 2) {
            const bool last = (t == nt - 2);
            const char* a1 = cA + (size_t)(t + 1) * kstep;
            const char* a2 = last ? nA : cA + (size_t)(t + 2) * kstep; const char* b2 = last ? nB : cB + (size_t)(t + 2) * kstep;
            const char* a3 = a2 + kstep; const char* b3 = b2 + kstep;
            if (last && has_next) S.a_ready(nxt);
            if constexpr (Epi::ROWPRE) { if (t == 8) E.pre_commit(pre); }
            if constexpr (Epi::MIDSCALE) { if (t == Epi::MID_T) {
_Pragma("unroll") for (int a = 0; a < 2; ++a) _Pragma("unroll") for (int m = 0; m < 4; ++m) { const float sc_ = E.mid_scale(a * HALF + wr * 64 + m * 16 + fr);
_Pragma("unroll") for (int b = 0; b < 2; ++b) _Pragma("unroll") for (int n = 0; n < 2; ++n) acc[a][b][m][n] = acc[a][b][m][n] * sc_; } } }
            if constexpr (SP2) {
            PG8_LDB(B0, 0, 0); PG8_LDB(B1, 0, 1); PG8_SCHED; PG8_LDA(At, 0, 0); PG8_STAGE(PG8_SA(1, 1), a1 + hstep, voffA);
            PG8_WAIT_V(8); PG8_WAIT_L(0); PG8_BAR; PG8_MMA(0, 0, At, B0); PG8_MMA(0, 1, At, B1); PG8_BAR; PG8_SCHED;
            PG8_LDA(At, 0, 1); PG8_STAGE(PG8_SB(0, 0), b2, voffB); PG8_STAGE(PG8_SB(0, 1), b2 + hstep, voffB); PG8_STAGE(PG8_SA(0, 0), a2, voffA);
            PG8_WAIT_V(8); PG8_WAIT_L(0); PG8_BAR; PG8_MMA(1, 0, At, B0); PG8_MMA(1, 1, At, B1); PG8_BAR; PG8_SCHED;
            PG8_LDB(B0, 1, 0); PG8_LDB(B1, 1, 1); PG8_SCHED; PG8_LDA(At, 1, 0); PG8_STAGE(PG8_SA(0, 1), a2 + hstep, voffA);
            PG8_WAIT_V(8); PG8_WAIT_L(0); PG8_BAR; PG8_MMA(0, 0, At, B0); PG8_MMA(0, 1, At, B1); PG8_BAR; PG8_SCHED;
            PG8_LDA(At, 1, 1); PG8_STAGE(PG8_SB(1, 0), b3, voffB); PG8_STAGE(PG8_SB(1, 1), b3 + hstep, voffB); PG8_STAGE(PG8_SA(1, 0), a3, voffA);
            PG8_WAIT_V(8); PG8_WAIT_L(0); PG8_BAR; PG8_MMA(1, 0, At, B0); PG8_MMA(1, 1, At, B1); PG8_BAR; PG8_SCHED;
            } else {
            PG8_LDB(B0, 0, 0); PG8_SCHED; PG8_LDA(At, 0, 0); PG8_STAGE(PG8_SA(1, 1), a1 + hstep, voffA);
            PG8_WAIT_L(8); PG8_BAR; PG8_WAIT_L(0); PG8_MMA(0, 0, At, B0); PG8_BAR; PG8_SCHED;
            PG8_LDB(B1, 0, 1); PG8_STAGE(PG8_SB(0, 0), b2, voffB);
            PG8_BAR; PG8_WAIT_L(0); PG8_MMA(0, 1, At, B1); PG8_BAR;
            PG8_LDA(At, 0, 1); PG8_STAGE(PG8_SA(0, 0), a2, voffA);
            PG8_BAR; PG8_WAIT_L(0); PG8_MMA(1, 0, At, B0); PG8_BAR; PG8_SCHED;
            PG8_STAGE(PG8_SB(0, 1), b2 + hstep, voffB);
            PG8_WAIT_V(6); PG8_BAR; PG8_MMA(1, 1, At, B1); PG8_BAR;
            PG8_LDB(B0, 1, 0); PG8_SCHED; PG8_LDA(At, 1, 0); PG8_STAGE(PG8_SA(0, 1), a2 + hstep, voffA);
            PG8_WAIT_L(8); PG8_BAR; PG8_WAIT_L(0); PG8_MMA(0, 0, At, B0); PG8_BAR; PG8_SCHED;
            PG8_LDB(B1, 1, 1); PG8_STAGE(PG8_SB(1, 0), b3, voffB);
            PG8_BAR; PG8_WAIT_L(0); PG8_MMA(0, 1, At, B1); PG8_BAR;
            PG8_LDA(At, 1, 1); PG8_STAGE(PG8_SA(1, 0), a3, voffA);
            PG8_BAR; PG8_WAIT_L(0); PG8_MMA(1, 0, At, B0); PG8_BAR; PG8_SCHED;
            PG8_STAGE(PG8_SB(1, 1), b3 + hstep, voffB);
            PG8_WAIT_V(6); PG8_BAR; PG8_MMA(1, 1, At, B1); PG8_BAR;
            }
        }
        if constexpr (ALIGN_EPI) { if (wr == 0) PG8_BAR; }
        if constexpr (!Epi::AFTER_DRAIN) { E(acc, cur, wr, wc, fr, fq); S.done(cur); }
        if (!has_next) break;
#pragma unroll
        for (int a = 0; a < 2; ++a)
#pragma unroll
            for (int b = 0; b < 2; ++b)
#pragma unroll
                for (int m = 0; m < 4; ++m)
#pragma unroll
                    for (int n = 0; n < 2; ++n) acc[a][b][m][n] = (f32x4){0.f, 0.f, 0.f, 0.f};
        cur = nxt; cA = nA; cB = nB; ++ui;
        if constexpr (Epi::MIDSCALE) E.load_mid(cur);
        if constexpr (Epi::ROWPRE) pre = E.pre_issue(cur);
        if constexpr (ALIGN_EPI) { if (wr == 1) PG8_BAR; }
    }
    PG8_WAIT_V(0);
    if constexpr (!ALIGN_EPI) { if (wr == 0) PG8_BAR; }
    PG8_BAR;
    if constexpr (Epi::AFTER_DRAIN) { E.fused(acc, cur, wr, wc, fr, fq, lds, wid, lane); S.done(cur); }
#undef PG8_SA
#undef PG8_SB
#undef PG8_STAGE
#undef PG8_LDA
#undef PG8_LDB
#undef PG8_MMA
#undef PG8_WAIT_V
#undef PG8_WAIT_L
#undef PG8_BAR
#undef PG8_SCHED
}
}

#define EPI_ARGS const f32x4 (&acc)[2][2][4][2], const pg8::Unit& u, int wr, int wc, int fr, int fq
#define EPI_HEAD static constexpr bool PERM = true, AFTER_DRAIN = false, MIDSCALE = false, ROWPRE = false; typedef int Pre;
#define EPI_HEAD_PRE(T) static constexpr bool PERM = true, AFTER_DRAIN = false, MIDSCALE = false, ROWPRE = true; typedef T Pre;
#define EPI_RC const int brow = u.pm * 256, bcol = u.pn * 256;
constexpr int HALF = 128, SHM_B = 131072, LDS_TOTAL = SHM_B + 16 + 4096 + 1024;
struct EpiIn {
    EPI_HEAD_PRE(float)
    const float* rx; char* ws; char* lds;
    __device__ __forceinline__ float pre_issue(const pg8::Unit& u) const { return threadIdx.x < 256 ? rx[u.pm * 256 + threadIdx.x] : 0.f; }
    __device__ __forceinline__ void pre_commit(float v) const { if (threadIdx.x < 256) ((float*)(lds + 4096))[threadIdx.x] = v; }
    __device__ __forceinline__ void operator()(EPI_ARGS) const { EPI_RC
        const int kind = bcol >> 9;
        const int lc0 = (bcol & 256) + wc * 32 + 8 * fq;
        bf16_t* dst = (bf16_t*)(ws + (kind == 0 ? OFF_QT : kind == 1 ? OFF_QT + SZ_HALF : kind == 2 ? OFF_QT + 3 * SZ_HALF : kind == 3 ? OFF_SQ : OFF_SQ + SZ_HALF));
        if (kind == 1) {
            float* dstf = (float*)(ws + OFF_BC); const float* lbp = (const float*)(ws + OFF_LB);
#pragma unroll
            for (int bj = 0; bj < 2; ++bj)
#pragma unroll
                for (int n = 0; n < 2; ++n) {
                    const f32x4 l0 = *(const f32x4*)(lbp + lc0 + bj * HALF + 4 * n), m0 = *(const f32x4*)(lbp + 512 + lc0 + bj * HALF + 4 * n);
                    float rsv[2][4];
#pragma unroll
                    for (int ai = 0; ai < 2; ++ai)
#pragma unroll
                        for (int m = 0; m < 4; ++m) rsv[ai][m] = ((const float*)(lds + 4096))[ai * HALF + wr * 64 + m * 16 + fr];
#pragma unroll
                    for (int ai = 0; ai < 2; ++ai)
#pragma unroll
                        for (int m = 0; m < 4; ++m) {
                            const int row = brow + ai * HALF + wr * 64 + m * 16 + fr; const float rs = rsv[ai][m];
                            const f32x4 z = acc[ai][bj][m][n] * rs; f32x4 lf;
#pragma unroll
                            for (int j = 0; j < 4; ++j) { const float s = sigmoidf_(z[j]); lf[j] = __builtin_amdgcn_logf(l0[j] + m0[j] * s)  ; }
                            const size_t o = (size_t)row * 512 + lc0 + bj * HALF + 4 * n;
                            u32x2 w; w.x = cvt_pk_f16(lf[0], lf[1]); w.y = cvt_pk_f16(lf[2], lf[3]); *(u32x2*)((unsigned short*)dstf + o) = w;
                        }
                }
            return;
        }
        float rsv[2][4];
#pragma unroll
        for (int ai = 0; ai < 2; ++ai)
#pragma unroll
            for (int m = 0; m < 4; ++m) rsv[ai][m] = ((const float*)(lds + 4096))[ai * HALF + wr * 64 + m * 16 + fr] * (kind == 3 ? 0.125f * LOG2E : 1.0f);
#pragma unroll
        for (int ai = 0; ai < 2; ++ai)
#pragma unroll
            for (int m = 0; m < 4; ++m) {
                const int row = brow + ai * HALF + wr * 64 + m * 16 + fr;
                const float rs = rsv[ai][m];
#pragma unroll
                for (int bj = 0; bj < 2; ++bj) {
                    f32x4 v0 = acc[ai][bj][m][0] * rs, v1 = acc[ai][bj][m][1] * rs;
                    if (kind == 0 || kind == 2) {
#pragma unroll
                        for (int j = 0; j < 4; ++j) { v0[j] = siluf_(v0[j]); v1[j] = siluf_(v1[j]); }
                    }
                    u32x4 w; w.x = cvt_pk_bf16(v0[0], v0[1]); w.y = cvt_pk_bf16(v0[2], v0[3]); w.z = cvt_pk_bf16(v1[0], v1[1]); w.w = cvt_pk_bf16(v1[2], v1[3]);
                    *(u32x4*)(dst + (size_t)row * 512 + lc0 + bj * HALF) = w;
                }
            }
    }
};
struct EpiVT {
    EPI_HEAD_PRE(float)
    const float* rx; char* ws; char* lds;
    __device__ __forceinline__ float pre_issue(const pg8::Unit& u) const { return threadIdx.x < 256 ? rx[u.pn * 256 + threadIdx.x] : 0.f; }
    __device__ __forceinline__ void pre_commit(float v) const { if (threadIdx.x < 256) ((float*)(lds + 4096))[threadIdx.x] = v; }
    __device__ __forceinline__ void operator()(EPI_ARGS) const { EPI_RC
        bf16_t* dst = (bf16_t*)(ws + (brow < 512 ? OFF_VHT : OFF_SVT));
        const int r0 = (brow & 511) + wr * 64 + fr, c0 = bcol + wc * 32 + 8 * fq;
#pragma unroll
        for (int bj = 0; bj < 2; ++bj) {
            const f32x4 s0 = *(const f32x4*)((const float*)(lds + 4096) + wc * 32 + 8 * fq + bj * HALF), s1 = *(const f32x4*)((const float*)(lds + 4096) + wc * 32 + 8 * fq + bj * HALF + 4);
#pragma unroll
            for (int ai = 0; ai < 2; ++ai)
#pragma unroll
                for (int m = 0; m < 4; ++m) {
                    const f32x4 v0 = acc[ai][bj][m][0] * s0, v1 = acc[ai][bj][m][1] * s1;
                    u32x4 w; w.x = cvt_pk_bf16(v0[0], v0[1]); w.y = cvt_pk_bf16(v0[2], v0[3]); w.z = cvt_pk_bf16(v1[0], v1[1]); w.w = cvt_pk_bf16(v1[2], v1[3]);
                    *(u32x4*)(dst + vt_off(r0 + ai * HALF + m * 16, (size_t)(c0 + bj * HALF))) = w;
                }
        }
    }
};
struct EpiF32 {
    EPI_HEAD
    float* C; int ldc;
    __device__ __forceinline__ void operator()(EPI_ARGS) const { EPI_RC
#pragma unroll
        for (int ai = 0; ai < 2; ++ai)
#pragma unroll
            for (int m = 0; m < 4; ++m) {
                float* rp = C + (size_t)(brow + ai * HALF + wr * 64 + m * 16 + fr) * ldc + bcol + wc * 32 + 8 * fq;
#pragma unroll
                for (int bj = 0; bj < 2; ++bj) { *(f32x4*)(rp + bj * HALF) = acc[ai][bj][m][0]; *(f32x4*)(rp + bj * HALF + 4) = acc[ai][bj][m][1]; }
            }
    }
};
struct EpiBf16 {
    EPI_HEAD
    bf16_t* C; int ldc;
    __device__ __forceinline__ void operator()(EPI_ARGS) const { EPI_RC
#pragma unroll
        for (int ai = 0; ai < 2; ++ai)
#pragma unroll
            for (int m = 0; m < 4; ++m) {
                bf16_t* rp = C + (size_t)(brow + ai * HALF + wr * 64 + m * 16 + fr) * ldc + bcol + wc * 32 + 8 * fq;
#pragma unroll
                for (int bj = 0; bj < 2; ++bj) {
                    const f32x4 v0 = acc[ai][bj][m][0], v1 = acc[ai][bj][m][1];
                    u32x4 w; w.x = cvt_pk_bf16(v0[0], v0[1]); w.y = cvt_pk_bf16(v0[2], v0[3]); w.z = cvt_pk_bf16(v1[0], v1[1]); w.w = cvt_pk_bf16(v1[2], v1[3]);
                    *(u32x4*)(rp + bj * HALF) = w;
                }
            }
    }
};
struct EpiAct {
    EPI_HEAD_PRE(f32x4)
    const float* rh; bf16_t* act; char* lds;
    __device__ __forceinline__ f32x4 pre_issue(const pg8::Unit& u) const { return threadIdx.x < 256 ? *(const f32x4*)(rh + (size_t)(u.pm * 256 + threadIdx.x) * 4) : (f32x4){0.f, 0.f, 0.f, 0.f}; }
    __device__ __forceinline__ void pre_commit(f32x4 q) const { if (threadIdx.x < 256) ((float*)(lds + 4096))[threadIdx.x] = rsqrtf(((q[0] + q[1]) + (q[2] + q[3])) * (1.0f / DM) + EPS); }
    __device__ __forceinline__ void operator()(EPI_ARGS) const { EPI_RC
        const int c0 = (bcol >> 1) + wc * 32 + 8 * fq;
        float rsv[2][4];
#pragma unroll
        for (int ai = 0; ai < 2; ++ai)
#pragma unroll
            for (int m = 0; m < 4; ++m) rsv[ai][m] = ((const float*)(lds + 4096))[ai * HALF + wr * 64 + m * 16 + fr];
#pragma unroll
        for (int ai = 0; ai < 2; ++ai)
#pragma unroll
            for (int m = 0; m < 4; ++m) {
                const int row = brow + ai * HALF + wr * 64 + m * 16 + fr;
                const float rs = rsv[ai][m];
                float o[8];
#pragma unroll
                for (int n = 0; n < 2; ++n)
#pragma unroll
                    for (int j = 0; j < 4; ++j) { const float g = acc[ai][0][m][n][j] * rs, u = acc[ai][1][m][n][j] * rs; o[n * 4 + j] = siluf_(g) * u; }
                u32x4 w; w.x = cvt_pk_bf16(o[0], o[1]); w.y = cvt_pk_bf16(o[2], o[3]); w.z = cvt_pk_bf16(o[4], o[5]); w.w = cvt_pk_bf16(o[6], o[7]);
                *(u32x4*)(act + (size_t)row * DFF + c0) = w;
            }
    }
};
struct EpiFinal {
    EPI_HEAD
    float* out; const bf16_t* ple; const bf16_t* h2;
    __device__ __forceinline__ void operator()(EPI_ARGS) const { EPI_RC
#pragma unroll
        for (int ai = 0; ai < 2; ++ai)
#pragma unroll
            for (int mp = 0; mp < 1; ++mp) {
                u32x4 pv[4][2], hv[4][2];
#pragma unroll
                for (int mm = 0; mm < 4; ++mm)
#pragma unroll
                    for (int bj = 0; bj < 2; ++bj) {
                        const size_t ro = (size_t)(brow + ai * HALF + wr * 64 + (4 * mp + mm) * 16 + fr) * DM + bcol + wc * 32 + 8 * fq + bj * HALF;
                        pv[mm][bj] = *(const u32x4*)(ple + ro); hv[mm][bj] = *(const u32x4*)(h2 + ro);
                    }
#pragma unroll
                for (int mm = 0; mm < 4; ++mm)
#pragma unroll
                    for (int bj = 0; bj < 2; ++bj) {
                        const int m = 4 * mp + mm;
                        const size_t ro = (size_t)(brow + ai * HALF + wr * 64 + m * 16 + fr) * DM + bcol + wc * 32 + 8 * fq + bj * HALF;
                        const f32x4 a0 = acc[ai][bj][m][0], a1 = acc[ai][bj][m][1]; const u32x4 q = pv[mm][bj], hq = hv[mm][bj]; f32x4 x0, x1;
                        x0[0] = bflo(hq.x) + bflo(q.x) * sigmoidf_(a0[0]); x0[1] = bfhi(hq.x) + bfhi(q.x) * sigmoidf_(a0[1]); x0[2] = bflo(hq.y) + bflo(q.y) * sigmoidf_(a0[2]); x0[3] = bfhi(hq.y) + bfhi(q.y) * sigmoidf_(a0[3]);
                        x1[0] = bflo(hq.z) + bflo(q.z) * sigmoidf_(a1[0]); x1[1] = bfhi(hq.z) + bfhi(q.z) * sigmoidf_(a1[1]); x1[2] = bflo(hq.w) + bflo(q.w) * sigmoidf_(a1[2]); x1[3] = bfhi(hq.w) + bfhi(q.w) * sigmoidf_(a1[3]);
                        *(f32x4*)(out + ro) = x0; *(f32x4*)(out + ro + 4) = x1;
                    }
            }
    }
};

template <int WHICH> struct EpiRes {
    static constexpr bool PERM = true, AFTER_DRAIN = false, MIDSCALE = (WHICH == 1), ROWPRE = false; typedef int Pre; static constexpr int MID_T = 8;
    const float* gain; bf16_t* hb; float* part; unsigned* cnt; float* part2; char* lds; const float* parth;
    __device__ __forceinline__ void load_mid(const pg8::Unit& u) const {
        if (threadIdx.x < 256) { const f32x4 q = *(const f32x4*)(parth + (size_t)(u.pm * 256 + threadIdx.x) * 4); ((float*)(lds + 4096))[threadIdx.x] = rsqrtf(((q[0] + q[1]) + (q[2] + q[3])) * (1.0f / 512) + EPS); }
    }
    __device__ __forceinline__ float mid_scale(int r) const { return ((const float*)(lds + 4096))[r]; }
    __device__ __forceinline__ void operator()(EPI_ARGS) const { EPI_RC
        float* red = (float*)lds; const int tid = threadIdx.x;
#pragma unroll
        for (int ai = 0; ai < 2; ++ai)
#pragma unroll
            for (int m = 0; m < 4; ++m) {
                float s = 0.f;
#pragma unroll
                for (int bj = 0; bj < 2; ++bj)
#pragma unroll
                    for (int n = 0; n < 2; ++n) { const f32x4 v = acc[ai][bj][m][n]; s += (v[0] * v[0] + v[1] * v[1]) + (v[2] * v[2] + v[3] * v[3]); }
                s += __shfl_xor(s, 16); s += __shfl_xor(s, 32);
                if (fq == 0) red[(ai * HALF + wr * 64 + m * 16 + fr) * 4 + wc] = s;
            }
        f32x4 g[2][2]; u32x4 bv[4][2];
#pragma unroll
        for (int bj = 0; bj < 2; ++bj) { g[bj][0] = *(const f32x4*)(gain + bcol + bj * HALF + wc * 32 + 8 * fq); g[bj][1] = *(const f32x4*)(gain + bcol + bj * HALF + wc * 32 + 8 * fq + 4); }
#pragma unroll
        for (int m = 0; m < 4; ++m)
#pragma unroll
            for (int bj = 0; bj < 2; ++bj) bv[m][bj] = *(const u32x4*)(hb + (size_t)(brow + wr * 64 + m * 16 + fr) * DM + bcol + bj * HALF + wc * 32 + 8 * fq);
        __syncthreads();
        if (tid < 256) { const f32x4 v = *(const f32x4*)(red + tid * 4); __hip_atomic_store(part + (size_t)(brow + tid) * 4 + u.pn, (v[0] + v[1]) + (v[2] + v[3]), __ATOMIC_RELAXED, __HIP_MEMORY_SCOPE_AGENT); }
        asm volatile("s_waitcnt vmcnt(0)" ::: "memory");
        __syncthreads();
        if (tid == 0) {
            unsigned* c = cnt + u.pm * 64;
            __hip_atomic_fetch_add(c, 1u, __ATOMIC_RELAXED, __HIP_MEMORY_SCOPE_AGENT);
            unsigned sp = 0;
            while (__hip_atomic_load(c, __ATOMIC_RELAXED, __HIP_MEMORY_SCOPE_AGENT) < 4u && ++sp < (1u << 20)) __builtin_amdgcn_s_sleep(1);
        }
        __syncthreads();
#pragma unroll
        for (int ai = 0; ai < 2; ++ai) {
            float pq[4][4];
#pragma unroll
            for (int m = 0; m < 4; ++m) {
                const float* pp = part + (size_t)(brow + ai * HALF + wr * 64 + m * 16 + fr) * 4;
#pragma unroll
                for (int q = 0; q < 4; ++q) pq[m][q] = __hip_atomic_load(pp + q, __ATOMIC_RELAXED, __HIP_MEMORY_SCOPE_AGENT);
            }
            if (ai == 1) {
#pragma unroll
                for (int m = 0; m < 4; ++m)
#pragma unroll
                    for (int bj = 0; bj < 2; ++bj) bv[m][bj] = *(const u32x4*)(hb + (size_t)(brow + HALF + wr * 64 + m * 16 + fr) * DM + bcol + bj * HALF + wc * 32 + 8 * fq);
            }
#pragma unroll
            for (int m = 0; m < 4; ++m) {
                float s2 = 0.f; const float r = rsqrtf(((pq[m][0] + pq[m][1]) + (pq[m][2] + pq[m][3])) * (1.0f / DM) + EPS);
#pragma unroll
                for (int bj = 0; bj < 2; ++bj) { const size_t ro = (size_t)(brow + ai * HALF + wr * 64 + m * 16 + fr) * DM + bcol + bj * HALF + wc * 32 + 8 * fq;
                    const u32x4 q = bv[m][bj]; const f32x4 b0 = {bflo(q.x), bfhi(q.x), bflo(q.y), bfhi(q.y)}, b1 = {bflo(q.z), bfhi(q.z), bflo(q.w), bfhi(q.w)};
                    f32x4 h0, h1;
#pragma unroll
                    for (int j = 0; j < 4; ++j) { h0[j] = b0[j] + acc[ai][bj][m][0][j] * r * g[bj][0][j]; h1[j] = b1[j] + acc[ai][bj][m][1][j] * r * g[bj][1][j]; s2 += h0[j] * h0[j] + h1[j] * h1[j]; }
                    u32x4 w; w.x = cvt_pk_bf16(h0[0], h0[1]); w.y = cvt_pk_bf16(h0[2], h0[3]); w.z = cvt_pk_bf16(h1[0], h1[1]); w.w = cvt_pk_bf16(h1[2], h1[3]);
                    *(u32x4*)(hb + ro) = w; }
                if (WHICH == 1) { s2 += __shfl_xor(s2, 16); s2 += __shfl_xor(s2, 32); if (fq == 0) red[(ai * HALF + wr * 64 + m * 16 + fr) * 4 + wc] = s2; }
            }
        }
        if (WHICH == 1) {
            __syncthreads();
            if (tid < 256) { const f32x4 v = *(const f32x4*)(red + tid * 4); part2[(size_t)(brow + tid) * 4 + u.pn] = (v[0] + v[1]) + (v[2] + v[3]); }
        }
    }
};

template <class Epi>
__device__ __forceinline__ void run_gemm(const bf16_t* A, const bf16_t* Bt, int M, int N, int K, char* shm, const Epi& epi) {
    asm volatile("" : "+s"(K));
    pg8::Gemm g{A, Bt, M, N, K}; pg8::StaticOrder S; S.init(M, N, (int)gridDim.x, (int)blockIdx.x);
    pg8::gemm_phase<Epi, pg8::StaticOrder, true, true>((PG8_LAS unsigned char*)shm, g, S, epi);
}

__device__ __forceinline__ int src_col(int r, int mode) {
    if (mode == 0) return r;
    if (mode == 2) { const int g = r >> 9; const int sg = g == 0 ? 0 : g == 1 ? 1 : g == 2 ? 3 : g == 3 ? 4 : g == 4 ? 5 : g == 5 ? 2 : 6; return sg * 512 + (r & 511); }
    const int tile = r >> 8, w = r & 255, bj = w >> 7, j = w & 127;
    return bj * DFF + tile * 128 + j;
}
__device__ void conv_weight(const float* __restrict__ W, int K, int ldw, bf16_t* __restrict__ Wt, int Nrows, int mode, const float* __restrict__ gain, float* lds, int vb, int nvb) {
    const int nk = K / 64, nr = Nrows / 256, tid = threadIdx.x;
    for (int it = vb; it < nk * nr; it += nvb) {
        const int k0 = (it % nk) * 64, r0 = (it / nk) * 256;
        f32x4 v[8];
        const int sc = src_col(r0 + (tid & 63) * 4, mode);
#pragma unroll
        for (int i = 0; i < 8; ++i) v[i] = __builtin_nontemporal_load((const f32x4*)(W + (size_t)(k0 + (tid >> 6) + 8 * i) * ldw + sc));
        __syncthreads();
#pragma unroll
        for (int i = 0; i < 8; ++i) *(f32x4*)(lds + ((tid >> 6) + 8 * i) * 260 + (tid & 63) * 4) = v[i];
        __syncthreads();
#pragma unroll
        for (int j = 0; j < 4; ++j) {
            const int e = tid + 512 * j, r = e & 255, kg = e >> 8;
            float f[8];
#pragma unroll
            for (int i = 0; i < 8; ++i) { f[i] = lds[(8 * kg + i) * 260 + r]; if (gain) f[i] *= gain[k0 + 8 * kg + i]; }
            u32x4 w; w.x = cvt_pk_bf16(f[0], f[1]); w.y = cvt_pk_bf16(f[2], f[3]); w.z = cvt_pk_bf16(f[4], f[5]); w.w = cvt_pk_bf16(f[6], f[7]);
            *(u32x4*)(Wt + (size_t)(r0 + r) * K + k0 + 8 * kg) = w;
        }
    }
}
__device__ void phase0_rest(const Params& p, char* shm) {
    float* lds = (float*)shm; char* ws = p.ws;
    const int vb = blockIdx.x, nvb = gridDim.x;
    conv_weight(p.w_out, DM, DM, (bf16_t*)(ws + OFF_WOUT), DM, 0, nullptr, lds, vb, nvb);
    conv_weight(p.w_gu, DM, 2 * DFF, (bf16_t*)(ws + OFF_WGU), 2 * DFF, 1, p.g_ffn_pre, lds, vb, nvb);
    conv_weight(p.w_down, DFF, DM, (bf16_t*)(ws + OFF_WDN), DM, 0, nullptr, lds, vb, nvb);
    conv_weight(p.w_pp, PLE, DM, (bf16_t*)(ws + OFF_WPP), DM, 0, nullptr, lds, vb, nvb);
    conv_weight(p.w_pg, DM, DM, (bf16_t*)(ws + OFF_WPG), DM, 0, nullptr, lds, vb, nvb);
    __syncthreads();
    bf16_t* pb = (bf16_t*)(ws + OFF_PB);
    for (size_t i0 = (size_t)blockIdx.x * 512 + threadIdx.x; i0 < (size_t)MT * PLE / 4; i0 += (size_t)gridDim.x * 512 * 4) {
        f32x4 v[4];
#pragma unroll
        for (int j = 0; j < 4; ++j) { const size_t i = i0 + (size_t)j * gridDim.x * 512; if (i < (size_t)MT * PLE / 4) v[j] = __builtin_nontemporal_load((const f32x4*)(p.p + i * 4)); }
#pragma unroll
        for (int j = 0; j < 4; ++j) { const size_t i = i0 + (size_t)j * gridDim.x * 512; if (i < (size_t)MT * PLE / 4) { u32x2 w; w.x = cvt_pk_bf16(v[j][0], v[j][1]); w.y = cvt_pk_bf16(v[j][2], v[j][3]); *(u32x2*)(pb + i * 4) = w; } }
    }
    __syncthreads();
}
__device__ void phase0(const Params& p, char* shm) {
    float* lds = (float*)shm; char* ws = p.ws;
    const int vb = blockIdx.x, nvb = gridDim.x;
    conv_weight(p.w_in, DM, NIN, (bf16_t*)(ws + OFF_WIN), NIN, 2, p.g_attn_pre, lds, vb, nvb);
    if (blockIdx.x == 0) { float* lb = (float*)(ws + OFF_LB); const int c = threadIdx.x; const float l = sigmoidf_(p.gamma[c] - p.gamma[512 + c]); lb[c] = l; lb[512 + c] = 1.0f - l; }
    const int wid = threadIdx.x >> 6, lane = threadIdx.x & 63;
    bf16_t* xb = (bf16_t*)(ws + OFF_XB); float* rx = (float*)(ws + OFF_RX);
    for (int row0 = (blockIdx.x * 8 + wid) * 4; row0 < MT; row0 += gridDim.x * 32) {
        f32x4 v[4][4];
#pragma unroll
        for (int r = 0; r < 4; ++r)
#pragma unroll
            for (int i = 0; i < 4; ++i) v[r][i] = __builtin_nontemporal_load((const f32x4*)(p.x + (size_t)(row0 + r) * DM + i * 256 + lane * 4));
#pragma unroll
        for (int r = 0; r < 4; ++r) {
            float ss = 0.f;
#pragma unroll
            for (int i = 0; i < 4; ++i) { const f32x4 t = v[r][i]; ss += t[0] * t[0] + t[1] * t[1] + t[2] * t[2] + t[3] * t[3];
                u32x2 w; w.x = cvt_pk_bf16(t[0], t[1]); w.y = cvt_pk_bf16(t[2], t[3]); *(u32x2*)(xb + (size_t)(row0 + r) * DM + i * 256 + lane * 4) = w; }
            ss = wave_sum(ss);
            if (lane == 0) rx[row0 + r] = rsqrtf(ss * (1.0f / DM) + EPS);
        }
    }
}

template <int WHICH>
__device__ void phase_res(const Params& p) {
    char* ws = p.ws; const int wid = threadIdx.x >> 6, lane = threadIdx.x & 63;
    const float* src = (const float*)(ws + (WHICH == 1 ? OFF_QT : OFF_Y)); const float* base = WHICH == 1 ? p.x : p.out; const float* gn = WHICH == 1 ? p.g_attn_post : p.g_ffn_post;
    bf16_t* hb = (bf16_t*)(ws + (WHICH == 1 ? OFF_XB : OFF_H2B)); float* rh = (float*)(ws + OFF_RH1);
    f32x4 g[4];
#pragma unroll
    for (int i = 0; i < 4; ++i) g[i] = *(const f32x4*)(gn + i * 256 + lane * 4);
    for (int row0 = (blockIdx.x * 8 + wid) * 2; row0 < MT; row0 += gridDim.x * 16) {
        f32x4 mv[2][4], xv[2][4];
#pragma unroll
        for (int r = 0; r < 2; ++r)
#pragma unroll
            for (int i = 0; i < 4; ++i) { mv[r][i] = __builtin_nontemporal_load((const f32x4*)(src + (size_t)(row0 + r) * DM + i * 256 + lane * 4)); xv[r][i] = __builtin_nontemporal_load((const f32x4*)(base + (size_t)(row0 + r) * DM + i * 256 + lane * 4)); }
#pragma unroll
        for (int r = 0; r < 2; ++r) {
            float ss = 0.f;
#pragma unroll
            for (int i = 0; i < 4; ++i) ss += mv[r][i][0] * mv[r][i][0] + mv[r][i][1] * mv[r][i][1] + mv[r][i][2] * mv[r][i][2] + mv[r][i][3] * mv[r][i][3];
            ss = wave_sum(ss); const float rr = rsqrtf(ss * (1.0f / DM) + EPS); float s2 = 0.f;
#pragma unroll
            for (int i = 0; i < 4; ++i) { const int c = i * 256 + lane * 4; f32x4 h;
#pragma unroll
                for (int j = 0; j < 4; ++j) { h[j] = xv[r][i][j] + mv[r][i][j] * rr * g[i][j]; s2 += h[j] * h[j]; }
                *(f32x4*)(p.out + (size_t)(row0 + r) * DM + c) = h; u32x2 w; w.x = cvt_pk_bf16(h[0], h[1]); w.y = cvt_pk_bf16(h[2], h[3]); *(u32x2*)(hb + (size_t)(row0 + r) * DM + c) = w; }
            if (WHICH == 1) { s2 = wave_sum(s2); if (lane == 0) rh[row0 + r] = rsqrtf(s2 * (1.0f / DM) + EPS); }
        }
    }
}

#define MFMA32(a, b, c) __builtin_amdgcn_mfma_f32_32x32x16_bf16((a), (b), (c), 0, 0, 0)
#define MFMA16(a, b, c) __builtin_amdgcn_mfma_f32_16x16x32_bf16((a), (b), (c), 0, 0, 0)
__device__ __forceinline__ bf16x8 mk8(u32x2 a, u32x2 b) { u32x4 t; t.x = a.x; t.y = a.y; t.z = b.x; t.w = b.y; return __builtin_bit_cast(bf16x8, t); }
__device__ void phase_attn(const Params& p, char* shm, unsigned* queue) {
    char* ws = p.ws; const int tid = opaque_tid(), h = tid >> 6, lane = tid & 63, n = lane & 31, hh = lane >> 5;
    const bf16_t* SQ = (const bf16_t*)(ws + OFF_SQ); const bf16_t* SK = (const bf16_t*)(ws + OFF_SQ + SZ_HALF); const bf16_t* SVT = (const bf16_t*)(ws + OFF_SVT);
    bf16_t* am = (bf16_t*)(ws + OFF_AMIX); float* red = (float*)shm;
    int* itp = (int*)(shm + 2048);
    unsigned nxt_it = 0;
    if (threadIdx.x == 0) nxt_it = __hip_atomic_fetch_add(queue, 1u, __ATOMIC_RELAXED, __HIP_MEMORY_SCOPE_AGENT);
    for (;;) {
        __syncthreads();
        if (threadIdx.x == 0) { *itp = (int)nxt_it; if (nxt_it < NB * 128) nxt_it = __hip_atomic_fetch_add(queue, 1u, __ATOMIC_RELAXED, __HIP_MEMORY_SCOPE_AGENT); }
        __syncthreads();
        const int it0 = *itp; if (it0 >= NB * 128) break;
        const int it = NB * 128 - 1 - it0;
        const int b = it >> 7, qb = it & 127, t0 = qb * 32;
        const size_t tokq = (size_t)b * NT + t0 + n;
        bf16x8 qf[4];
#pragma unroll
        for (int ks = 0; ks < 4; ++ks) qf[ks] = *(const bf16x8*)(SQ + tokq * 512 + h * 64 + 16 * ks + 8 * hh);
        f32x16 o0, o1;
#pragma unroll
        for (int r = 0; r < 16; ++r) { o0[r] = 0.f; o1[r] = 0.f; }
        float R = 1.0f;
        bf16x8 kf[4]; u32x2 vf[2][2][2];
        const bf16_t* vbase = SVT + (size_t)(h * 64 + n) * 64 + 4 * hh;
        {
            const size_t tk = (size_t)b * NT + t0 + n;
#pragma unroll
            for (int ks = 0; ks < 4; ++ks) kf[ks] = *(const bf16x8*)(SK + tk * 512 + h * 64 + 16 * ks + 8 * hh);
#pragma unroll
            for (int db = 0; db < 2; ++db)
#pragma unroll
                for (int s = 0; s < 2; ++s)
#pragma unroll
                    for (int hf = 0; hf < 2; ++hf) vf[db][s][hf] = *(const u32x2*)(vbase + vt_off(0, (size_t)b * NT + t0) + db * 32 * 64 + 16 * s + 8 * hf);
        }
        for (int kb = qb; kb >= 0; --kb) {
            const int s1 = (kb > 0 ? kb - 1 : 0) * 32;
            bf16x8 kn[4]; u32x2 vn[2][2][2];
            {
                const size_t tk = (size_t)b * NT + s1 + n;
#pragma unroll
                for (int ks = 0; ks < 4; ++ks) kn[ks] = *(const bf16x8*)(SK + tk * 512 + h * 64 + 16 * ks + 8 * hh);
#pragma unroll
                for (int db = 0; db < 2; ++db)
#pragma unroll
                    for (int s = 0; s < 2; ++s)
#pragma unroll
                        for (int hf = 0; hf < 2; ++hf) vn[db][s][hf] = *(const u32x2*)(vbase + vt_off(0, (size_t)b * NT + s1) + db * 32 * 64 + 16 * s + 8 * hf);
            }
            f32x16 st;
#pragma unroll
            for (int r = 0; r < 16; ++r) st[r] = 0.f;
#pragma unroll
            for (int ks = 0; ks < 4; ++ks) st = MFMA32(kf[ks], qf[ks], st);
            float mm[16], be[16];
#pragma unroll
            for (int r = 0; r < 16; ++r) { const float e = fexp2(st[r]); mm[r] = frcp(1.0f + e); be[r] = 1.0f - mm[r]; }
            if (kb == qb) {
#pragma unroll
                for (int r = 0; r < 16; ++r) { const bool act = ((r & 3) + 8 * (r >> 2) + 4 * hh) < n; mm[r] = act ? mm[r] : 1.0f; be[r] = act ? be[r] : 0.0f; }
            }
            float go[4], gp[4], T[4];
#pragma unroll
            for (int g = 0; g < 4; ++g) { go[g] = (mm[4 * g] * mm[4 * g + 1]) * (mm[4 * g + 2] * mm[4 * g + 3]); gp[g] = __shfl_xor(go[g], 32); }
            T[3] = 1.0f; T[2] = go[3] * gp[3]; T[1] = T[2] * (go[2] * gp[2]); T[0] = T[1] * (go[1] * gp[1]);
            const float tot = T[0] * (go[0] * gp[0]);
            float aa[16];
#pragma unroll
            for (int g = 0; g < 4; ++g) {
                float x = R * T[g] * (hh == 0 ? gp[g] : 1.0f);
                aa[4 * g + 3] = be[4 * g + 3] * x; x *= mm[4 * g + 3];
                aa[4 * g + 2] = be[4 * g + 2] * x; x *= mm[4 * g + 2];
                aa[4 * g + 1] = be[4 * g + 1] * x; x *= mm[4 * g + 1];
                aa[4 * g + 0] = be[4 * g + 0] * x;
            }
            u32x4 p0, p1;
            p0.x = cvt_pk_bf16(aa[0], aa[1]); p0.y = cvt_pk_bf16(aa[2], aa[3]); p0.z = cvt_pk_bf16(aa[4], aa[5]); p0.w = cvt_pk_bf16(aa[6], aa[7]);
            p1.x = cvt_pk_bf16(aa[8], aa[9]); p1.y = cvt_pk_bf16(aa[10], aa[11]); p1.z = cvt_pk_bf16(aa[12], aa[13]); p1.w = cvt_pk_bf16(aa[14], aa[15]);
            const bf16x8 pf0 = __builtin_bit_cast(bf16x8, p0), pf1 = __builtin_bit_cast(bf16x8, p1);
            o0 = MFMA32(mk8(vf[0][0][0], vf[0][0][1]), pf0, o0); o0 = MFMA32(mk8(vf[0][1][0], vf[0][1][1]), pf1, o0);
            o1 = MFMA32(mk8(vf[1][0][0], vf[1][0][1]), pf0, o1); o1 = MFMA32(mk8(vf[1][1][0], vf[1][1][1]), pf1, o1);
            R *= tot;
            if (__ballot(R > 0.0f) == 0ull) break;
#pragma unroll
            for (int ks = 0; ks < 4; ++ks) kf[ks] = kn[ks];
#pragma unroll
            for (int db = 0; db < 2; ++db)
#pragma unroll
                for (int s = 0; s < 2; ++s) { vf[db][s][0] = vn[db][s][0]; vf[db][s][1] = vn[db][s][1]; }
        }
        float ss = 0.f;
#pragma unroll
        for (int r = 0; r < 16; ++r) ss += o0[r] * o0[r] + o1[r] * o1[r];
        ss += __shfl_xor(ss, 32);
        __syncthreads();
        if (hh == 0) red[h * 32 + n] = ss;
        __syncthreads();
        float tsum = 0.f;
#pragma unroll
        for (int w = 0; w < 8; ++w) tsum += red[w * 32 + n];
        const float rr = rsqrtf(tsum * (1.0f / 512) + EPS);
        f32x4 gwv[2][4];
#pragma unroll
        for (int db = 0; db < 2; ++db)
#pragma unroll
            for (int g = 0; g < 4; ++g) gwv[db][g] = *(const f32x4*)(p.g_sb + h * 64 + 32 * db + 8 * g + 4 * hh);
#pragma unroll
        for (int db = 0; db < 2; ++db)
#pragma unroll
            for (int g = 0; g < 4; ++g) {
                const int d0 = 32 * db + 8 * g + 4 * hh; const f32x4 gw = gwv[db][g];
                float v[4];
#pragma unroll
                for (int j = 0; j < 4; ++j) v[j] = (db == 0 ? o0[4 * g + j] : o1[4 * g + j]) * rr * gw[j];
                u32x2 w; w.x = cvt_pk_bf16(v[0], v[1]); w.y = cvt_pk_bf16(v[2], v[3]);
                *(u32x2*)(am + tokq * DM + 512 + h * 64 + d0) = w;
            }
    }
}

#define LDS_BAR() do { asm volatile("s_waitcnt lgkmcnt(0)" ::: "memory"); __builtin_amdgcn_s_barrier(); asm volatile("" ::: "memory"); } while (0)
constexpr int HSEG = 8, HCH = 64 / HSEG;
template <bool FULL>
__device__ void phase_hgseg(const Params& p, char* shm, int bh, int seg) {
    char* ws = p.ws; const int tid = opaque_tid(), w = tid >> 6, lane = tid & 63, fr = lane & 15, fq = lane >> 4, kp = tid & 63, r8 = tid >> 6;
    const int b = bh >> 2, h = bh & 3;
    const unsigned short* LF = (const unsigned short*)(ws + OFF_BC); const bf16_t* QT = (const bf16_t*)(ws + OFF_QT);
    const bf16_t* G = (const bf16_t*)(ws + OFF_QT + 3 * SZ_HALF); const bf16_t* VHT = (const bf16_t*)(ws + OFF_VHT);
    bf16_t* am = (bf16_t*)(ws + OFF_AMIX); float* parth = (float*)(ws + OFF_DC); float* SLOC = (float*)(ws + OFF_SLOC); float* DSEG = (float*)(ws + OFF_SLOC + 32 * MiB);
    float* qs = (float*)shm; float* dvec = (float*)(shm + 4096); float* red = (float*)(shm + 4608);
    char* sQs = shm + 8192; char* sQd = sQs + 17408; char* sKd = sQd + 17408; char* sP = sKd + 17408; char* keT = sP + 9216;
    f32x4 S[8];
#pragma unroll
    for (int kb = 0; kb < 8; ++kb) S[kb] = (f32x4){0.f, 0.f, 0.f, 0.f};
    f32x2 lfn[8]; unsigned qn[8]; bf16x8 vn[2]; u32x2 gn[4];
#define HG_LOAD(cc) do { const size_t _t0 = (size_t)b * NT + 64 * (cc); \
        _Pragma("unroll") for (int i = 0; i < 8; ++i) { const size_t a_ = (_t0 + 8 * r8 + i) * 512 + h * 128 + 2 * kp; lfn[i] = unpk_f16(*(const unsigned*)(LF + a_)); if (FULL) qn[i] = *(const unsigned*)(QT + a_); } \
        _Pragma("unroll") for (int ks = 0; ks < 2; ++ks) vn[ks] = *(const bf16x8*)(VHT + vt_off(h * 128 + 16 * w + fr, _t0) + 32 * ks + 8 * fq); \
        if (FULL) { _Pragma("unroll") for (int tb = 0; tb < 4; ++tb) gn[tb] = *(const u32x2*)(G + (_t0 + 16 * tb + fr) * 512 + h * 128 + 16 * w + 4 * fq); } } while (0)
    const int c0 = seg * HCH;
    HG_LOAD(c0);
    if (FULL) {
        for (int s = 0; s < seg; ++s) {
            const float* sl = SLOC + ((size_t)(bh * HSEG + s) * 128 + 16 * w + fr) * 128 + 4 * fq; const float* ds = DSEG + (size_t)(bh * HSEG + s) * 128 + 4 * fq;
            f32x4 lv[8], dv[8];
#pragma unroll
            for (int kb = 0; kb < 8; ++kb) { lv[kb] = *(const f32x4*)(sl + 16 * kb); dv[kb] = *(const f32x4*)(ds + 16 * kb); }
#pragma unroll
            for (int kb = 0; kb < 8; ++kb) S[kb] = S[kb] * dv[kb] + lv[kb];
        }
    }
    f32x4 gw = {0.f, 0.f, 0.f, 0.f};
    if (FULL) gw = *(const f32x4*)(p.g_hg + h * 128 + 16 * w + 4 * fq);
    float dsum0 = 0.f, dsum1 = 0.f;
    for (int ci = 0; ci < HCH; ++ci) {
        const int c = c0 + ci; const size_t tok0 = (size_t)b * NT + 64 * c;
        f32x2 lfv[8], kkv[8]; unsigned qv[8]; bf16x8 vfr[2]; u32x2 gv[4];
#pragma unroll
        for (int i = 0; i < 8; ++i) { lfv[i] = lfn[i]; kkv[i].x = 1.0f - fexp2(lfn[i].x); kkv[i].y = 1.0f - fexp2(lfn[i].y); if (FULL) qv[i] = qn[i]; }
        vfr[0] = vn[0]; vfr[1] = vn[1];
        if (FULL) {
#pragma unroll
            for (int tb = 0; tb < 4; ++tb) gv[tb] = gn[tb];
        }
        { const int cn = ci < HCH - 1 ? c + 1 : c; HG_LOAD(cn); }
        f32x2 run = {0.f, 0.f};
#pragma unroll
        for (int i = 0; i < 8; ++i) { run += lfv[i]; lfv[i] = run; }
        *(f32x2*)(qs + r8 * 128 + 2 * kp) = run;
        LDS_BAR();
        if (FULL && ci > 0 && tid < 64) { float s = 0.f;
#pragma unroll
            for (int ww = 0; ww < 8; ++ww) s += red[ww * 64 + tid];
            parth[(tok0 - 64 + tid) * 4 + h] = s; }
        f32x2 off = {0.f, 0.f}, bmid = {0.f, 0.f}, blast = {0.f, 0.f};
#pragma unroll
        for (int j = 0; j < 8; ++j) { const f32x2 q = *(const f32x2*)(qs + j * 128 + 2 * kp); if (j < r8) off += q; if (j < 4) bmid += q; blast += q; }
        if (r8 == 0) { f32x2 d; d.x = fexp2(blast.x); d.y = fexp2(blast.y); *(f32x2*)(dvec + 2 * kp) = d; dsum0 += blast.x; dsum1 += blast.y; }
        f32x2 emid, elast;
        emid.x = fexp2(bmid.x); emid.y = fexp2(bmid.y); elast.x = fexp2(blast.x - bmid.x); elast.y = fexp2(blast.y - bmid.y);
        float ke0[8], ke1[8];
#pragma unroll
        for (int i = 0; i < 8; ++i) {
            const int t = 8 * r8 + i; const f32x2 bb = off + lfv[i];
            const float k0 = kkv[i].x, k1 = kkv[i].y;
            const float f0 = fexp2(bmid.x - bb.x), f1 = fexp2(bmid.y - bb.y);
            const float kd0 = k0 * f0, kd1 = k1 * f1;
            ke0[i] = kd0 * elast.x; ke1[i] = kd1 * elast.y;
            if (FULL) {
                const float e0 = fexp2(bb.x - bmid.x), e1 = fexp2(bb.y - bmid.y);
                const float qd0 = bflo(qv[i]) * e0, qd1 = bfhi(qv[i]) * e1;
                *(unsigned*)(sQd + t * 272 + kp * 4) = cvt_pk_bf16(qd0, qd1);
                *(unsigned*)(sQs + t * 272 + kp * 4) = cvt_pk_bf16(qd0 * emid.x, qd1 * emid.y);
                *(unsigned*)(sKd + t * 272 + kp * 4) = cvt_pk_bf16(kd0, kd1);
            }
        }
        { u32x4 a0, a1;
          a0.x = cvt_pk_bf16(ke0[0], ke0[1]); a0.y = cvt_pk_bf16(ke0[2], ke0[3]); a0.z = cvt_pk_bf16(ke0[4], ke0[5]); a0.w = cvt_pk_bf16(ke0[6], ke0[7]);
          a1.x = cvt_pk_bf16(ke1[0], ke1[1]); a1.y = cvt_pk_bf16(ke1[2], ke1[3]); a1.z = cvt_pk_bf16(ke1[4], ke1[5]); a1.w = cvt_pk_bf16(ke1[6], ke1[7]);
          *(u32x4*)(keT + (2 * kp) * 144 + r8 * 16) = a0; *(u32x4*)(keT + (2 * kp + 1) * 144 + r8 * 16) = a1; }
        LDS_BAR();
        if (FULL) {
            {
                const int tb = w >> 1;
                bf16x8 qf[4], kf[2][4];
#pragma unroll
                for (int ks = 0; ks < 4; ++ks) { qf[ks] = *(const bf16x8*)(sQd + (16 * tb + fr) * 272 + 64 * ks + 16 * fq);
#pragma unroll
                    for (int u = 0; u < 2; ++u) kf[u][ks] = *(const bf16x8*)(sKd + (16 * (2 * (w & 1) + u) + fr) * 272 + 64 * ks + 16 * fq); }
                __builtin_amdgcn_sched_barrier(0);
#pragma unroll
                for (int u = 0; u < 2; ++u) {
                    const int sb = 2 * (w & 1) + u;
                    f32x4 acc = {0.f, 0.f, 0.f, 0.f};
                    if (sb <= tb) {
#pragma unroll
                        for (int ks = 0; ks < 4; ++ks) acc = MFMA16(kf[u][ks], qf[ks], acc);
                    }
                    const int t = 16 * tb + fr, s0 = 16 * sb + 4 * fq;
#pragma unroll
                    for (int j = 0; j < 4; ++j) acc[j] = (s0 + j <= t) ? acc[j] : 0.f;
                    u32x2 o; o.x = cvt_pk_bf16(acc[0], acc[1]); o.y = cvt_pk_bf16(acc[2], acc[3]);
                    *(u32x2*)(sP + t * 144 + s0 * 2) = o;
                }
            }
            LDS_BAR();
            bf16x8 sb16[4];
#pragma unroll
            for (int ks = 0; ks < 4; ++ks) { u32x4 t4; t4.x = cvt_pk_bf16(S[2 * ks][0], S[2 * ks][1]); t4.y = cvt_pk_bf16(S[2 * ks][2], S[2 * ks][3]); t4.z = cvt_pk_bf16(S[2 * ks + 1][0], S[2 * ks + 1][1]); t4.w = cvt_pk_bf16(S[2 * ks + 1][2], S[2 * ks + 1][3]); sb16[ks] = __builtin_bit_cast(bf16x8, t4); }
            bf16x8 qsf[4][4], pf[4][2];
#pragma unroll
            for (int tb = 0; tb < 4; ++tb) {
#pragma unroll
                for (int ks = 0; ks < 4; ++ks) { const u32x2 lo = *(const u32x2*)(sQs + (16 * tb + fr) * 272 + (32 * ks + 4 * fq) * 2), hi = *(const u32x2*)(sQs + (16 * tb + fr) * 272 + (32 * ks + 16 + 4 * fq) * 2); qsf[tb][ks] = mk8(lo, hi); }
#pragma unroll
                for (int ks = 0; ks < 2; ++ks) pf[tb][ks] = *(const bf16x8*)(sP + (16 * tb + fr) * 144 + 64 * ks + 16 * fq);
            }
            __builtin_amdgcn_sched_barrier(0);
#pragma unroll
            for (int tb = 0; tb < 4; ++tb) {
                f32x4 acc = {0.f, 0.f, 0.f, 0.f};
#pragma unroll
                for (int ks = 0; ks < 4; ++ks) acc = MFMA16(sb16[ks], qsf[tb][ks], acc);
#pragma unroll
                for (int ks = 0; ks < 2; ++ks) acc = MFMA16(vfr[ks], pf[tb][ks], acc);
                float s = (acc[0] * acc[0] + acc[1] * acc[1]) + (acc[2] * acc[2] + acc[3] * acc[3]);
                s += __shfl_xor(s, 16); s += __shfl_xor(s, 32);
                if (fq == 0) red[w * 64 + 16 * tb + fr] = s;
                const u32x2 g2 = gv[tb];
                u32x2 o; o.x = cvt_pk_bf16(acc[0] * gw[0] * bflo(g2.x), acc[1] * gw[1] * bfhi(g2.x)); o.y = cvt_pk_bf16(acc[2] * gw[2] * bflo(g2.y), acc[3] * gw[3] * bfhi(g2.y));
                *(u32x2*)(am + (tok0 + 16 * tb + fr) * DM + h * 128 + 16 * w + 4 * fq) = o;
            }
        }
#pragma unroll
        for (int kg = 0; kg < 2; ++kg) {
            f32x4 dd[4]; bf16x8 kf[4][2];
#pragma unroll
            for (int q = 0; q < 4; ++q) { const int kb = 4 * kg + q; dd[q] = *(const f32x4*)(dvec + 16 * kb + 4 * fq);
#pragma unroll
                for (int ks = 0; ks < 2; ++ks) kf[q][ks] = *(const bf16x8*)(keT + (16 * kb + fr) * 144 + 64 * ks + 16 * fq); }
            __builtin_amdgcn_sched_barrier(0);
#pragma unroll
            for (int q = 0; q < 4; ++q) { const int kb = 4 * kg + q;
                f32x4 acc = S[kb] * dd[q];
#pragma unroll
                for (int ks = 0; ks < 2; ++ks) acc = MFMA16(kf[q][ks], vfr[ks], acc);
                S[kb] = acc; }
        }
    }
    if (FULL) {
        __syncthreads();
        if (tid < 64) { float s = 0.f;
#pragma unroll
            for (int ww = 0; ww < 8; ++ww) s += red[ww * 64 + tid];
            parth[((size_t)b * NT + 64 * (c0 + HCH - 1) + tid) * 4 + h] = s; }
    } else {
#pragma unroll
        for (int kb = 0; kb < 8; ++kb) *(f32x4*)(SLOC + ((size_t)(bh * HSEG + seg) * 128 + 16 * w + fr) * 128 + 16 * kb + 4 * fq) = S[kb];
        if (r8 == 0) { f32x2 d; d.x = fexp2(dsum0); d.y = fexp2(dsum1); *(f32x2*)(DSEG + (size_t)(bh * HSEG + seg) * 128 + 2 * kp) = d; }
    }
    __syncthreads();
#undef HG_LOAD
}

#define XB_TMO      128
#define XB_XCNT(j)  (256  + 64 * (j))
#define XB_XSUB(j)  (1280 + 64 * (j))
#define XB_XGEN(j)  (2304 + 64 * (j))
#define XB_TOP      3328
#define XB_TOPGEN   3392
#define XCD_BAR_WORDS 3456
#define XB_SPIN_CAP (1u << 18)
#define LAS __attribute__((address_space(3)))

__device__ __forceinline__ unsigned xb_ld(unsigned* p)              { return __hip_atomic_load(p, __ATOMIC_RELAXED, __HIP_MEMORY_SCOPE_AGENT); }
__device__ __forceinline__ unsigned xb_add(unsigned* p, unsigned v) { return __hip_atomic_fetch_add(p, v, __ATOMIC_RELAXED, __HIP_MEMORY_SCOPE_AGENT); }
__device__ __forceinline__ unsigned xb_xcc_id() { return (unsigned)__builtin_amdgcn_s_getreg((3 << 11) | 20) & 0xFu; }
#define XB_SPIN(cond, bar) do { unsigned _sp = 0; while (cond) { __builtin_amdgcn_s_sleep(1); \
    if ((++_sp & 255u) == 0u) { if (xb_ld(&(bar)[XB_TMO])) break; if (_sp > XB_SPIN_CAP) { atomicAdd(&(bar)[XB_TMO], 1u); break; } } } } while (0)

struct XcdBarrier {
    unsigned* bar; unsigned x;
    volatile LAS unsigned* st;
};

__device__ __forceinline__ XcdBarrier xcd_barrier_post(unsigned* bar, volatile LAS unsigned* st) {
    XcdBarrier b; b.bar = bar; b.x = xb_xcc_id(); b.st = st;
    if (threadIdx.x == 0) (void)xb_add(&bar[XB_XCNT(b.x)], 1u);
    return b;
}
__device__ __forceinline__ void xcd_barrier_complete(unsigned* bar, unsigned x, unsigned& nloc, unsigned& nx) {
    const unsigned G = gridDim.x * gridDim.y * gridDim.z;
    unsigned sum, cnt, mine, sp = 0u;
    for (;;) {
        sum = 0u; cnt = 0u; mine = 0u;
#pragma unroll
        for (unsigned j = 0; j < 16; ++j) { const unsigned c = xb_ld(&bar[XB_XCNT(j)]); sum += c; cnt += (c > 0u) ? 1u : 0u; mine = (j == x) ? c : mine; }
        if (sum == G) break;
        __builtin_amdgcn_s_sleep(1);
        if ((++sp & 255u) == 0u) { if (xb_ld(&bar[XB_TMO])) break; if (sp > XB_SPIN_CAP) { atomicAdd(&bar[XB_TMO], 1u); break; } }
    }
    nloc = mine > 0u ? mine : 1u; nx = cnt > 0u ? cnt : 1u;
}

__device__ __forceinline__ void xcd_barrier(const XcdBarrier& b) {
    asm volatile("s_waitcnt vmcnt(0)" ::: "memory");
    __syncthreads();
    if (threadIdx.x == 0) {
        unsigned* bar = b.bar;
        __builtin_amdgcn_s_waitcnt(0);
        unsigned nloc = b.st[0], nx = b.st[1];
        if (nloc == 0u) { xcd_barrier_complete(bar, b.x, nloc, nx); b.st[0] = nloc; b.st[1] = nx; }
        const unsigned old = xb_add(&bar[XB_XSUB(b.x)], 1u);
        const unsigned gen = old / nloc;
        if (old + 1u == (gen + 1u) * nloc) {
            __builtin_amdgcn_fence(__ATOMIC_RELEASE, "agent");
            asm volatile("s_waitcnt vmcnt(0)" ::: "memory");
            const unsigned og = xb_add(&bar[XB_TOP], 1u);
            const unsigned tg = og / nx;
            if (og + 1u == (tg + 1u) * nx) xb_add(&bar[XB_TOPGEN], 1u);
            else XB_SPIN(xb_ld(&bar[XB_TOPGEN]) == tg, bar);
            __builtin_amdgcn_fence(__ATOMIC_ACQUIRE, "agent");
            xb_add(&bar[XB_XGEN(b.x)], 1u);
            asm volatile("s_waitcnt vmcnt(0)" ::: "memory");
        } else {
            XB_SPIN(xb_ld(&bar[XB_XGEN(b.x)]) == gen, bar);
            __builtin_amdgcn_fence(__ATOMIC_ACQUIRE, "agent");
            asm volatile("s_waitcnt vmcnt(0)" ::: "memory");
        }
    }
    __syncthreads();
}


template <int PH> __device__ __forceinline__ void do_phase(const Params& p, char* shm) {
    char* ws = p.ws; char* epl = shm + SHM_B + 16;
    if (PH == 0) phase0(p, shm);
    if (PH == 1) {
        if (blockIdx.x & 1) phase0_rest(p, shm);
        run_gemm((const bf16_t*)(ws + OFF_XB), (const bf16_t*)(ws + OFF_WIN), MT, 2560, DM, shm, EpiIn{(const float*)(ws + OFF_RX), ws, epl});
        run_gemm((const bf16_t*)(ws + OFF_WIN) + (size_t)2560 * DM, (const bf16_t*)(ws + OFF_XB), 1024, MT, DM, shm, EpiVT{(const float*)(ws + OFF_RX), ws, epl});
        if (!(blockIdx.x & 1)) phase0_rest(p, shm);
    }
    if (PH == 2) { for (int u = blockIdx.x; u < 32 * HSEG; u += gridDim.x) if ((u & (HSEG - 1)) != HSEG - 1) phase_hgseg<false>(p, shm, u / HSEG, u & (HSEG - 1));
                   phase_attn(p, shm, (unsigned*)(ws + OFF_CNT) + 2 * 128 * 64); }
    if (PH == 3) { for (int u = blockIdx.x; u < 32 * HSEG; u += gridDim.x) phase_hgseg<true>(p, shm, u / HSEG, u & (HSEG - 1)); }
    if (PH == 5) run_gemm((const bf16_t*)(ws + OFF_AMIX), (const bf16_t*)(ws + OFF_WOUT), MT, DM, DM, shm,
                          EpiRes<1>{p.g_attn_post, (bf16_t*)(ws + OFF_XB), (float*)(ws + OFF_PART1), (unsigned*)(ws + OFF_CNT), (float*)(ws + OFF_PART2), epl, (const float*)(ws + OFF_DC)});
    if (PH == 7) {
        const bool ple_first = ((blockIdx.x >> 3) & 1) != 0;
        if (ple_first) run_gemm((const bf16_t*)(ws + OFF_PB), (const bf16_t*)(ws + OFF_WPP), MT, DM, PLE, shm, EpiBf16{(bf16_t*)(ws + OFF_PLE), DM});
        run_gemm((const bf16_t*)(ws + OFF_XB), (const bf16_t*)(ws + OFF_WGU), MT, 2 * DFF, DM, shm, EpiAct{(const float*)(ws + OFF_PART2), (bf16_t*)(ws + OFF_ACT), epl});
        if (!ple_first) run_gemm((const bf16_t*)(ws + OFF_PB), (const bf16_t*)(ws + OFF_WPP), MT, DM, PLE, shm, EpiBf16{(bf16_t*)(ws + OFF_PLE), DM});
    }
    if (PH == 8) run_gemm((const bf16_t*)(ws + OFF_ACT), (const bf16_t*)(ws + OFF_WDN), MT, DM, DFF, shm,
                          EpiRes<2>{p.g_ffn_post, (bf16_t*)(ws + OFF_XB), (float*)(ws + OFF_PART3), (unsigned*)(ws + OFF_CNT) + 128 * 64, nullptr, epl, nullptr});
    if (PH == 10) run_gemm((const bf16_t*)(ws + OFF_XB), (const bf16_t*)(ws + OFF_WPG), MT, DM, DM, shm, EpiFinal{p.out, (const bf16_t*)(ws + OFF_PLE), (const bf16_t*)(ws + OFF_XB)});
}
#if MEGA
__global__ __launch_bounds__(512) void k_mega(Params p) {
    extern __shared__ __attribute__((aligned(16))) char shm[];
    cg::grid_group grid = cg::this_grid();
    volatile LAS unsigned* st = (volatile LAS unsigned*)(shm + SHM_B);
    if (threadIdx.x < 2) st[threadIdx.x] = 0u;
    __syncthreads();
    const XcdBarrier xb = xcd_barrier_post((unsigned*)(p.ws + OFF_BAR), st);
    if (p.ws == nullptr) grid.sync();
    do_phase<0>(p, shm); xcd_barrier(xb);
    do_phase<1>(p, shm); xcd_barrier(xb);
    do_phase<2>(p, shm); xcd_barrier(xb);
    do_phase<3>(p, shm); xcd_barrier(xb);
    do_phase<5>(p, shm); xcd_barrier(xb);
    do_phase<7>(p, shm); xcd_barrier(xb);
    do_phase<8>(p, shm); xcd_barrier(xb);
    do_phase<10>(p, shm);
}
#else
template <int PH> __global__ __launch_bounds__(512) void k_phase(Params p) {
    extern __shared__ __attribute__((aligned(16))) char shm[];
    do_phase<PH>(p, shm);
}
template <int PH> static void launch_phase(const Params& p, hipStream_t s) {
    static bool attr = false;
    if (!attr) { (void)hipFuncSetAttribute((const void*)k_phase<PH>, hipFuncAttributeMaxDynamicSharedMemorySize, SHM_B); attr = true; }
    hipLaunchKernelGGL(k_phase<PH>, dim3(256), dim3(512), SHM_B, s, p);
}
#endif

extern "C" void kernel_launch(void* const* d_in, const int* in_sizes, int n_in, void* d_out, int out_size, void* d_ws, size_t ws_size, hipStream_t stream) {
    Params p{};
    p.x = (const float*)d_in[0]; p.p = (const float*)d_in[1]; p.g_attn_pre = (const float*)d_in[2]; p.w_in = (const float*)d_in[3]; p.gamma = (const float*)d_in[4];
    p.g_hg = (const float*)d_in[5]; p.g_sb = (const float*)d_in[6]; p.w_out = (const float*)d_in[7]; p.g_attn_post = (const float*)d_in[8]; p.g_ffn_pre = (const float*)d_in[9];
    p.w_gu = (const float*)d_in[10]; p.w_down = (const float*)d_in[11]; p.g_ffn_post = (const float*)d_in[12]; p.w_pp = (const float*)d_in[13]; p.w_pg = (const float*)d_in[14];
    p.out = (float*)d_out; p.ws = (char*)d_ws;
#if MEGA
    static int grid_blocks = 0;
    if (!grid_blocks) {
        int dev = 0, cus = 0, per_cu = 0;
        (void)hipGetDevice(&dev); (void)hipDeviceGetAttribute(&cus, hipDeviceAttributeMultiprocessorCount, dev);
        (void)hipFuncSetAttribute((const void*)k_mega, hipFuncAttributeMaxDynamicSharedMemorySize, LDS_TOTAL);
        (void)hipOccupancyMaxActiveBlocksPerMultiprocessor(&per_cu, (const void*)k_mega, 512, LDS_TOTAL);
        if (per_cu < 1) per_cu = 1;
        grid_blocks = cus * per_cu;
    }
    (void)hipMemsetAsync((char*)d_ws + OFF_BAR, 0, CTL_BYTES, stream);
    void* args[] = {&p};
    hipError_t e = hipLaunchCooperativeKernel((const void*)k_mega, dim3(grid_blocks), dim3(512), args, LDS_TOTAL, stream);
    if (e != hipSuccess) fprintf(stderr, "cooperative launch failed: %s (grid %d)\n", hipGetErrorString(e), grid_blocks);
#else
    launch_phase<0>(p, stream); launch_phase<1>(p, stream); launch_phase<2>(p, stream); launch_phase<3>(p, stream); launch_phase<5>(p, stream);
    launch_phase<7>(p, stream); launch_phase<8>(p, stream); launch_phase<10>(p, stream);
#endif
}
```

```cpp
#include <hip/hip_runtime.h>
#include <hip/hip_cooperative_groups.h>
#include <cstdio>
#include <cstdint>
namespace cg = cooperative_groups;

#ifndef MEGA
#define MEGA 1
#endif

typedef unsigned short bf16_t;
typedef short bf16x8 __attribute__((ext_vector_type(8)));
typedef float f32x4 __attribute__((ext_vector_type(4)));
typedef unsigned u32x4 __attribute__((ext_vector_type(4)));
typedef unsigned u32x2 __attribute__((ext_vector_type(2)));

constexpr int NB = 8, NT = 4096, DM = 1024, MT = NB * NT;
constexpr int NIN = 3584, DFF = 2816, PLE = 256;
constexpr float EPS = 1e-6f;
constexpr float LOG2E = 1.4426950408889634f;

constexpr size_t MiB = 1ull << 20;
constexpr size_t OFF_WIN = 0;
constexpr size_t OFF_WOUT = 7 * MiB;
constexpr size_t OFF_WGU = 9 * MiB;
constexpr size_t OFF_WDN = 20 * MiB;
constexpr size_t OFF_WPP = 26 * MiB;
constexpr size_t OFF_WPG = 27 * MiB;
constexpr size_t OFF_RX = 30 * MiB;
constexpr size_t OFF_RH1 = 31 * MiB;
constexpr size_t OFF_LB = 32 * MiB;
constexpr size_t OFF_PB = 40 * MiB;
constexpr size_t OFF_XB = 56 * MiB;
constexpr size_t OFF_SQ = 120 * MiB;
constexpr size_t OFF_Y = 56 * MiB;
constexpr size_t OFF_QT = 216 * MiB;
constexpr size_t OFF_BC = 344 * MiB;
constexpr size_t OFF_ACT = 216 * MiB;
constexpr size_t OFF_H2B = 216 * MiB;
constexpr size_t OFF_PLE = 408 * MiB;
constexpr size_t OFF_SLOC = 472 * MiB;
constexpr size_t OFF_AMIX = 408 * MiB;
constexpr size_t OFF_PART1 = 35 * MiB;
constexpr size_t OFF_PART2 = 36 * MiB;
constexpr size_t OFF_PART3 = 37 * MiB;
constexpr size_t OFF_CNT = 34 * MiB + 16384;
constexpr size_t CTL_BYTES = 16384 + 2 * 128 * 64 * 4 + 256;
constexpr size_t OFF_BAR = 34 * MiB;
constexpr size_t OFF_DC = 33 * MiB;
constexpr size_t OFF_U = 56 * MiB;
constexpr size_t OFF_SC = 120 * MiB;
constexpr size_t OFF_VHT = 216 * MiB + 2 * (32 * MiB);
constexpr size_t OFF_SVT = 120 * MiB + 2 * (32 * MiB);
constexpr size_t SZ_HALF = 32 * MiB;

struct Params {
    const float *x, *p, *g_attn_pre, *w_in, *gamma, *g_hg, *g_sb, *w_out, *g_attn_post, *g_ffn_pre, *w_gu, *w_down, *g_ffn_post, *w_pp, *w_pg;
    float* out; char* ws;
};

typedef __bf16 bf2_t __attribute__((ext_vector_type(2)));
typedef float f32x2 __attribute__((ext_vector_type(2)));
typedef float f32x16 __attribute__((ext_vector_type(16)));
typedef _Float16 h16x2 __attribute__((ext_vector_type(2)));
__device__ __forceinline__ unsigned cvt_pk_f16(float lo, float hi) { f32x2 v = {lo, hi}; return __builtin_bit_cast(unsigned, __builtin_convertvector(v, h16x2)); }
__device__ __forceinline__ f32x2 unpk_f16(unsigned u) { return __builtin_convertvector(__builtin_bit_cast(h16x2, u), f32x2); }
__device__ __forceinline__ unsigned cvt_pk_bf16(float lo, float hi) { f32x2 v = {lo, hi}; return __builtin_bit_cast(unsigned, __builtin_convertvector(v, bf2_t)); }
__device__ __forceinline__ size_t vt_off(int ch, size_t tok) { return ((tok >> 6) * 512 + (size_t)ch) * 64 + (tok & 63); }
__device__ __forceinline__ float bf2f(bf16_t h) { return __uint_as_float(((unsigned)h) << 16); }
__device__ __forceinline__ float bflo(unsigned u) { return __uint_as_float(u << 16); }
__device__ __forceinline__ float bfhi(unsigned u) { return __uint_as_float(u & 0xffff0000u); }
__device__ __forceinline__ float fexp2(float x) { return __builtin_amdgcn_exp2f(x); }
__device__ __forceinline__ float frcp(float x) { return __builtin_amdgcn_rcpf(x); }
__device__ __forceinline__ float sigmoidf_(float x) { return frcp(1.0f + fexp2(-x * LOG2E)); }
__device__ __forceinline__ float siluf_(float x) { return x * sigmoidf_(x); }
__device__ __forceinline__ float wave_sum(float v) {
#pragma unroll
    for (int o = 32; o >= 1; o >>= 1) v += __shfl_xor(v, o);
    return v;
}

__device__ __forceinline__ int opaque_tid() { int t = threadIdx.x; asm volatile("" : "+v"(t)); return t; }

namespace pg8 {
#define PG8_LAS __attribute__((address_space(3)))
typedef unsigned short bf16_t;
typedef short bf16x8 __attribute__((ext_vector_type(8)));
typedef float f32x4 __attribute__((ext_vector_type(4)));
typedef unsigned u32x4 __attribute__((ext_vector_type(4)));
constexpr int BM = 256, BK = 64, HALF = 128, HTB = HALF * BK * 2  , STAGE_BYTES = 8 * HTB, NXCD = 8, WGM = 8;

__host__ __device__ __forceinline__ int lds_byte(int r, int c) { const int st = (r >> 4) * 2 + (c >> 5), rr = r & 15, cc = c & 31, ob = rr * 64 + cc * 2; return st * 1024 + (ob ^ (((ob >> 9) & 1) << 5)); }
__host__ __device__ __forceinline__ void stage_rc(int b, int& R, int& C) { const int st = b / 1024, sb = b % 1024, swz = sb ^ (((sb >> 9) & 1) << 5); R = (st >> 1) * 16 + swz / 64; C = (st & 1) * 32 + (swz % 64) / 2; }
__host__ __device__ __forceinline__ int perm32(int rho) { const int n = rho >> 4, i = rho & 15; return 8 * (i >> 2) + 4 * n + (i & 3); }

struct Unit { int pm, pn; };
struct Gemm { const bf16_t* A; const bf16_t* Bt; int M, N, K; };

struct StaticOrder {
    int nM, nN, nwg, G, c;
    __host__ __device__ void init(int M, int N, int G_, int c_) { nM = M / BM; nN = N / BM; nwg = nM * nN; G = G_; c = c_; }
    __host__ __device__ bool next(int i, Unit& u) const {
        const long L = (long)i * G + c; if (L >= nwg) return false;
        int wgid = (int)L; { const int q = nwg / NXCD, r = nwg % NXCD, xcd = wgid % NXCD, off = wgid / NXCD; wgid = (xcd < r ? xcd * (q + 1) : r * (q + 1) + (xcd - r) * q) + off; }
        const int nig = WGM * nN, gid = wgid / nig, fm = gid * WGM, gsz = (nM - fm) < WGM ? (nM - fm) : WGM;
        u.pm = fm + ((wgid % nig) % gsz); u.pn = (wgid % nig) / gsz; return true;
    }
    __device__ __forceinline__ void a_ready(const Unit&) const {}
    __device__ __forceinline__ void done(const Unit&) const {}
};
template <class Epi, class Sched, bool ALIGN_EPI = false, bool SP2 = false>
__device__ __forceinline__ void gemm_phase(PG8_LAS unsigned char* lds, const Gemm g, const Sched& S, const Epi& E) {
    const int tid = opaque_tid(), wid = __builtin_amdgcn_readfirstlane(tid >> 6), lane = tid & 63, wr = wid >> 2, wc = wid & 3, fr = lane & 15, fq = lane >> 4;
    const int K = g.K, nt = K / BK;
    unsigned voffA[2], voffB[2];
#pragma unroll
    for (int i = 0; i < 2; ++i) { int R, C; stage_rc(tid * 16 + i * 8192, R, C); const int Rb = Epi::PERM ? ((R & ~31) + perm32(R & 31)) : R;
        voffA[i] = (unsigned)(R * K + C) * 2u; voffB[i] = (unsigned)(Rb * K + C) * 2u; }
    const size_t kstep = (size_t)(BK * 2);
    const size_t hstep = (size_t)HALF * K * 2;
    const size_t tstep = 2 * hstep;
    const unsigned ldsw = (unsigned)wid * 1024u;
    const int aoff = lds_byte(wr * 64 + fr, fq * 8), boff = lds_byte(wc * 32 + fr, fq * 8);
#define PG8_SA(b, h) (((b) * 2 + (h)) * HTB)
#define PG8_SB(b, h) ((4 + (b) * 2 + (h)) * HTB)
#define PG8_STAGE(bufoff, gbase, voff) do { _Pragma("unroll") for (int _i = 0; _i < 2; ++_i) \
        __builtin_amdgcn_global_load_lds((const unsigned*)((const char*)(gbase) + (voff)[_i]), (PG8_LAS unsigned*)(lds + (bufoff) + ldsw + _i * 8192), 16, 0, 0); } while (0)
#define PG8_LDA(dst, b, h) do { _Pragma("unroll") for (int m = 0; m < 4; ++m) _Pragma("unroll") for (int k = 0; k < 2; ++k) dst[m][k] = *(const PG8_LAS bf16x8*)(lds + PG8_SA(b, h) + aoff + m * 2048 + k * 1024); } while (0)
#define PG8_LDB(dst, b, h) do { _Pragma("unroll") for (int n = 0; n < 2; ++n) _Pragma("unroll") for (int k = 0; k < 2; ++k) dst[n][k] = *(const PG8_LAS bf16x8*)(lds + PG8_SB(b, h) + boff + n * 2048 + k * 1024); } while (0)
#define PG8_MMA(ai, bj, At, Bt) do { __builtin_amdgcn_s_setprio(1); _Pragma("unroll") for (int m = 0; m < 4; ++m) _Pragma("unroll") for (int n = 0; n < 2; ++n) _Pragma("unroll") for (int k = 0; k < 2; ++k) \
        acc[ai][bj][m][n] = __builtin_amdgcn_mfma_f32_16x16x32_bf16(Bt[n][k], At[m][k], acc[ai][bj][m][n], 0, 0, 0); __builtin_amdgcn_s_setprio(0); } while (0)
#define PG8_WAIT_V(n) asm volatile("s_waitcnt vmcnt(" #n ")" ::: "memory")
#define PG8_WAIT_L(n) asm volatile("s_waitcnt lgkmcnt(" #n ")" ::: "memory")
#define PG8_BAR __builtin_amdgcn_s_barrier()
#define PG8_SCHED __builtin_amdgcn_sched_barrier(0)
    Unit cur, nxt; int ui = 0;
    if (!S.next(0, cur)) return;
    f32x4 acc[2][2][4][2];
#pragma unroll
    for (int a = 0; a < 2; ++a)
#pragma unroll
        for (int b = 0; b < 2; ++b)
#pragma unroll
            for (int m = 0; m < 4; ++m)
#pragma unroll
                for (int n = 0; n < 2; ++n) acc[a][b][m][n] = (f32x4){0.f, 0.f, 0.f, 0.f};
    bf16x8 At[4][2], B0[2][2], B1[2][2];
    const char* cA = (const char*)g.A + (size_t)cur.pm * tstep; const char* cB = (const char*)g.Bt + (size_t)cur.pn * tstep;
    S.a_ready(cur);
    if constexpr (Epi::MIDSCALE) E.load_mid(cur);
    typename Epi::Pre pre = {};
    if constexpr (Epi::ROWPRE) pre = E.pre_issue(cur);
    if constexpr (SP2) {
        PG8_STAGE(PG8_SB(0, 0), cB, voffB); PG8_STAGE(PG8_SB(0, 1), cB + hstep, voffB); PG8_STAGE(PG8_SA(0, 0), cA, voffA); PG8_STAGE(PG8_SA(0, 1), cA + hstep, voffA);
        if (wr == 1) PG8_BAR;
        PG8_WAIT_V(2); PG8_BAR;
        PG8_STAGE(PG8_SB(1, 0), cB + kstep, voffB); PG8_STAGE(PG8_SA(1, 0), cA + kstep, voffA); PG8_STAGE(PG8_SB(1, 1), cB + hstep + kstep, voffB);
        PG8_WAIT_V(6); PG8_BAR;
    } else {
        PG8_STAGE(PG8_SB(0, 0), cB, voffB); PG8_STAGE(PG8_SA(0, 0), cA, voffA); PG8_STAGE(PG8_SB(0, 1), cB + hstep, voffB); PG8_STAGE(PG8_SA(0, 1), cA + hstep, voffA);
        if (wr == 1) PG8_BAR;
        PG8_WAIT_V(4); PG8_BAR;
        PG8_STAGE(PG8_SB(1, 0), cB + kstep, voffB); PG8_STAGE(PG8_SA(1, 0), cA + kstep, voffA); PG8_STAGE(PG8_SB(1, 1), cB + hstep + kstep, voffB);
        PG8_WAIT_V(6); PG8_BAR;
    }
    for (;;) {
        const bool has_next = S.next(ui + 1, nxt);
        const char* nA = has_next ? (const char*)g.A + (size_t)nxt.pm * tstep : cA; const char* nB = has_next ? (const char*)g.Bt + (size_t)nxt.pn * tstep : cB;
        for (int t = 0; t < nt; t += 2) {
            const bool last = (t == nt - 2);
            const char* a1 = cA + (size_t)(t + 1) * kstep;
            const char* a2 = last ? nA : cA + (size_t)(t + 2) * kstep; const char* b2 = last ? nB : cB + (size_t)(t + 2) * kstep;
            const char* a3 = a2 + kstep; const char* b3 = b2 + kstep;
            if (last && has_next) S.a_ready(nxt);
            if constexpr (Epi::ROWPRE) { if (t == 8) E.pre_commit(pre); }
            if constexpr (Epi::MIDSCALE) { if (t == Epi::MID_T) {
_Pragma("unroll") for (int a = 0; a < 2; ++a) _Pragma("unroll") for (int m = 0; m < 4; ++m) { const float sc_ = E.mid_scale(a * HALF + wr * 64 + m * 16 + fr);
_Pragma("unroll") for (int b = 0; b < 2; ++b) _Pragma("unroll") for (int n = 0; n < 2; ++n) acc[a][b][m][n] = acc[a][b][m][n] * sc_; } } }
            if constexpr (SP2) {
            PG8_LDB(B0, 0, 0); PG8_LDB(B1, 0, 1); PG8_SCHED; PG8_LDA(At, 0, 0); PG8_STAGE(PG8_SA(1, 1), a1 + hstep, voffA);
            PG8_WAIT_V(8); PG8_WAIT_L(0); PG8_BAR; PG8_MMA(0, 0, At, B0); PG8_MMA(0, 1, At, B1); PG8_BAR; PG8_SCHED;
            PG8_LDA(At, 0, 1); PG8_STAGE(PG8_SB(0, 0), b2, voffB); PG8_STAGE(PG8_SB(0, 1), b2 + hstep, voffB); PG8_STAGE(PG8_SA(0, 0), a2, voffA);
            PG8_WAIT_V(8); PG8_WAIT_L(0); PG8_BAR; PG8_MMA(1, 0, At, B0); PG8_MMA(1, 1, At, B1); PG8_BAR; PG8_SCHED;
            PG8_LDB(B0, 1, 0); PG8_LDB(B1, 1, 1); PG8_SCHED; PG8_LDA(At, 1, 0); PG8_STAGE(PG8_SA(0, 1), a2 + hstep, voffA);
            PG8_WAIT_V(8); PG8_WAIT_L(0); PG8_BAR; PG8_MMA(0, 0, At, B0); PG8_MMA(0, 1, At, B1); PG8_BAR; PG8_SCHED;
            PG8_LDA(At, 1, 1); PG8_STAGE(PG8_SB(1, 0), b3, voffB); PG8_STAGE(PG8_SB(1, 1), b3 + hstep, voffB); PG8_STAGE(PG8_SA(1, 0), a3, voffA);
            PG8_WAIT_V(8); PG8_WAIT_L(0); PG8_BAR; PG8_MMA(1, 0, At, B0); PG8_MMA(1, 1, At, B1); PG8_BAR; PG8_SCHED;
            } else {
            PG8_LDB(B0, 0, 0); PG8_SCHED; PG8_LDA(At, 0, 0); PG8_STAGE(PG8_SA(1, 1), a1 + hstep, voffA);
            PG8_WAIT_L(8); PG8_BAR; PG8_WAIT_L(0); PG8_MMA(0, 0, At, B0); PG8_BAR; PG8_SCHED;
            PG8_LDB(B1, 0, 1); PG8_STAGE(PG8_SB(0, 0), b2, voffB);
            PG8_BAR; PG8_WAIT_L(0); PG8_MMA(0, 1, At, B1); PG8_BAR;
            PG8_LDA(At, 0, 1); PG8_STAGE(PG8_SA(0, 0), a2, voffA);
            PG8_BAR; PG8_WAIT_L(0); PG8_MMA(1, 0, At, B0); PG8_BAR; PG8_SCHED;
            PG8_STAGE(PG8_SB(0, 1), b2 + hstep, voffB);
            PG8_WAIT_V(6); PG8_BAR; PG8_MMA(1, 1, At, B1); PG8_BAR;
            PG8_LDB(B0, 1, 0); PG8_SCHED; PG8_LDA(At, 1, 0); PG8_STAGE(PG8_SA(0, 1), a2 + hstep, voffA);
            PG8_WAIT_L(8); PG8_BAR; PG8_WAIT_L(0); PG8_MMA(0, 0, At, B0); PG8_BAR; PG8_SCHED;
            PG8_LDB(B1, 1, 1); PG8_STAGE(PG8_SB(1, 0), b3, voffB);
            PG8_BAR; PG8_WAIT_L(0); PG8_MMA(0, 1, At, B1); PG8_BAR;
            PG8_LDA(At, 1, 1); PG8_STAGE(PG8_SA(1, 0), a3, voffA);
            PG8_BAR; PG8_WAIT_L(0); PG8_MMA(1, 0, At, B0); PG8_BAR; PG8_SCHED;
            PG8_STAGE(PG8_SB(1, 1), b3 + hstep, voffB);
            PG8_WAIT_V(6); PG8_BAR; PG8_MMA(1, 1, At, B1); PG8_BAR;
            }
        }
        if constexpr (ALIGN_EPI) { if (wr == 0) PG8_BAR; }
        if constexpr (!Epi::AFTER_DRAIN) { E(acc, cur, wr, wc, fr, fq); S.done(cur); }
        if (!has_next) break;
#pragma unroll
        for (int a = 0; a < 2; ++a)
#pragma unroll
            for (int b = 0; b < 2; ++b)
#pragma unroll
                for (int m = 0; m < 4; ++m)
#pragma unroll
                    for (int n = 0; n < 2; ++n) acc[a][b][m][n] = (f32x4){0.f, 0.f, 0.f, 0.f};
        cur = nxt; cA = nA; cB = nB; ++ui;
        if constexpr (Epi::MIDSCALE) E.load_mid(cur);
        if constexpr (Epi::ROWPRE) pre = E.pre_issue(cur);
        if constexpr (ALIGN_EPI) { if (wr == 1) PG8_BAR; }
    }
    PG8_WAIT_V(0);
    if constexpr (!ALIGN_EPI) { if (wr == 0) PG8_BAR; }
    PG8_BAR;
    if constexpr (Epi::AFTER_DRAIN) { E.fused(acc, cur, wr, wc, fr, fq, lds, wid, lane); S.done(cur); }
#undef PG8_SA
#undef PG8_SB
#undef PG8_STAGE
#undef PG8_LDA
#undef PG8_LDB
#undef PG8_MMA
#undef PG8_WAIT_V
#undef PG8_WAIT_L
#undef PG8_BAR
#undef PG8_SCHED
}
}

#define EPI_ARGS const f32x4 (&acc)[2][2][4][2], const pg8::Unit& u, int wr, int wc, int fr, int fq
#define EPI_HEAD static constexpr bool PERM = true, AFTER_DRAIN = false, MIDSCALE = false, ROWPRE = false; typedef int Pre;
#define EPI_HEAD_PRE(T) static constexpr bool PERM = true, AFTER_DRAIN = false, MIDSCALE = false, ROWPRE = true; typedef T Pre;
#define EPI_RC const int brow = u.pm * 256, bcol = u.pn * 256;
constexpr int HALF = 128, SHM_B = 131072, LDS_TOTAL = SHM_B + 16 + 4096 + 1024;
struct EpiIn {
    EPI_HEAD_PRE(float)
    const float* rx; char* ws; char* lds;
    __device__ __forceinline__ float pre_issue(const pg8::Unit& u) const { return threadIdx.x < 256 ? rx[u.pm * 256 + threadIdx.x] : 0.f; }
    __device__ __forceinline__ void pre_commit(float v) const { if (threadIdx.x < 256) ((float*)(lds + 4096))[threadIdx.x] = v; }
    __device__ __forceinline__ void operator()(EPI_ARGS) const { EPI_RC
        const int kind = bcol >> 9;
        const int lc0 = (bcol & 256) + wc * 32 + 8 * fq;
        bf16_t* dst = (bf16_t*)(ws + (kind == 0 ? OFF_QT : kind == 1 ? OFF_QT + SZ_HALF : kind == 2 ? OFF_QT + 3 * SZ_HALF : kind == 3 ? OFF_SQ : OFF_SQ + SZ_HALF));
        if (kind == 1) {
            float* dstf = (float*)(ws + OFF_BC); const float* lbp = (const float*)(ws + OFF_LB);
#pragma unroll
            for (int bj = 0; bj < 2; ++bj)
#pragma unroll
                for (int n = 0; n < 2; ++n) {
                    const f32x4 l0 = *(const f32x4*)(lbp + lc0 + bj * HALF + 4 * n), m0 = *(const f32x4*)(lbp + 512 + lc0 + bj * HALF + 4 * n);
                    float rsv[2][4];
#pragma unroll
                    for (int ai = 0; ai < 2; ++ai)
#pragma unroll
                        for (int m = 0; m < 4; ++m) rsv[ai][m] = ((const float*)(lds + 4096))[ai * HALF + wr * 64 + m * 16 + fr];
#pragma unroll
                    for (int ai = 0; ai < 2; ++ai)
#pragma unroll
                        for (int m = 0; m < 4; ++m) {
                            const int row = brow + ai * HALF + wr * 64 + m * 16 + fr; const float rs = rsv[ai][m];
                            const f32x4 z = acc[ai][bj][m][n] * rs; f32x4 lf;
#pragma unroll
                            for (int j = 0; j < 4; ++j) { const float s = sigmoidf_(z[j]); lf[j] = __builtin_amdgcn_logf(l0[j] + m0[j] * s)  ; }
                            const size_t o = (size_t)row * 512 + lc0 + bj * HALF + 4 * n;
                            u32x2 w; w.x = cvt_pk_f16(lf[0], lf[1]); w.y = cvt_pk_f16(lf[2], lf[3]); *(u32x2*)((unsigned short*)dstf + o) = w;
                        }
                }
            return;
        }
        float rsv[2][4];
#pragma unroll
        for (int ai = 0; ai < 2; ++ai)
#pragma unroll
            for (int m = 0; m < 4; ++m) rsv[ai][m] = ((const float*)(lds + 4096))[ai * HALF + wr * 64 + m * 16 + fr] * (kind == 3 ? 0.125f * LOG2E : 1.0f);
#pragma unroll
        for (int ai = 0; ai < 2; ++ai)
#pragma unroll
            for (int m = 0; m < 4; ++m) {
                const int row = brow + ai * HALF + wr * 64 + m * 16 + fr;
                const float rs = rsv[ai][m];
#pragma unroll
                for (int bj = 0; bj < 2; ++bj) {
                    f32x4 v0 = acc[ai][bj][m][0] * rs, v1 = acc[ai][bj][m][1] * rs;
                    if (kind == 0 || kind == 2) {
#pragma unroll
                        for (int j = 0; j < 4; ++j) { v0[j] = siluf_(v0[j]); v1[j] = siluf_(v1[j]); }
                    }
                    u32x4 w; w.x = cvt_pk_bf16(v0[0], v0[1]); w.y = cvt_pk_bf16(v0[2], v0[3]); w.z = cvt_pk_bf16(v1[0], v1[1]); w.w = cvt_pk_bf16(v1[2], v1[3]);
                    *(u32x4*)(dst + (size_t)row * 512 + lc0 + bj * HALF) = w;
                }
            }
    }
};
struct EpiVT {
    EPI_HEAD_PRE(float)
    const float* rx; char* ws; char* lds;
    __device__ __forceinline__ float pre_issue(const pg8::Unit& u) const { return threadIdx.x < 256 ? rx[u.pn * 256 + threadIdx.x] : 0.f; }
    __device__ __forceinline__ void pre_commit(float v) const { if (threadIdx.x < 256) ((float*)(lds + 4096))[threadIdx.x] = v; }
    __device__ __forceinline__ void operator()(EPI_ARGS) const { EPI_RC
        bf16_t* dst = (bf16_t*)(ws + (brow < 512 ? OFF_VHT : OFF_SVT));
        const int r0 = (brow & 511) + wr * 64 + fr, c0 = bcol + wc * 32 + 8 * fq;
#pragma unroll
        for (int bj = 0; bj < 2; ++bj) {
            const f32x4 s0 = *(const f32x4*)((const float*)(lds + 4096) + wc * 32 + 8 * fq + bj * HALF), s1 = *(const f32x4*)((const float*)(lds + 4096) + wc * 32 + 8 * fq + bj * HALF + 4);
#pragma unroll
            for (int ai = 0; ai < 2; ++ai)
#pragma unroll
                for (int m = 0; m < 4; ++m) {
                    const f32x4 v0 = acc[ai][bj][m][0] * s0, v1 = acc[ai][bj][m][1] * s1;
                    u32x4 w; w.x = cvt_pk_bf16(v0[0], v0[1]); w.y = cvt_pk_bf16(v0[2], v0[3]); w.z = cvt_pk_bf16(v1[0], v1[1]); w.w = cvt_pk_bf16(v1[2], v1[3]);
                    *(u32x4*)(dst + vt_off(r0 + ai * HALF + m * 16, (size_t)(c0 + bj * HALF))) = w;
                }
        }
    }
};
struct EpiF32 {
    EPI_HEAD
    float* C; int ldc;
    __device__ __forceinline__ void operator()(EPI_ARGS) const { EPI_RC
#pragma unroll
        for (int ai = 0; ai < 2; ++ai)
#pragma unroll
            for (int m = 0; m < 4; ++m) {
                float* rp = C + (size_t)(brow + ai * HALF + wr * 64 + m * 16 + fr) * ldc + bcol + wc * 32 + 8 * fq;
#pragma unroll
                for (int bj = 0; bj < 2; ++bj) { *(f32x4*)(rp + bj * HALF) = acc[ai][bj][m][0]; *(f32x4*)(rp + bj * HALF + 4) = acc[ai][bj][m][1]; }
            }
    }
};
struct EpiBf16 {
    EPI_HEAD
    bf16_t* C; int ldc;
    __device__ __forceinline__ void operator()(EPI_ARGS) const { EPI_RC
#pragma unroll
        for (int ai = 0; ai < 2; ++ai)
#pragma unroll
            for (int m = 0; m < 4; ++m) {
                bf16_t* rp = C + (size_t)(brow + ai * HALF + wr * 64 + m * 16 + fr) * ldc + bcol + wc * 32 + 8 * fq;
#pragma unroll
                for (int bj = 0; bj < 2; ++bj) {
                    const f32x4 v0 = acc[ai][bj][m][0], v1 = acc[ai][bj][m][1];
                    u32x4 w; w.x = cvt_pk_bf16(v0[0], v0[1]); w.y = cvt_pk_bf16(v0[2], v0[3]); w.z = cvt_pk_bf16(v1[0], v1[1]); w.w = cvt_pk_bf16(v1[2], v1[3]);
                    *(u32x4*)(rp + bj * HALF) = w;
                }
            }
    }
};
struct EpiAct {
    EPI_HEAD_PRE(f32x4)
    const float* rh; bf16_t* act; char* lds;
    __device__ __forceinline__ f32x4 pre_issue(const pg8::Unit& u) const { return threadIdx.x < 256 ? *(const f32x4*)(rh + (size_t)(u.pm * 256 + threadIdx.x) * 4) : (f32x4){0.f, 0.f, 0.f, 0.f}; }
    __device__ __forceinline__ void pre_commit(f32x4 q) const { if (threadIdx.x < 256) ((float*)(lds + 4096))[threadIdx.x] = rsqrtf(((q[0] + q[1]) + (q[2] + q[3])) * (1.0f / DM) + EPS); }
    __device__ __forceinline__ void operator()(EPI_ARGS) const { EPI_RC
        const int c0 = (bcol >> 1) + wc * 32 + 8 * fq;
        float rsv[2][4];
#pragma unroll
        for (int ai = 0; ai < 2; ++ai)
#pragma unroll
            for (int m = 0; m < 4; ++m) rsv[ai][m] = ((const float*)(lds + 4096))[ai * HALF + wr * 64 + m * 16 + fr];
#pragma unroll
        for (int ai = 0; ai < 2; ++ai)
#pragma unroll
            for (int m = 0; m < 4; ++m) {
                const int row = brow + ai * HALF + wr * 64 + m * 16 + fr;
                const float rs = rsv[ai][m];
                float o[8];
#pragma unroll
                for (int n = 0; n < 2; ++n)
#pragma unroll
                    for (int j = 0; j < 4; ++j) { const float g = acc[ai][0][m][n][j] * rs, u = acc[ai][1][m][n][j] * rs; o[n * 4 + j] = siluf_(g) * u; }
                u32x4 w; w.x = cvt_pk_bf16(o[0], o[1]); w.y = cvt_pk_bf16(o[2], o[3]); w.z = cvt_pk_bf16(o[4], o[5]); w.w = cvt_pk_bf16(o[6], o[7]);
                *(u32x4*)(act + (size_t)row * DFF + c0) = w;
            }
    }
};
struct EpiFinal {
    EPI_HEAD
    float* out; const bf16_t* ple; const bf16_t* h2;
    __device__ __forceinline__ void operator()(EPI_ARGS) const { EPI_RC
#pragma unroll
        for (int ai = 0; ai < 2; ++ai)
#pragma unroll
            for (int mp = 0; mp < 1; ++mp) {
                u32x4 pv[4][2], hv[4][2];
#pragma unroll
                for (int mm = 0; mm < 4; ++mm)
#pragma unroll
                    for (int bj = 0; bj < 2; ++bj) {
                        const size_t ro = (size_t)(brow + ai * HALF + wr * 64 + (4 * mp + mm) * 16 + fr) * DM + bcol + wc * 32 + 8 * fq + bj * HALF;
                        pv[mm][bj] = *(const u32x4*)(ple + ro); hv[mm][bj] = *(const u32x4*)(h2 + ro);
                    }
#pragma unroll
                for (int mm = 0; mm < 4; ++mm)
#pragma unroll
                    for (int bj = 0; bj < 2; ++bj) {
                        const int m = 4 * mp + mm;
                        const size_t ro = (size_t)(brow + ai * HALF + wr * 64 + m * 16 + fr) * DM + bcol + wc * 32 + 8 * fq + bj * HALF;
                        const f32x4 a0 = acc[ai][bj][m][0], a1 = acc[ai][bj][m][1]; const u32x4 q = pv[mm][bj], hq = hv[mm][bj]; f32x4 x0, x1;
                        x0[0] = bflo(hq.x) + bflo(q.x) * sigmoidf_(a0[0]); x0[1] = bfhi(hq.x) + bfhi(q.x) * sigmoidf_(a0[1]); x0[2] = bflo(hq.y) + bflo(q.y) * sigmoidf_(a0[2]); x0[3] = bfhi(hq.y) + bfhi(q.y) * sigmoidf_(a0[3]);
                        x1[0] = bflo(hq.z) + bflo(q.z) * sigmoidf_(a1[0]); x1[1] = bfhi(hq.z) + bfhi(q.z) * sigmoidf_(a1[1]); x1[2] = bflo(hq.w) + bflo(q.w) * sigmoidf_(a1[2]); x1[3] = bfhi(hq.w) + bfhi(q.w) * sigmoidf_(a1[3]);
                        *(f32x4*)(out + ro) = x0; *(f32x4*)(out + ro + 4) = x1;
                    }
            }
    }
};

template <int WHICH> struct EpiRes {
    static constexpr bool PERM = true, AFTER_DRAIN = false, MIDSCALE = (WHICH == 1), ROWPRE = false; typedef int Pre; static constexpr int MID_T = 8;
    const float* gain; bf16_t* hb; float* part; unsigned* cnt; float* part2; char* lds; const float* parth;
    __device__ __forceinline__ void load_mid(const pg8::Unit& u) const {
        if (threadIdx.x < 256) { const f32x4 q = *(const f32x4*)(parth + (size_t)(u.pm * 256 + threadIdx.x) * 4); ((float*)(lds + 4096))[threadIdx.x] = rsqrtf(((q[0] + q[1]) + (q[2] + q[3])) * (1.0f / 512) + EPS); }
    }
    __device__ __forceinline__ float mid_scale(int r) const { return ((const float*)(lds + 4096))[r]; }
    __device__ __forceinline__ void operator()(EPI_ARGS) const { EPI_RC
        float* red = (float*)lds; const int tid = threadIdx.x;
#pragma unroll
        for (int ai = 0; ai < 2; ++ai)
#pragma unroll
            for (int m = 0; m < 4; ++m) {
                float s = 0.f;
#pragma unroll
                for (int bj = 0; bj < 2; ++bj)
#pragma unroll
                    for (int n = 0; n < 2; ++n) { const f32x4 v = acc[ai][bj][m][n]; s += (v[0] * v[0] + v[1] * v[1]) + (v[2] * v[2] + v[3] * v[3]); }
                s += __shfl_xor(s, 16); s += __shfl_xor(s, 32);
                if (fq == 0) red[(ai * HALF + wr * 64 + m * 16 + fr) * 4 + wc] = s;
            }
        f32x4 g[2][2]; u32x4 bv[4][2];
#pragma unroll
        for (int bj = 0; bj < 2; ++bj) { g[bj][0] = *(const f32x4*)(gain + bcol + bj * HALF + wc * 32 + 8 * fq); g[bj][1] = *(const f32x4*)(gain + bcol + bj * HALF + wc * 32 + 8 * fq + 4); }
#pragma unroll
        for (int m = 0; m < 4; ++m)
#pragma unroll
            for (int bj = 0; bj < 2; ++bj) bv[m][bj] = *(const u32x4*)(hb + (size_t)(brow + wr * 64 + m * 16 + fr) * DM + bcol + bj * HALF + wc * 32 + 8 * fq);
        __syncthreads();
        if (tid < 256) { const f32x4 v = *(const f32x4*)(red + tid * 4); __hip_atomic_store(part + (size_t)(brow + tid) * 4 + u.pn, (v[0] + v[1]) + (v[2] + v[3]), __ATOMIC_RELAXED, __HIP_MEMORY_SCOPE_AGENT); }
        asm volatile("s_waitcnt vmcnt(0)" ::: "memory");
        __syncthreads();
        if (tid == 0) {
            unsigned* c = cnt + u.pm * 64;
            __hip_atomic_fetch_add(c, 1u, __ATOMIC_RELAXED, __HIP_MEMORY_SCOPE_AGENT);
            unsigned sp = 0;
            while (__hip_atomic_load(c, __ATOMIC_RELAXED, __HIP_MEMORY_SCOPE_AGENT) < 4u && ++sp < (1u << 20)) __builtin_amdgcn_s_sleep(1);
        }
        __syncthreads();
#pragma unroll
        for (int ai = 0; ai < 2; ++ai) {
            float pq[4][4];
#pragma unroll
            for (int m = 0; m < 4; ++m) {
                const float* pp = part + (size_t)(brow + ai * HALF + wr * 64 + m * 16 + fr) * 4;
#pragma unroll
                for (int q = 0; q < 4; ++q) pq[m][q] = __hip_atomic_load(pp + q, __ATOMIC_RELAXED, __HIP_MEMORY_SCOPE_AGENT);
            }
            if (ai == 1) {
#pragma unroll
                for (int m = 0; m < 4; ++m)
#pragma unroll
                    for (int bj = 0; bj < 2; ++bj) bv[m][bj] = *(const u32x4*)(hb + (size_t)(brow + HALF + wr * 64 + m * 16 + fr) * DM + bcol + bj * HALF + wc * 32 + 8 * fq);
            }
#pragma unroll
            for (int m = 0; m < 4; ++m) {
                float s2 = 0.f; const float r = rsqrtf(((pq[m][0] + pq[m][1]) + (pq[m][2] + pq[m][3])) * (1.0f / DM) + EPS);
#pragma unroll
                for (int bj = 0; bj < 2; ++bj) { const size_t ro = (size_t)(brow + ai * HALF + wr * 64 + m * 16 + fr) * DM + bcol + bj * HALF + wc * 32 + 8 * fq;
                    const u32x4 q = bv[m][bj]; const f32x4 b0 = {bflo(q.x), bfhi(q.x), bflo(q.y), bfhi(q.y)}, b1 = {bflo(q.z), bfhi(q.z), bflo(q.w), bfhi(q.w)};
                    f32x4 h0, h1;
#pragma unroll
                    for (int j = 0; j < 4; ++j) { h0[j] = b0[j] + acc[ai][bj][m][0][j] * r * g[bj][0][j]; h1[j] = b1[j] + acc[ai][bj][m][1][j] * r * g[bj][1][j]; s2 += h0[j] * h0[j] + h1[j] * h1[j]; }
                    u32x4 w; w.x = cvt_pk_bf16(h0[0], h0[1]); w.y = cvt_pk_bf16(h0[2], h0[3]); w.z = cvt_pk_bf16(h1[0], h1[1]); w.w = cvt_pk_bf16(h1[2], h1[3]);
                    *(u32x4*)(hb + ro) = w; }
                if (WHICH == 1) { s2 += __shfl_xor(s2, 16); s2 += __shfl_xor(s2, 32); if (fq == 0) red[(ai * HALF + wr * 64 + m * 16 + fr) * 4 + wc] = s2; }
            }
        }
        if (WHICH == 1) {
            __syncthreads();
            if (tid < 256) { const f32x4 v = *(const f32x4*)(red + tid * 4); part2[(size_t)(brow + tid) * 4 + u.pn] = (v[0] + v[1]) + (v[2] + v[3]); }
        }
    }
};

template <class Epi>
__device__ __forceinline__ void run_gemm(const bf16_t* A, const bf16_t* Bt, int M, int N, int K, char* shm, const Epi& epi) {
    asm volatile("" : "+s"(K));
    pg8::Gemm g{A, Bt, M, N, K}; pg8::StaticOrder S; S.init(M, N, (int)gridDim.x, (int)blockIdx.x);
    pg8::gemm_phase<Epi, pg8::StaticOrder, true, true>((PG8_LAS unsigned char*)shm, g, S, epi);
}

__device__ __forceinline__ int src_col(int r, int mode) {
    if (mode == 0) return r;
    if (mode == 2) { const int g = r >> 9; const int sg = g == 0 ? 0 : g == 1 ? 1 : g == 2 ? 3 : g == 3 ? 4 : g == 4 ? 5 : g == 5 ? 2 : 6; return sg * 512 + (r & 511); }
    const int tile = r >> 8, w = r & 255, bj = w >> 7, j = w & 127;
    return bj * DFF + tile * 128 + j;
}
__device__ void conv_weight(const float* __restrict__ W, int K, int ldw, bf16_t* __restrict__ Wt, int Nrows, int mode, const float* __restrict__ gain, float* lds, int vb, int nvb) {
    const int nk = K / 64, nr = Nrows / 256, tid = threadIdx.x;
    for (int it = vb; it < nk * nr; it += nvb) {
        const int k0 = (it % nk) * 64, r0 = (it / nk) * 256;
        f32x4 v[8];
        const int sc = src_col(r0 + (tid & 63) * 4, mode);
#pragma unroll
        for (int i = 0; i < 8; ++i) v[i] = __builtin_nontemporal_load((const f32x4*)(W + (size_t)(k0 + (tid >> 6) + 8 * i) * ldw + sc));
        __syncthreads();
#pragma unroll
        for (int i = 0; i < 8; ++i) *(f32x4*)(lds + ((tid >> 6) + 8 * i) * 260 + (tid & 63) * 4) = v[i];
        __syncthreads();
#pragma unroll
        for (int j = 0; j < 4; ++j) {
            const int e = tid + 512 * j, r = e & 255, kg = e >> 8;
            float f[8];
#pragma unroll
            for (int i = 0; i < 8; ++i) { f[i] = lds[(8 * kg + i) * 260 + r]; if (gain) f[i] *= gain[k0 + 8 * kg + i]; }
            u32x4 w; w.x = cvt_pk_bf16(f[0], f[1]); w.y = cvt_pk_bf16(f[2], f[3]); w.z = cvt_pk_bf16(f[4], f[5]); w.w = cvt_pk_bf16(f[6], f[7]);
            *(u32x4*)(Wt + (size_t)(r0 + r) * K + k0 + 8 * kg) = w;
        }
    }
}
__device__ void phase0_rest(const Params& p, char* shm) {
    float* lds = (float*)shm; char* ws = p.ws;
    const int vb = blockIdx.x, nvb = gridDim.x;
    conv_weight(p.w_out, DM, DM, (bf16_t*)(ws + OFF_WOUT), DM, 0, nullptr, lds, vb, nvb);
    conv_weight(p.w_gu, DM, 2 * DFF, (bf16_t*)(ws + OFF_WGU), 2 * DFF, 1, p.g_ffn_pre, lds, vb, nvb);
    conv_weight(p.w_down, DFF, DM, (bf16_t*)(ws + OFF_WDN), DM, 0, nullptr, lds, vb, nvb);
    conv_weight(p.w_pp, PLE, DM, (bf16_t*)(ws + OFF_WPP), DM, 0, nullptr, lds, vb, nvb);
    conv_weight(p.w_pg, DM, DM, (bf16_t*)(ws + OFF_WPG), DM, 0, nullptr, lds, vb, nvb);
    __syncthreads();
    bf16_t* pb = (bf16_t*)(ws + OFF_PB);
    for (size_t i0 = (size_t)blockIdx.x * 512 + threadIdx.x; i0 < (size_t)MT * PLE / 4; i0 += (size_t)gridDim.x * 512 * 4) {
        f32x4 v[4];
#pragma unroll
        for (int j = 0; j < 4; ++j) { const size_t i = i0 + (size_t)j * gridDim.x * 512; if (i < (size_t)MT * PLE / 4) v[j] = __builtin_nontemporal_load((const f32x4*)(p.p + i * 4)); }
#pragma unroll
        for (int j = 0; j < 4; ++j) { const size_t i = i0 + (size_t)j * gridDim.x * 512; if (i < (size_t)MT * PLE / 4) { u32x2 w; w.x = cvt_pk_bf16(v[j][0], v[j][1]); w.y = cvt_pk_bf16(v[j][2], v[j][3]); *(u32x2*)(pb + i * 4) = w; } }
    }
    __syncthreads();
}
__device__ void phase0(const Params& p, char* shm) {
    float* lds = (float*)shm; char* ws = p.ws;
    const int vb = blockIdx.x, nvb = gridDim.x;
    conv_weight(p.w_in, DM, NIN, (bf16_t*)(ws + OFF_WIN), NIN, 2, p.g_attn_pre, lds, vb, nvb);
    if (blockIdx.x == 0) { float* lb = (float*)(ws + OFF_LB); const int c = threadIdx.x; const float l = sigmoidf_(p.gamma[c] - p.gamma[512 + c]); lb[c] = l; lb[512 + c] = 1.0f - l; }
    const int wid = threadIdx.x >> 6, lane = threadIdx.x & 63;
    bf16_t* xb = (bf16_t*)(ws + OFF_XB); float* rx = (float*)(ws + OFF_RX);
    for (int row0 = (blockIdx.x * 8 + wid) * 4; row0 < MT; row0 += gridDim.x * 32) {
        f32x4 v[4][4];
#pragma unroll
        for (int r = 0; r < 4; ++r)
#pragma unroll
            for (int i = 0; i < 4; ++i) v[r][i] = __builtin_nontemporal_load((const f32x4*)(p.x + (size_t)(row0 + r) * DM + i * 256 + lane * 4));
#pragma unroll
        for (int r = 0; r < 4; ++r) {
            float ss = 0.f;
#pragma unroll
            for (int i = 0; i < 4; ++i) { const f32x4 t = v[r][i]; ss += t[0] * t[0] + t[1] * t[1] + t[2] * t[2] + t[3] * t[3];
                u32x2 w; w.x = cvt_pk_bf16(t[0], t[1]); w.y = cvt_pk_bf16(t[2], t[3]); *(u32x2*)(xb + (size_t)(row0 + r) * DM + i * 256 + lane * 4) = w; }
            ss = wave_sum(ss);
            if (lane == 0) rx[row0 + r] = rsqrtf(ss * (1.0f / DM) + EPS);
        }
    }
}

template <int WHICH>
__device__ void phase_res(const Params& p) {
    char* ws = p.ws; const int wid = threadIdx.x >> 6, lane = threadIdx.x & 63;
    const float* src = (const float*)(ws + (WHICH == 1 ? OFF_QT : OFF_Y)); const float* base = WHICH == 1 ? p.x : p.out; const float* gn = WHICH == 1 ? p.g_attn_post : p.g_ffn_post;
    bf16_t* hb = (bf16_t*)(ws + (WHICH == 1 ? OFF_XB : OFF_H2B)); float* rh = (float*)(ws + OFF_RH1);
    f32x4 g[4];
#pragma unroll
    for (int i = 0; i < 4; ++i) g[i] = *(const f32x4*)(gn + i * 256 + lane * 4);
    for (int row0 = (blockIdx.x * 8 + wid) * 2; row0 < MT; row0 += gridDim.x * 16) {
        f32x4 mv[2][4], xv[2][4];
#pragma unroll
        for (int r = 0; r < 2; ++r)
#pragma unroll
            for (int i = 0; i < 4; ++i) { mv[r][i] = __builtin_nontemporal_load((const f32x4*)(src + (size_t)(row0 + r) * DM + i * 256 + lane * 4)); xv[r][i] = __builtin_nontemporal_load((const f32x4*)(base + (size_t)(row0 + r) * DM + i * 256 + lane * 4)); }
#pragma unroll
        for (int r = 0; r < 2; ++r) {
            float ss = 0.f;
#pragma unroll
            for (int i = 0; i < 4; ++i) ss += mv[r][i][0] * mv[r][i][0] + mv[r][i][1] * mv[r][i][1] + mv[r][i][2] * mv[r][i][2] + mv[r][i][3] * mv[r][i][3];
            ss = wave_sum(ss); const float rr = rsqrtf(ss * (1.0f / DM) + EPS); float s2 = 0.f;
#pragma unroll
            for (int i = 0; i < 4; ++i) { const int c = i * 256 + lane * 4; f32x4 h;
#pragma unroll
                for (int j = 0; j < 4; ++j) { h[j] = xv[r][i][j] + mv[r][i][j] * rr * g[i][j]; s2 += h[j] * h[j]; }
                *(f32x4*)(p.out + (size_t)(row0 + r) * DM + c) = h; u32x2 w; w.x = cvt_pk_bf16(h[0], h[1]); w.y = cvt_pk_bf16(h[2], h[3]); *(u32x2*)(hb + (size_t)(row0 + r) * DM + c) = w; }
            if (WHICH == 1) { s2 = wave_sum(s2); if (lane == 0) rh[row0 + r] = rsqrtf(s2 * (1.0f / DM) + EPS); }
        }
    }
}

#define MFMA32(a, b, c) __builtin_amdgcn_mfma_f32_32x32x16_bf16((a), (b), (c), 0, 0, 0)
#define MFMA16(a, b, c) __builtin_amdgcn_mfma_f32_16x16x32_bf16((a), (b), (c), 0, 0, 0)
__device__ __forceinline__ bf16x8 mk8(u32x2 a, u32x2 b) { u32x4 t; t.x = a.x; t.y = a.y; t.z = b.x; t.w = b.y; return __builtin_bit_cast(bf16x8, t); }
__device__ void phase_attn(const Params& p, char* shm, unsigned* queue) {
    char* ws = p.ws; const int tid = opaque_tid(), h = tid >> 6, lane = tid & 63, n = lane & 31, hh = lane >> 5;
    const bf16_t* SQ = (const bf16_t*)(ws + OFF_SQ); const bf16_t* SK = (const bf16_t*)(ws + OFF_SQ + SZ_HALF); const bf16_t* SVT = (const bf16_t*)(ws + OFF_SVT);
    bf16_t* am = (bf16_t*)(ws + OFF_AMIX); float* red = (float*)shm;
    int* itp = (int*)(shm + 2048);
    unsigned nxt_it = 0;
    if (threadIdx.x == 0) nxt_it = __hip_atomic_fetch_add(queue, 1u, __ATOMIC_RELAXED, __HIP_MEMORY_SCOPE_AGENT);
    for (;;) {
        __syncthreads();
        if (threadIdx.x == 0) { *itp = (int)nxt_it; if (nxt_it < NB * 128) nxt_it = __hip_atomic_fetch_add(queue, 1u, __ATOMIC_RELAXED, __HIP_MEMORY_SCOPE_AGENT); }
        __syncthreads();
        const int it0 = *itp; if (it0 >= NB * 128) break;
        const int it = NB * 128 - 1 - it0;
        const int b = it >> 7, qb = it & 127, t0 = qb * 32;
        const size_t tokq = (size_t)b * NT + t0 + n;
        bf16x8 qf[4];
#pragma unroll
        for (int ks = 0; ks < 4; ++ks) qf[ks] = *(const bf16x8*)(SQ + tokq * 512 + h * 64 + 16 * ks + 8 * hh);
        f32x16 o0, o1;
#pragma unroll
        for (int r = 0; r < 16; ++r) { o0[r] = 0.f; o1[r] = 0.f; }
        float R = 1.0f;
        bf16x8 kf[4]; u32x2 vf[2][2][2];
        const bf16_t* vbase = SVT + (size_t)(h * 64 + n) * 64 + 4 * hh;
        {
            const size_t tk = (size_t)b * NT + t0 + n;
#pragma unroll
            for (int ks = 0; ks < 4; ++ks) kf[ks] = *(const bf16x8*)(SK + tk * 512 + h * 64 + 16 * ks + 8 * hh);
#pragma unroll
            for (int db = 0; db < 2; ++db)
#pragma unroll
                for (int s = 0; s < 2; ++s)
#pragma unroll
                    for (int hf = 0; hf < 2; ++hf) vf[db][s][hf] = *(const u32x2*)(vbase + vt_off(0, (size_t)b * NT + t0) + db * 32 * 64 + 16 * s + 8 * hf);
        }
        for (int kb = qb; kb >= 0; --kb) {
            const int s1 = (kb > 0 ? kb - 1 : 0) * 32;
            bf16x8 kn[4]; u32x2 vn[2][2][2];
            {
                const size_t tk = (size_t)b * NT + s1 + n;
#pragma unroll
                for (int ks = 0; ks < 4; ++ks) kn[ks] = *(const bf16x8*)(SK + tk * 512 + h * 64 + 16 * ks + 8 * hh);
#pragma unroll
                for (int db = 0; db < 2; ++db)
#pragma unroll
                    for (int s = 0; s < 2; ++s)
#pragma unroll
                        for (int hf = 0; hf < 2; ++hf) vn[db][s][hf] = *(const u32x2*)(vbase + vt_off(0, (size_t)b * NT + s1) + db * 32 * 64 + 16 * s + 8 * hf);
            }
            f32x16 st;
#pragma unroll
            for (int r = 0; r < 16; ++r) st[r] = 0.f;
#pragma unroll
            for (int ks = 0; ks < 4; ++ks) st = MFMA32(kf[ks], qf[ks], st);
            float mm[16], be[16];
#pragma unroll
            for (int r = 0; r < 16; ++r) { const float e = fexp2(st[r]); mm[r] = frcp(1.0f + e); be[r] = 1.0f - mm[r]; }
            if (kb == qb) {
#pragma unroll
                for (int r = 0; r < 16; ++r) { const bool act = ((r & 3) + 8 * (r >> 2) + 4 * hh) < n; mm[r] = act ? mm[r] : 1.0f; be[r] = act ? be[r] : 0.0f; }
            }
            float go[4], gp[4], T[4];
#pragma unroll
            for (int g = 0; g < 4; ++g) { go[g] = (mm[4 * g] * mm[4 * g + 1]) * (mm[4 * g + 2] * mm[4 * g + 3]); gp[g] = __shfl_xor(go[g], 32); }
            T[3] = 1.0f; T[2] = go[3] * gp[3]; T[1] = T[2] * (go[2] * gp[2]); T[0] = T[1] * (go[1] * gp[1]);
            const float tot = T[0] * (go[0] * gp[0]);
            float aa[16];
#pragma unroll
            for (int g = 0; g < 4; ++g) {
                float x = R * T[g] * (hh == 0 ? gp[g] : 1.0f);
                aa[4 * g + 3] = be[4 * g + 3] * x; x *= mm[4 * g + 3];
                aa[4 * g + 2] = be[4 * g + 2] * x; x *= mm[4 * g + 2];
                aa[4 * g + 1] = be[4 * g + 1] * x; x *= mm[4 * g + 1];
                aa[4 * g + 0] = be[4 * g + 0] * x;
            }
            u32x4 p0, p1;
            p0.x = cvt_pk_bf16(aa[0], aa[1]); p0.y = cvt_pk_bf16(aa[2], aa[3]); p0.z = cvt_pk_bf16(aa[4], aa[5]); p0.w = cvt_pk_bf16(aa[6], aa[7]);
            p1.x = cvt_pk_bf16(aa[8], aa[9]); p1.y = cvt_pk_bf16(aa[10], aa[11]); p1.z = cvt_pk_bf16(aa[12], aa[13]); p1.w = cvt_pk_bf16(aa[14], aa[15]);
            const bf16x8 pf0 = __builtin_bit_cast(bf16x8, p0), pf1 = __builtin_bit_cast(bf16x8, p1);
            o0 = MFMA32(mk8(vf[0][0][0], vf[0][0][1]), pf0, o0); o0 = MFMA32(mk8(vf[0][1][0], vf[0][1][1]), pf1, o0);
            o1 = MFMA32(mk8(vf[1][0][0], vf[1][0][1]), pf0, o1); o1 = MFMA32(mk8(vf[1][1][0], vf[1][1][1]), pf1, o1);
            R *= tot;
            if (__ballot(R >= 0x1p-134f) == 0ull) break;
#pragma unroll
            for (int ks = 0; ks < 4; ++ks) kf[ks] = kn[ks];
#pragma unroll
            for (int db = 0; db < 2; ++db)
#pragma unroll
                for (int s = 0; s < 2; ++s) { vf[db][s][0] = vn[db][s][0]; vf[db][s][1] = vn[db][s][1]; }
        }
        float ss = 0.f;
#pragma unroll
        for (int r = 0; r < 16; ++r) ss += o0[r] * o0[r] + o1[r] * o1[r];
        ss += __shfl_xor(ss, 32);
        __syncthreads();
        if (hh == 0) red[h * 32 + n] = ss;
        __syncthreads();
        float tsum = 0.f;
#pragma unroll
        for (int w = 0; w < 8; ++w) tsum += red[w * 32 + n];
        const float rr = rsqrtf(tsum * (1.0f / 512) + EPS);
        f32x4 gwv[2][4];
#pragma unroll
        for (int db = 0; db < 2; ++db)
#pragma unroll
            for (int g = 0; g < 4; ++g) gwv[db][g] = *(const f32x4*)(p.g_sb + h * 64 + 32 * db + 8 * g + 4 * hh);
#pragma unroll
        for (int db = 0; db < 2; ++db)
#pragma unroll
            for (int g = 0; g < 4; ++g) {
                const int d0 = 32 * db + 8 * g + 4 * hh; const f32x4 gw = gwv[db][g];
                float v[4];
#pragma unroll
                for (int j = 0; j < 4; ++j) v[j] = (db == 0 ? o0[4 * g + j] : o1[4 * g + j]) * rr * gw[j];
                u32x2 w; w.x = cvt_pk_bf16(v[0], v[1]); w.y = cvt_pk_bf16(v[2], v[3]);
                *(u32x2*)(am + tokq * DM + 512 + h * 64 + d0) = w;
            }
    }
}

#define LDS_BAR() do { asm volatile("s_waitcnt lgkmcnt(0)" ::: "memory"); __builtin_amdgcn_s_barrier(); asm volatile("" ::: "memory"); } while (0)
constexpr int HSEG = 8;
__device__ __forceinline__ int seg_first(int s) { return s < 2 ? 9 * s : (s < 6 ? 18 + 8 * (s - 2) : 50 + 7 * (s - 6)); }
__device__ __forceinline__ int seg_len(int s) { return s < 2 ? 9 : (s < 6 ? 8 : 7); }
template <bool FULL>
__device__ void phase_hgseg(const Params& p, char* shm, int bh, int seg) {
    char* ws = p.ws; const int tid = opaque_tid(), w = tid >> 6, lane = tid & 63, fr = lane & 15, fq = lane >> 4, kp = tid & 63, r8 = tid >> 6;
    const int b = bh >> 2, h = bh & 3;
    const unsigned short* LF = (const unsigned short*)(ws + OFF_BC); const bf16_t* QT = (const bf16_t*)(ws + OFF_QT);
    const bf16_t* G = (const bf16_t*)(ws + OFF_QT + 3 * SZ_HALF); const bf16_t* VHT = (const bf16_t*)(ws + OFF_VHT);
    bf16_t* am = (bf16_t*)(ws + OFF_AMIX); float* parth = (float*)(ws + OFF_DC); float* SLOC = (float*)(ws + OFF_SLOC); float* DSEG = (float*)(ws + OFF_SLOC + 32 * MiB);
    float* qs = (float*)shm; float* dvec = (float*)(shm + 4096); float* red = (float*)(shm + 4608);
    char* sQs = shm + 8192; char* sQd = sQs + 17408; char* sKd = sQd + 17408; char* sP = sKd + 17408; char* keT = sP + 9216;
    f32x4 S[8];
#pragma unroll
    for (int kb = 0; kb < 8; ++kb) S[kb] = (f32x4){0.f, 0.f, 0.f, 0.f};
    f32x2 lfn[8]; unsigned qn[8]; bf16x8 vn[2]; u32x2 gn[4];
#define HG_LOAD(cc) do { const size_t _t0 = (size_t)b * NT + 64 * (cc); \
        _Pragma("unroll") for (int i = 0; i < 8; ++i) { const size_t a_ = (_t0 + 8 * r8 + i) * 512 + h * 128 + 2 * kp; lfn[i] = unpk_f16(*(const unsigned*)(LF + a_)); if (FULL) qn[i] = *(const unsigned*)(QT + a_); } \
        _Pragma("unroll") for (int ks = 0; ks < 2; ++ks) vn[ks] = *(const bf16x8*)(VHT + vt_off(h * 128 + 16 * w + fr, _t0) + 32 * ks + 8 * fq); \
        if (FULL) { _Pragma("unroll") for (int tb = 0; tb < 4; ++tb) gn[tb] = *(const u32x2*)(G + (_t0 + 16 * tb + fr) * 512 + h * 128 + 16 * w + 4 * fq); } } while (0)
    const int c0 = seg_first(seg), HCH = seg_len(seg);
    HG_LOAD(c0);
    if (FULL) {
        for (int s = 0; s < seg; ++s) {
            const float* sl = SLOC + ((size_t)(bh * HSEG + s) * 128 + 16 * w + fr) * 128 + 4 * fq; const float* ds = DSEG + (size_t)(bh * HSEG + s) * 128 + 4 * fq;
            f32x4 lv[8], dv[8];
#pragma unroll
            for (int kb = 0; kb < 8; ++kb) { lv[kb] = *(const f32x4*)(sl + 16 * kb); dv[kb] = *(const f32x4*)(ds + 16 * kb); }
#pragma unroll
            for (int kb = 0; kb < 8; ++kb) S[kb] = S[kb] * dv[kb] + lv[kb];
        }
    }
    f32x4 gw = {0.f, 0.f, 0.f, 0.f};
    if (FULL) gw = *(const f32x4*)(p.g_hg + h * 128 + 16 * w + 4 * fq);
    float dsum0 = 0.f, dsum1 = 0.f;
    for (int ci = 0; ci < HCH; ++ci) {
        const int c = c0 + ci; const size_t tok0 = (size_t)b * NT + 64 * c;
        f32x2 lfv[8], kkv[8]; unsigned qv[8]; bf16x8 vfr[2]; u32x2 gv[4];
#pragma unroll
        for (int i = 0; i < 8; ++i) { lfv[i] = lfn[i]; kkv[i].x = 1.0f - fexp2(lfn[i].x); kkv[i].y = 1.0f - fexp2(lfn[i].y); if (FULL) qv[i] = qn[i]; }
        vfr[0] = vn[0]; vfr[1] = vn[1];
        if (FULL) {
#pragma unroll
            for (int tb = 0; tb < 4; ++tb) gv[tb] = gn[tb];
        }
        { const int cn = ci < HCH - 1 ? c + 1 : c; HG_LOAD(cn); }
        f32x2 run = {0.f, 0.f};
#pragma unroll
        for (int i = 0; i < 8; ++i) { run += lfv[i]; lfv[i] = run; }
        *(f32x2*)(qs + r8 * 128 + 2 * kp) = run;
        LDS_BAR();
        if (FULL && ci > 0 && tid < 64) { float s = 0.f;
#pragma unroll
            for (int ww = 0; ww < 8; ++ww) s += red[ww * 64 + tid];
            parth[(tok0 - 64 + tid) * 4 + h] = s; }
        f32x2 off = {0.f, 0.f}, bmid = {0.f, 0.f}, blast = {0.f, 0.f};
#pragma unroll
        for (int j = 0; j < 8; ++j) { const f32x2 q = *(const f32x2*)(qs + j * 128 + 2 * kp); if (j < r8) off += q; if (j < 4) bmid += q; blast += q; }
        if (r8 == 0) { f32x2 d; d.x = fexp2(blast.x); d.y = fexp2(blast.y); *(f32x2*)(dvec + 2 * kp) = d; dsum0 += blast.x; dsum1 += blast.y; }
        f32x2 emid, elast;
        emid.x = fexp2(bmid.x); emid.y = fexp2(bmid.y); elast.x = fexp2(blast.x - bmid.x); elast.y = fexp2(blast.y - bmid.y);
        float ke0[8], ke1[8];
#pragma unroll
        for (int i = 0; i < 8; ++i) {
            const int t = 8 * r8 + i; const f32x2 bb = off + lfv[i];
            const float k0 = kkv[i].x, k1 = kkv[i].y;
            const float f0 = fexp2(bmid.x - bb.x), f1 = fexp2(bmid.y - bb.y);
            const float kd0 = k0 * f0, kd1 = k1 * f1;
            ke0[i] = kd0 * elast.x; ke1[i] = kd1 * elast.y;
            if (FULL) {
                const float e0 = fexp2(bb.x - bmid.x), e1 = fexp2(bb.y - bmid.y);
                const float qd0 = bflo(qv[i]) * e0, qd1 = bfhi(qv[i]) * e1;
                *(unsigned*)(sQd + t * 272 + kp * 4) = cvt_pk_bf16(qd0, qd1);
                *(unsigned*)(sQs + t * 272 + kp * 4) = cvt_pk_bf16(qd0 * emid.x, qd1 * emid.y);
                *(unsigned*)(sKd + t * 272 + kp * 4) = cvt_pk_bf16(kd0, kd1);
            }
        }
        { u32x4 a0, a1;
          a0.x = cvt_pk_bf16(ke0[0], ke0[1]); a0.y = cvt_pk_bf16(ke0[2], ke0[3]); a0.z = cvt_pk_bf16(ke0[4], ke0[5]); a0.w = cvt_pk_bf16(ke0[6], ke0[7]);
          a1.x = cvt_pk_bf16(ke1[0], ke1[1]); a1.y = cvt_pk_bf16(ke1[2], ke1[3]); a1.z = cvt_pk_bf16(ke1[4], ke1[5]); a1.w = cvt_pk_bf16(ke1[6], ke1[7]);
          *(u32x4*)(keT + (2 * kp) * 144 + r8 * 16) = a0; *(u32x4*)(keT + (2 * kp + 1) * 144 + r8 * 16) = a1; }
        LDS_BAR();
        if (FULL) {
            {
                const int tb = w >> 1;
                bf16x8 qf[4], kf[2][4];
#pragma unroll
                for (int ks = 0; ks < 4; ++ks) { qf[ks] = *(const bf16x8*)(sQd + (16 * tb + fr) * 272 + 64 * ks + 16 * fq);
#pragma unroll
                    for (int u = 0; u < 2; ++u) kf[u][ks] = *(const bf16x8*)(sKd + (16 * (2 * (w & 1) + u) + fr) * 272 + 64 * ks + 16 * fq); }
                __builtin_amdgcn_sched_barrier(0);
#pragma unroll
                for (int u = 0; u < 2; ++u) {
                    const int sb = 2 * (w & 1) + u;
                    f32x4 acc = {0.f, 0.f, 0.f, 0.f};
                    if (sb <= tb) {
#pragma unroll
                        for (int ks = 0; ks < 4; ++ks) acc = MFMA16(kf[u][ks], qf[ks], acc);
                    }
                    const int t = 16 * tb + fr, s0 = 16 * sb + 4 * fq;
#pragma unroll
                    for (int j = 0; j < 4; ++j) acc[j] = (s0 + j <= t) ? acc[j] : 0.f;
                    u32x2 o; o.x = cvt_pk_bf16(acc[0], acc[1]); o.y = cvt_pk_bf16(acc[2], acc[3]);
                    *(u32x2*)(sP + t * 144 + s0 * 2) = o;
                }
            }
            LDS_BAR();
            bf16x8 sb16[4];
#pragma unroll
            for (int ks = 0; ks < 4; ++ks) { u32x4 t4; t4.x = cvt_pk_bf16(S[2 * ks][0], S[2 * ks][1]); t4.y = cvt_pk_bf16(S[2 * ks][2], S[2 * ks][3]); t4.z = cvt_pk_bf16(S[2 * ks + 1][0], S[2 * ks + 1][1]); t4.w = cvt_pk_bf16(S[2 * ks + 1][2], S[2 * ks + 1][3]); sb16[ks] = __builtin_bit_cast(bf16x8, t4); }
            bf16x8 qsf[4][4], pf[4][2];
#pragma unroll
            for (int tb = 0; tb < 4; ++tb) {
#pragma unroll
                for (int ks = 0; ks < 4; ++ks) { const u32x2 lo = *(const u32x2*)(sQs + (16 * tb + fr) * 272 + (32 * ks + 4 * fq) * 2), hi = *(const u32x2*)(sQs + (16 * tb + fr) * 272 + (32 * ks + 16 + 4 * fq) * 2); qsf[tb][ks] = mk8(lo, hi); }
#pragma unroll
                for (int ks = 0; ks < 2; ++ks) pf[tb][ks] = *(const bf16x8*)(sP + (16 * tb + fr) * 144 + 64 * ks + 16 * fq);
            }
            __builtin_amdgcn_sched_barrier(0);
#pragma unroll
            for (int tb = 0; tb < 4; ++tb) {
                f32x4 acc = {0.f, 0.f, 0.f, 0.f};
#pragma unroll
                for (int ks = 0; ks < 4; ++ks) acc = MFMA16(sb16[ks], qsf[tb][ks], acc);
#pragma unroll
                for (int ks = 0; ks < 2; ++ks) acc = MFMA16(vfr[ks], pf[tb][ks], acc);
                float s = (acc[0] * acc[0] + acc[1] * acc[1]) + (acc[2] * acc[2] + acc[3] * acc[3]);
                s += __shfl_xor(s, 16); s += __shfl_xor(s, 32);
                if (fq == 0) red[w * 64 + 16 * tb + fr] = s;
                const u32x2 g2 = gv[tb];
                u32x2 o; o.x = cvt_pk_bf16(acc[0] * gw[0] * bflo(g2.x), acc[1] * gw[1] * bfhi(g2.x)); o.y = cvt_pk_bf16(acc[2] * gw[2] * bflo(g2.y), acc[3] * gw[3] * bfhi(g2.y));
                *(u32x2*)(am + (tok0 + 16 * tb + fr) * DM + h * 128 + 16 * w + 4 * fq) = o;
            }
        }
#pragma unroll
        for (int kg = 0; kg < 2; ++kg) {
            f32x4 dd[4]; bf16x8 kf[4][2];
#pragma unroll
            for (int q = 0; q < 4; ++q) { const int kb = 4 * kg + q; dd[q] = *(const f32x4*)(dvec + 16 * kb + 4 * fq);
#pragma unroll
                for (int ks = 0; ks < 2; ++ks) kf[q][ks] = *(const bf16x8*)(keT + (16 * kb + fr) * 144 + 64 * ks + 16 * fq); }
            __builtin_amdgcn_sched_barrier(0);
#pragma unroll
            for (int q = 0; q < 4; ++q) { const int kb = 4 * kg + q;
                f32x4 acc = S[kb] * dd[q];
#pragma unroll
                for (int ks = 0; ks < 2; ++ks) acc = MFMA16(kf[q][ks], vfr[ks], acc);
                S[kb] = acc; }
        }
    }
    if (FULL) {
        __syncthreads();
        if (tid < 64) { float s = 0.f;
#pragma unroll
            for (int ww = 0; ww < 8; ++ww) s += red[ww * 64 + tid];
            parth[((size_t)b * NT + 64 * (c0 + HCH - 1) + tid) * 4 + h] = s; }
    } else {
#pragma unroll
        for (int kb = 0; kb < 8; ++kb) *(f32x4*)(SLOC + ((size_t)(bh * HSEG + seg) * 128 + 16 * w + fr) * 128 + 16 * kb + 4 * fq) = S[kb];
        if (r8 == 0) { f32x2 d; d.x = fexp2(dsum0); d.y = fexp2(dsum1); *(f32x2*)(DSEG + (size_t)(bh * HSEG + seg) * 128 + 2 * kp) = d; }
    }
    __syncthreads();
#undef HG_LOAD
}

#define XB_TMO      128
#define XB_XCNT(j)  (256  + 64 * (j))
#define XB_XSUB(j)  (1280 + 64 * (j))
#define XB_XGEN(j)  (2304 + 64 * (j))
#define XB_TOP      3328
#define XB_TOPGEN   3392
#define XCD_BAR_WORDS 3456
#define XB_SPIN_CAP (1u << 18)
#define LAS __attribute__((address_space(3)))

__device__ __forceinline__ unsigned xb_ld(unsigned* p)              { return __hip_atomic_load(p, __ATOMIC_RELAXED, __HIP_MEMORY_SCOPE_AGENT); }
__device__ __forceinline__ unsigned xb_add(unsigned* p, unsigned v) { return __hip_atomic_fetch_add(p, v, __ATOMIC_RELAXED, __HIP_MEMORY_SCOPE_AGENT); }
__device__ __forceinline__ unsigned xb_xcc_id() { return (unsigned)__builtin_amdgcn_s_getreg((3 << 11) | 20) & 0xFu; }
#define XB_SPIN(cond, bar) do { unsigned _sp = 0; while (cond) { __builtin_amdgcn_s_sleep(1); \
    if ((++_sp & 255u) == 0u) { if (xb_ld(&(bar)[XB_TMO])) break; if (_sp > XB_SPIN_CAP) { atomicAdd(&(bar)[XB_TMO], 1u); break; } } } } while (0)

struct XcdBarrier {
    unsigned* bar; unsigned x;
    volatile LAS unsigned* st;
};

__device__ __forceinline__ XcdBarrier xcd_barrier_post(unsigned* bar, volatile LAS unsigned* st) {
    XcdBarrier b; b.bar = bar; b.x = xb_xcc_id(); b.st = st;
    if (threadIdx.x == 0) (void)xb_add(&bar[XB_XCNT(b.x)], 1u);
    return b;
}
__device__ __forceinline__ void xcd_barrier_complete(unsigned* bar, unsigned x, unsigned& nloc, unsigned& nx) {
    const unsigned G = gridDim.x * gridDim.y * gridDim.z;
    unsigned sum, cnt, mine, sp = 0u;
    for (;;) {
        sum = 0u; cnt = 0u; mine = 0u;
#pragma unroll
        for (unsigned j = 0; j < 16; ++j) { const unsigned c = xb_ld(&bar[XB_XCNT(j)]); sum += c; cnt += (c > 0u) ? 1u : 0u; mine = (j == x) ? c : mine; }
        if (sum == G) break;
        __builtin_amdgcn_s_sleep(1);
        if ((++sp & 255u) == 0u) { if (xb_ld(&bar[XB_TMO])) break; if (sp > XB_SPIN_CAP) { atomicAdd(&bar[XB_TMO], 1u); break; } }
    }
    nloc = mine > 0u ? mine : 1u; nx = cnt > 0u ? cnt : 1u;
}

__device__ __forceinline__ void xcd_barrier(const XcdBarrier& b) {
    asm volatile("s_waitcnt vmcnt(0)" ::: "memory");
    __syncthreads();
    if (threadIdx.x == 0) {
        unsigned* bar = b.bar;
        __builtin_amdgcn_s_waitcnt(0);
        unsigned nloc = b.st[0], nx = b.st[1];
        if (nloc == 0u) { xcd_barrier_complete(bar, b.x, nloc, nx); b.st[0] = nloc; b.st[1] = nx; }
        const unsigned old = xb_add(&bar[XB_XSUB(b.x)], 1u);
        const unsigned gen = old / nloc;
        if (old + 1u == (gen + 1u) * nloc) {
            __builtin_amdgcn_fence(__ATOMIC_RELEASE, "agent");
            asm volatile("s_waitcnt vmcnt(0)" ::: "memory");
            const unsigned og = xb_add(&bar[XB_TOP], 1u);
            const unsigned tg = og / nx;
            if (og + 1u == (tg + 1u) * nx) xb_add(&bar[XB_TOPGEN], 1u);
            else XB_SPIN(xb_ld(&bar[XB_TOPGEN]) == tg, bar);
            __builtin_amdgcn_fence(__ATOMIC_ACQUIRE, "agent");
            xb_add(&bar[XB_XGEN(b.x)], 1u);
            asm volatile("s_waitcnt vmcnt(0)" ::: "memory");
        } else {
            XB_SPIN(xb_ld(&bar[XB_XGEN(b.x)]) == gen, bar);
            __builtin_amdgcn_fence(__ATOMIC_ACQUIRE, "agent");
            asm volatile("s_waitcnt vmcnt(0)" ::: "memory");
        }
    }
    __syncthreads();
}


template <int PH> __device__ __forceinline__ void do_phase(const Params& p, char* shm) {
    char* ws = p.ws; char* epl = shm + SHM_B + 16;
    if (PH == 0) phase0(p, shm);
    if (PH == 1) {
        if (blockIdx.x & 1) phase0_rest(p, shm);
        run_gemm((const bf16_t*)(ws + OFF_XB), (const bf16_t*)(ws + OFF_WIN), MT, 2560, DM, shm, EpiIn{(const float*)(ws + OFF_RX), ws, epl});
        run_gemm((const bf16_t*)(ws + OFF_WIN) + (size_t)2560 * DM, (const bf16_t*)(ws + OFF_XB), 1024, MT, DM, shm, EpiVT{(const float*)(ws + OFF_RX), ws, epl});
        if (!(blockIdx.x & 1)) phase0_rest(p, shm);
    }
    if (PH == 2) { for (int u = blockIdx.x; u < 32 * HSEG; u += gridDim.x) if ((u & (HSEG - 1)) != HSEG - 1) phase_hgseg<false>(p, shm, u / HSEG, u & (HSEG - 1));
                   phase_attn(p, shm, (unsigned*)(ws + OFF_CNT) + 2 * 128 * 64); }
    if (PH == 3) { for (int u = blockIdx.x; u < 32 * HSEG; u += gridDim.x) phase_hgseg<true>(p, shm, u / HSEG, u & (HSEG - 1)); }
    if (PH == 5) run_gemm((const bf16_t*)(ws + OFF_AMIX), (const bf16_t*)(ws + OFF_WOUT), MT, DM, DM, shm,
                          EpiRes<1>{p.g_attn_post, (bf16_t*)(ws + OFF_XB), (float*)(ws + OFF_PART1), (unsigned*)(ws + OFF_CNT), (float*)(ws + OFF_PART2), epl, (const float*)(ws + OFF_DC)});
    if (PH == 7) {
        const bool ple_first = ((blockIdx.x >> 3) & 1) != 0;
        if (ple_first) run_gemm((const bf16_t*)(ws + OFF_PB), (const bf16_t*)(ws + OFF_WPP), MT, DM, PLE, shm, EpiBf16{(bf16_t*)(ws + OFF_PLE), DM});
        run_gemm((const bf16_t*)(ws + OFF_XB), (const bf16_t*)(ws + OFF_WGU), MT, 2 * DFF, DM, shm, EpiAct{(const float*)(ws + OFF_PART2), (bf16_t*)(ws + OFF_ACT), epl});
        if (!ple_first) run_gemm((const bf16_t*)(ws + OFF_PB), (const bf16_t*)(ws + OFF_WPP), MT, DM, PLE, shm, EpiBf16{(bf16_t*)(ws + OFF_PLE), DM});
    }
    if (PH == 8) run_gemm((const bf16_t*)(ws + OFF_ACT), (const bf16_t*)(ws + OFF_WDN), MT, DM, DFF, shm,
                          EpiRes<2>{p.g_ffn_post, (bf16_t*)(ws + OFF_XB), (float*)(ws + OFF_PART3), (unsigned*)(ws + OFF_CNT) + 128 * 64, nullptr, epl, nullptr});
    if (PH == 10) run_gemm((const bf16_t*)(ws + OFF_XB), (const bf16_t*)(ws + OFF_WPG), MT, DM, DM, shm, EpiFinal{p.out, (const bf16_t*)(ws + OFF_PLE), (const bf16_t*)(ws + OFF_XB)});
}
#if MEGA
__global__ __launch_bounds__(512) void k_mega(Params p) {
    extern __shared__ __attribute__((aligned(16))) char shm[];
    cg::grid_group grid = cg::this_grid();
    volatile LAS unsigned* st = (volatile LAS unsigned*)(shm + SHM_B);
    if (threadIdx.x < 2) st[threadIdx.x] = 0u;
    __syncthreads();
    const XcdBarrier xb = xcd_barrier_post((unsigned*)(p.ws + OFF_BAR), st);
    if (p.ws == nullptr) grid.sync();
    do_phase<0>(p, shm); xcd_barrier(xb);
    do_phase<1>(p, shm); xcd_barrier(xb);
    do_phase<2>(p, shm); xcd_barrier(xb);
    do_phase<3>(p, shm); xcd_barrier(xb);
    do_phase<5>(p, shm); xcd_barrier(xb);
    do_phase<7>(p, shm); xcd_barrier(xb);
    do_phase<8>(p, shm); xcd_barrier(xb);
    do_phase<10>(p, shm);
}
#else
template <int PH> __global__ __launch_bounds__(512) void k_phase(Params p) {
    extern __shared__ __attribute__((aligned(16))) char shm[];
    do_phase<PH>(p, shm);
}
template <int PH> static void launch_phase(const Params& p, hipStream_t s) {
    static bool attr = false;
    if (!attr) { (void)hipFuncSetAttribute((const void*)k_phase<PH>, hipFuncAttributeMaxDynamicSharedMemorySize, SHM_B); attr = true; }
    hipLaunchKernelGGL(k_phase<PH>, dim3(256), dim3(512), SHM_B, s, p);
}
#endif

extern "C" void kernel_launch(void* const* d_in, const int* in_sizes, int n_in, void* d_out, int out_size, void* d_ws, size_t ws_size, hipStream_t stream) {
    Params p{};
    p.x = (const float*)d_in[0]; p.p = (const float*)d_in[1]; p.g_attn_pre = (const float*)d_in[2]; p.w_in = (const float*)d_in[3]; p.gamma = (const float*)d_in[4];
    p.g_hg = (const float*)d_in[5]; p.g_sb = (const float*)d_in[6]; p.w_out = (const float*)d_in[7]; p.g_attn_post = (const float*)d_in[8]; p.g_ffn_pre = (const float*)d_in[9];
    p.w_gu = (const float*)d_in[10]; p.w_down = (const float*)d_in[11]; p.g_ffn_post = (const float*)d_in[12]; p.w_pp = (const float*)d_in[13]; p.w_pg = (const float*)d_in[14];
    p.out = (float*)d_out; p.ws = (char*)d_ws;
#if MEGA
    static int grid_blocks = 0;
    if (!grid_blocks) {
        int dev = 0, cus = 0, per_cu = 0;
        (void)hipGetDevice(&dev); (void)hipDeviceGetAttribute(&cus, hipDeviceAttributeMultiprocessorCount, dev);
        (void)hipFuncSetAttribute((const void*)k_mega, hipFuncAttributeMaxDynamicSharedMemorySize, LDS_TOTAL);
        (void)hipOccupancyMaxActiveBlocksPerMultiprocessor(&per_cu, (const void*)k_mega, 512, LDS_TOTAL);
        if (per_cu < 1) per_cu = 1;
        grid_blocks = cus * per_cu;
    }
    (void)hipMemsetAsync((char*)d_ws + OFF_BAR, 0, CTL_BYTES, stream);
    void* args[] = {&p};
    hipError_t e = hipLaunchCooperativeKernel((const void*)k_mega, dim3(grid_blocks), dim3(512), args, LDS_TOTAL, stream);
    if (e != hipSuccess) fprintf(stderr, "cooperative launch failed: %s (grid %d)\n", hipGetErrorString(e), grid_blocks);
#else
    launch_phase<0>(p, stream); launch_phase<1>(p, stream); launch_phase<2>(p, stream); launch_phase<3>(p, stream); launch_phase<5>(p, stream);
    launch_phase<7>(p, stream); launch_phase<8>(p, stream); launch_phase<10>(p, stream);
#endif
}
```

```cpp
#include <hip/hip_runtime.h>
#include <hip/hip_cooperative_groups.h>
#include <cstdio>
#include <cstdint>
namespace cg = cooperative_groups;

#ifndef MEGA
#define MEGA 1
#endif

typedef unsigned short bf16_t;
typedef short bf16x8 __attribute__((ext_vector_type(8)));
typedef float f32x4 __attribute__((ext_vector_type(4)));
typedef unsigned u32x4 __attribute__((ext_vector_type(4)));
typedef unsigned u32x2 __attribute__((ext_vector_type(2)));

constexpr int NB = 8, NT = 4096, DM = 1024, MT = NB * NT;
constexpr int NIN = 3584, DFF = 2816, PLE = 256;
constexpr float EPS = 1e-6f;
constexpr float LOG2E = 1.4426950408889634f;

constexpr size_t MiB = 1ull << 20;
constexpr size_t OFF_WIN = 0;
constexpr size_t OFF_WOUT = 7 * MiB;
constexpr size_t OFF_WGU = 9 * MiB;
constexpr size_t OFF_WDN = 20 * MiB;
constexpr size_t OFF_WPP = 26 * MiB;
constexpr size_t OFF_WPG = 27 * MiB;
constexpr size_t OFF_RX = 30 * MiB;
constexpr size_t OFF_RH1 = 31 * MiB;
constexpr size_t OFF_LB = 32 * MiB;
constexpr size_t OFF_PB = 40 * MiB;
constexpr size_t OFF_XB = 56 * MiB;
constexpr size_t OFF_SQ = 120 * MiB;
constexpr size_t OFF_Y = 56 * MiB;
constexpr size_t OFF_QT = 216 * MiB;
constexpr size_t OFF_BC = 344 * MiB;
constexpr size_t OFF_ACT = 216 * MiB;
constexpr size_t OFF_H2B = 216 * MiB;
constexpr size_t OFF_PLE = 408 * MiB;
constexpr size_t OFF_SLOC = 472 * MiB;
constexpr size_t OFF_AMIX = 408 * MiB;
constexpr size_t OFF_PART1 = 35 * MiB;
constexpr size_t OFF_PART2 = 36 * MiB;
constexpr size_t OFF_PART3 = 37 * MiB;
constexpr size_t OFF_CNT = 34 * MiB + 16384;
constexpr size_t CTL_BYTES = 16384 + 2 * 128 * 64 * 4 + 256;
constexpr size_t OFF_BAR = 34 * MiB;
constexpr size_t OFF_DC = 33 * MiB;
constexpr size_t OFF_U = 56 * MiB;
constexpr size_t OFF_SC = 120 * MiB;
constexpr size_t OFF_VHT = 216 * MiB + 2 * (32 * MiB);
constexpr size_t OFF_SVT = 120 * MiB + 2 * (32 * MiB);
constexpr size_t SZ_HALF = 32 * MiB;

struct Params {
    const float *x, *p, *g_attn_pre, *w_in, *gamma, *g_hg, *g_sb, *w_out, *g_attn_post, *g_ffn_pre, *w_gu, *w_down, *g_ffn_post, *w_pp, *w_pg;
    float* out; char* ws;
};

typedef __bf16 bf2_t __attribute__((ext_vector_type(2)));
typedef float f32x2 __attribute__((ext_vector_type(2)));
typedef float f32x16 __attribute__((ext_vector_type(16)));
typedef _Float16 h16x2 __attribute__((ext_vector_type(2)));
__device__ __forceinline__ unsigned cvt_pk_f16(float lo, float hi) { f32x2 v = {lo, hi}; return __builtin_bit_cast(unsigned, __builtin_convertvector(v, h16x2)); }
__device__ __forceinline__ f32x2 unpk_f16(unsigned u) { return __builtin_convertvector(__builtin_bit_cast(h16x2, u), f32x2); }
__device__ __forceinline__ unsigned cvt_pk_bf16(float lo, float hi) { f32x2 v = {lo, hi}; return __builtin_bit_cast(unsigned, __builtin_convertvector(v, bf2_t)); }
__device__ __forceinline__ size_t vt_off(int ch, size_t tok) { return ((tok >> 6) * 512 + (size_t)ch) * 64 + (tok & 63); }
__device__ __forceinline__ float bf2f(bf16_t h) { return __uint_as_float(((unsigned)h) << 16); }
__device__ __forceinline__ float bflo(unsigned u) { return __uint_as_float(u << 16); }
__device__ __forceinline__ float bfhi(unsigned u) { return __uint_as_float(u & 0xffff0000u); }
__device__ __forceinline__ float fexp2(float x) { return __builtin_amdgcn_exp2f(x); }
__device__ __forceinline__ float frcp(float x) { return __builtin_amdgcn_rcpf(x); }
__device__ __forceinline__ float sigmoidf_(float x) { return frcp(1.0f + fexp2(-x * LOG2E)); }
__device__ __forceinline__ float siluf_(float x) { return x * sigmoidf_(x); }
__device__ __forceinline__ float wave_sum(float v) {
#pragma unroll
    for (int o = 32; o >= 1; o >>= 1) v += __shfl_xor(v, o);
    return v;
}

__device__ __forceinline__ int opaque_tid() { int t = threadIdx.x; asm volatile("" : "+v"(t)); return t; }

namespace pg8 {
#define PG8_LAS __attribute__((address_space(3)))
typedef unsigned short bf16_t;
typedef short bf16x8 __attribute__((ext_vector_type(8)));
typedef float f32x4 __attribute__((ext_vector_type(4)));
typedef unsigned u32x4 __attribute__((ext_vector_type(4)));
constexpr int BM = 256, BK = 64, HALF = 128, HTB = HALF * BK * 2  , STAGE_BYTES = 8 * HTB, NXCD = 8, WGM = 8;

__host__ __device__ __forceinline__ int lds_byte(int r, int c) { const int st = (r >> 4) * 2 + (c >> 5), rr = r & 15, cc = c & 31, ob = rr * 64 + cc * 2; return st * 1024 + (ob ^ (((ob >> 9) & 1) << 5)); }
__host__ __device__ __forceinline__ void stage_rc(int b, int& R, int& C) { const int st = b / 1024, sb = b % 1024, swz = sb ^ (((sb >> 9) & 1) << 5); R = (st >> 1) * 16 + swz / 64; C = (st & 1) * 32 + (swz % 64) / 2; }
__host__ __device__ __forceinline__ int perm32(int rho) { const int n = rho >> 4, i = rho & 15; return 8 * (i >> 2) + 4 * n + (i & 3); }

struct Unit { int pm, pn; };
struct Gemm { const bf16_t* A; const bf16_t* Bt; int M, N, K; };

struct StaticOrder {
    int nM, nN, nwg, G, c;
    __host__ __device__ void init(int M, int N, int G_, int c_) { nM = M / BM; nN = N / BM; nwg = nM * nN; G = G_; c = c_; }
    __host__ __device__ bool next(int i, Unit& u) const {
        const long L = (long)i * G + c; if (L >= nwg) return false;
        int wgid = (int)L; { const int q = nwg / NXCD, r = nwg % NXCD, xcd = wgid % NXCD, off = wgid / NXCD; wgid = (xcd < r ? xcd * (q + 1) : r * (q + 1) + (xcd - r) * q) + off; }
        const int nig = WGM * nN, gid = wgid / nig, fm = gid * WGM, gsz = (nM - fm) < WGM ? (nM - fm) : WGM;
        u.pm = fm + ((wgid % nig) % gsz); u.pn = (wgid % nig) / gsz; return true;
    }
    __device__ __forceinline__ void a_ready(const Unit&) const {}
    __device__ __forceinline__ void done(const Unit&) const {}
};
template <class Epi, class Sched, bool ALIGN_EPI = false, bool SP2 = false>
__device__ __forceinline__ void gemm_phase(PG8_LAS unsigned char* lds, const Gemm g, const Sched& S, const Epi& E) {
    const int tid = opaque_tid(), wid = __builtin_amdgcn_readfirstlane(tid >> 6), lane = tid & 63, wr = wid >> 2, wc = wid & 3, fr = lane & 15, fq = lane >> 4;
    const int K = g.K, nt = K / BK;
    unsigned voffA[2], voffB[2];
#pragma unroll
    for (int i = 0; i < 2; ++i) { int R, C; stage_rc(tid * 16 + i * 8192, R, C); const int Rb = Epi::PERM ? ((R & ~31) + perm32(R & 31)) : R;
        voffA[i] = (unsigned)(R * K + C) * 2u; voffB[i] = (unsigned)(Rb * K + C) * 2u; }
    const size_t kstep = (size_t)(BK * 2);
    const size_t hstep = (size_t)HALF * K * 2;
    const size_t tstep = 2 * hstep;
    const unsigned ldsw = (unsigned)wid * 1024u;
    const int aoff = lds_byte(wr * 64 + fr, fq * 8), boff = lds_byte(wc * 32 + fr, fq * 8);
#define PG8_SA(b, h) (((b) * 2 + (h)) * HTB)
#define PG8_SB(b, h) ((4 + (b) * 2 + (h)) * HTB)
#define PG8_STAGE(bufoff, gbase, voff) do { _Pragma("unroll") for (int _i = 0; _i < 2; ++_i) \
        __builtin_amdgcn_global_load_lds((const unsigned*)((const char*)(gbase) + (voff)[_i]), (PG8_LAS unsigned*)(lds + (bufoff) + ldsw + _i * 8192), 16, 0, 0); } while (0)
#define PG8_LDA(dst, b, h) do { _Pragma("unroll") for (int m = 0; m < 4; ++m) _Pragma("unroll") for (int k = 0; k < 2; ++k) dst[m][k] = *(const PG8_LAS bf16x8*)(lds + PG8_SA(b, h) + aoff + m * 2048 + k * 1024); } while (0)
#define PG8_LDB(dst, b, h) do { _Pragma("unroll") for (int n = 0; n < 2; ++n) _Pragma("unroll") for (int k = 0; k < 2; ++k) dst[n][k] = *(const PG8_LAS bf16x8*)(lds + PG8_SB(b, h) + boff + n * 2048 + k * 1024); } while (0)
#define PG8_MMA(ai, bj, At, Bt) do { __builtin_amdgcn_s_setprio(1); _Pragma("unroll") for (int m = 0; m < 4; ++m) _Pragma("unroll") for (int n = 0; n < 2; ++n) _Pragma("unroll") for (int k = 0; k < 2; ++k) \
        acc[ai][bj][m][n] = __builtin_amdgcn_mfma_f32_16x16x32_bf16(Bt[n][k], At[m][k], acc[ai][bj][m][n], 0, 0, 0); __builtin_amdgcn_s_setprio(0); } while (0)
#define PG8_WAIT_V(n) asm volatile("s_waitcnt vmcnt(" #n ")" ::: "memory")
#define PG8_WAIT_L(n) asm volatile("s_waitcnt lgkmcnt(" #n ")" ::: "memory")
#define PG8_BAR __builtin_amdgcn_s_barrier()
#define PG8_SCHED __builtin_amdgcn_sched_barrier(0)
    Unit cur, nxt; int ui = 0;
    if (!S.next(0, cur)) return;
    f32x4 acc[2][2][4][2];
#pragma unroll
    for (int a = 0; a < 2; ++a)
#pragma unroll
        for (int b = 0; b < 2; ++b)
#pragma unroll
            for (int m = 0; m < 4; ++m)
#pragma unroll
                for (int n = 0; n < 2; ++n) acc[a][b][m][n] = (f32x4){0.f, 0.f, 0.f, 0.f};
    bf16x8 At[4][2], B0[2][2], B1[2][2];
    const char* cA = (const char*)g.A + (size_t)cur.pm * tstep; const char* cB = (const char*)g.Bt + (size_t)cur.pn * tstep;
    S.a_ready(cur);
    if constexpr (Epi::MIDSCALE) E.load_mid(cur);
    typename Epi::Pre pre = {};
    if constexpr (Epi::ROWPRE) pre = E.pre_issue(cur);
    if constexpr (SP2) {
        PG8_STAGE(PG8_SB(0, 0), cB, voffB); PG8_STAGE(PG8_SB(0, 1), cB + hstep, voffB); PG8_STAGE(PG8_SA(0, 0), cA, voffA); PG8_STAGE(PG8_SA(0, 1), cA + hstep, voffA);
        if (wr == 1) PG8_BAR;
        PG8_WAIT_V(2); PG8_BAR;
        PG8_STAGE(PG8_SB(1, 0), cB + kstep, voffB); PG8_STAGE(PG8_SA(1, 0), cA + kstep, voffA); PG8_STAGE(PG8_SB(1, 1), cB + hstep + kstep, voffB);
        PG8_WAIT_V(6); PG8_BAR;
    } else {
        PG8_STAGE(PG8_SB(0, 0), cB, voffB); PG8_STAGE(PG8_SA(0, 0), cA, voffA); PG8_STAGE(PG8_SB(0, 1), cB + hstep, voffB); PG8_STAGE(PG8_SA(0, 1), cA + hstep, voffA);
        if (wr == 1) PG8_BAR;
        PG8_WAIT_V(4); PG8_BAR;
        PG8_STAGE(PG8_SB(1, 0), cB + kstep, voffB); PG8_STAGE(PG8_SA(1, 0), cA + kstep, voffA); PG8_STAGE(PG8_SB(1, 1), cB + hstep + kstep, voffB);
        PG8_WAIT_V(6); PG8_BAR;
    }
    for (;;) {
        const bool has_next = S.next(ui + 1, nxt);
        const char* nA = has_next ? (const char*)g.A + (size_t)nxt.pm * tstep : cA; const char* nB = has_next ? (const char*)g.Bt + (size_t)nxt.pn * tstep : cB;
        for (int t = 0; t < nt; t += 2) {
            const bool last = (t == nt - 2);
            const char* a1 = cA + (size_t)(t + 1) * kstep;
            const char* a2 = last ? nA : cA + (size_t)(t + 2) * kstep; const char* b2 = last ? nB : cB + (size_t)(t + 2) * kstep;
            const char* a3 = a2 + kstep; const char* b3 = b2 + kstep;
            if (last && has_next) S.a_ready(nxt);
            if constexpr (Epi::ROWPRE) { if (t == 8) E.pre_commit(pre); }
            if constexpr (Epi::MIDSCALE) { if (t == Epi::MID_T) {
_Pragma("unroll") for (int a = 0; a < 2; ++a) _Pragma("unroll") for (int m = 0; m < 4; ++m) { const float sc_ = E.mid_scale(a * HALF + wr * 64 + m * 16 + fr);
_Pragma("unroll") for (int b = 0; b < 2; ++b) _Pragma("unroll") for (int n = 0; n < 2; ++n) acc[a][b][m][n] = acc[a][b][m][n] * sc_; } } }
            if constexpr (SP2) {
            PG8_LDB(B0, 0, 0); PG8_LDB(B1, 0, 1); PG8_SCHED; PG8_LDA(At, 0, 0); PG8_STAGE(PG8_SA(1, 1), a1 + hstep, voffA);
            PG8_WAIT_V(8); PG8_WAIT_L(0); PG8_BAR; PG8_MMA(0, 0, At, B0); PG8_MMA(0, 1, At, B1); PG8_BAR; PG8_SCHED;
            PG8_LDA(At, 0, 1); PG8_STAGE(PG8_SB(0, 0), b2, voffB); PG8_STAGE(PG8_SB(0, 1), b2 + hstep, voffB); PG8_STAGE(PG8_SA(0, 0), a2, voffA);
            PG8_WAIT_V(8); PG8_WAIT_L(0); PG8_BAR; PG8_MMA(1, 0, At, B0); PG8_MMA(1, 1, At, B1); PG8_BAR; PG8_SCHED;
            PG8_LDB(B0, 1, 0); PG8_LDB(B1, 1, 1); PG8_SCHED; PG8_LDA(At, 1, 0); PG8_STAGE(PG8_SA(0, 1), a2 + hstep, voffA);
            PG8_WAIT_V(8); PG8_WAIT_L(0); PG8_BAR; PG8_MMA(0, 0, At, B0); PG8_MMA(0, 1, At, B1); PG8_BAR; PG8_SCHED;
            PG8_LDA(At, 1, 1); PG8_STAGE(PG8_SB(1, 0), b3, voffB); PG8_STAGE(PG8_SB(1, 1), b3 + hstep, voffB); PG8_STAGE(PG8_SA(1, 0), a3, voffA);
            PG8_WAIT_V(8); PG8_WAIT_L(0); PG8_BAR; PG8_MMA(1, 0, At, B0); PG8_MMA(1, 1, At, B1); PG8_BAR; PG8_SCHED;
            } else {
            PG8_LDB(B0, 0, 0); PG8_SCHED; PG8_LDA(At, 0, 0); PG8_STAGE(PG8_SA(1, 1), a1 + hstep, voffA);
            PG8_WAIT_L(8); PG8_BAR; PG8_WAIT_L(0); PG8_MMA(0, 0, At, B0); PG8_BAR; PG8_SCHED;
            PG8_LDB(B1, 0, 1); PG8_STAGE(PG8_SB(0, 0), b2, voffB);
            PG8_BAR; PG8_WAIT_L(0); PG8_MMA(0, 1, At, B1); PG8_BAR;
            PG8_LDA(At, 0, 1); PG8_STAGE(PG8_SA(0, 0), a2, voffA);
            PG8_BAR; PG8_WAIT_L(0); PG8_MMA(1, 0, At, B0); PG8_BAR; PG8_SCHED;
            PG8_STAGE(PG8_SB(0, 1), b2 + hstep, voffB);
            PG8_WAIT_V(6); PG8_BAR; PG8_MMA(1, 1, At, B1); PG8_BAR;
            PG8_LDB(B0, 1, 0); PG8_SCHED; PG8_LDA(At, 1, 0); PG8_STAGE(PG8_SA(0, 1), a2 + hstep, voffA);
            PG8_WAIT_L(8); PG8_BAR; PG8_WAIT_L(0); PG8_MMA(0, 0, At, B0); PG8_BAR; PG8_SCHED;
            PG8_LDB(B1, 1, 1); PG8_STAGE(PG8_SB(1, 0), b3, voffB);
            PG8_BAR; PG8_WAIT_L(0); PG8_MMA(0, 1, At, B1); PG8_BAR;
            PG8_LDA(At, 1, 1); PG8_STAGE(PG8_SA(1, 0), a3, voffA);
            PG8_BAR; PG8_WAIT_L(0); PG8_MMA(1, 0, At, B0); PG8_BAR; PG8_SCHED;
            PG8_STAGE(PG8_SB(1, 1), b3 + hstep, voffB);
            PG8_WAIT_V(6); PG8_BAR; PG8_MMA(1, 1, At, B1); PG8_BAR;
            }
        }
        if constexpr (ALIGN_EPI) { if (wr == 0) PG8_BAR; }
        if constexpr (!Epi::AFTER_DRAIN) { E(acc, cur, wr, wc, fr, fq); S.done(cur); }
        if (!has_next) break;
#pragma unroll
        for (int a = 0; a < 2; ++a)
#pragma unroll
            for (int b = 0; b < 2; ++b)
#pragma unroll
                for (int m = 0; m < 4; ++m)
#pragma unroll
                    for (int n = 0; n < 2; ++n) acc[a][b][m][n] = (f32x4){0.f, 0.f, 0.f, 0.f};
        cur = nxt; cA = nA; cB = nB; ++ui;
        if constexpr (Epi::MIDSCALE) E.load_mid(cur);
        if constexpr (Epi::ROWPRE) pre = E.pre_issue(cur);
        if constexpr (ALIGN_EPI) { if (wr == 1) PG8_BAR; }
    }
    PG8_WAIT_V(0);
    if constexpr (!ALIGN_EPI) { if (wr == 0) PG8_BAR; }
    PG8_BAR;
    if constexpr (Epi::AFTER_DRAIN) { E.fused(acc, cur, wr, wc, fr, fq, lds, wid, lane); S.done(cur); }
#undef PG8_SA
#undef PG8_SB
#undef PG8_STAGE
#undef PG8_LDA
#undef PG8_LDB
#undef PG8_MMA
#undef PG8_WAIT_V
#undef PG8_WAIT_L
#undef PG8_BAR
#undef PG8_SCHED
}
}

#define EPI_ARGS const f32x4 (&acc)[2][2][4][2], const pg8::Unit& u, int wr, int wc, int fr, int fq
#define EPI_HEAD static constexpr bool PERM = true, AFTER_DRAIN = false, MIDSCALE = false, ROWPRE = false; typedef int Pre;
#define EPI_HEAD_PRE(T) static constexpr bool PERM = true, AFTER_DRAIN = false, MIDSCALE = false, ROWPRE = true; typedef T Pre;
#define EPI_RC const int brow = u.pm * 256, bcol = u.pn * 256;
constexpr int HALF = 128, SHM_B = 131072, LDS_TOTAL = SHM_B + 16 + 4096 + 1024;
struct EpiIn {
    EPI_HEAD_PRE(float)
    const float* rx; char* ws; char* lds;
    __device__ __forceinline__ float pre_issue(const pg8::Unit& u) const { return threadIdx.x < 256 ? rx[u.pm * 256 + threadIdx.x] : 0.f; }
    __device__ __forceinline__ void pre_commit(float v) const { if (threadIdx.x < 256) ((float*)(lds + 4096))[threadIdx.x] = v; }
    __device__ __forceinline__ void operator()(EPI_ARGS) const { EPI_RC
        const int kind = bcol >> 9;
        const int lc0 = (bcol & 256) + wc * 32 + 8 * fq;
        bf16_t* dst = (bf16_t*)(ws + (kind == 0 ? OFF_QT : kind == 1 ? OFF_QT + SZ_HALF : kind == 2 ? OFF_QT + 3 * SZ_HALF : kind == 3 ? OFF_SQ : OFF_SQ + SZ_HALF));
        if (kind == 1) {
            float* dstf = (float*)(ws + OFF_BC); const float* lbp = (const float*)(ws + OFF_LB);
#pragma unroll
            for (int bj = 0; bj < 2; ++bj)
#pragma unroll
                for (int n = 0; n < 2; ++n) {
                    const f32x4 l0 = *(const f32x4*)(lbp + lc0 + bj * HALF + 4 * n), m0 = *(const f32x4*)(lbp + 512 + lc0 + bj * HALF + 4 * n);
                    float rsv[2][4];
#pragma unroll
                    for (int ai = 0; ai < 2; ++ai)
#pragma unroll
                        for (int m = 0; m < 4; ++m) rsv[ai][m] = ((const float*)(lds + 4096))[ai * HALF + wr * 64 + m * 16 + fr];
#pragma unroll
                    for (int ai = 0; ai < 2; ++ai)
#pragma unroll
                        for (int m = 0; m < 4; ++m) {
                            const int row = brow + ai * HALF + wr * 64 + m * 16 + fr; const float rs = rsv[ai][m];
                            const f32x4 z = acc[ai][bj][m][n] * rs; f32x4 lf;
#pragma unroll
                            for (int j = 0; j < 4; ++j) { const float s = sigmoidf_(z[j]); lf[j] = __builtin_amdgcn_logf(l0[j] + m0[j] * s)  ; }
                            const size_t o = (size_t)row * 512 + lc0 + bj * HALF + 4 * n;
                            u32x2 w; w.x = cvt_pk_f16(lf[0], lf[1]); w.y = cvt_pk_f16(lf[2], lf[3]); *(u32x2*)((unsigned short*)dstf + o) = w;
                        }
                }
            return;
        }
        float rsv[2][4];
#pragma unroll
        for (int ai = 0; ai < 2; ++ai)
#pragma unroll
            for (int m = 0; m < 4; ++m) rsv[ai][m] = ((const float*)(lds + 4096))[ai * HALF + wr * 64 + m * 16 + fr] * (kind == 3 ? 0.125f * LOG2E : 1.0f);
#pragma unroll
        for (int ai = 0; ai < 2; ++ai)
#pragma unroll
            for (int m = 0; m < 4; ++m) {
                const int row = brow + ai * HALF + wr * 64 + m * 16 + fr;
                const float rs = rsv[ai][m];
#pragma unroll
                for (int bj = 0; bj < 2; ++bj) {
                    f32x4 v0 = acc[ai][bj][m][0] * rs, v1 = acc[ai][bj][m][1] * rs;
                    if (kind == 0 || kind == 2) {
#pragma unroll
                        for (int j = 0; j < 4; ++j) { v0[j] = siluf_(v0[j]); v1[j] = siluf_(v1[j]); }
                    }
                    u32x4 w; w.x = cvt_pk_bf16(v0[0], v0[1]); w.y = cvt_pk_bf16(v0[2], v0[3]); w.z = cvt_pk_bf16(v1[0], v1[1]); w.w = cvt_pk_bf16(v1[2], v1[3]);
                    *(u32x4*)(dst + (size_t)row * 512 + lc0 + bj * HALF) = w;
                }
            }
    }
};
struct EpiVT {
    EPI_HEAD_PRE(float)
    const float* rx; char* ws; char* lds;
    __device__ __forceinline__ float pre_issue(const pg8::Unit& u) const { return threadIdx.x < 256 ? rx[u.pn * 256 + threadIdx.x] : 0.f; }
    __device__ __forceinline__ void pre_commit(float v) const { if (threadIdx.x < 256) ((float*)(lds + 4096))[threadIdx.x] = v; }
    __device__ __forceinline__ void operator()(EPI_ARGS) const { EPI_RC
        bf16_t* dst = (bf16_t*)(ws + (brow < 512 ? OFF_VHT : OFF_SVT));
        const int r0 = (brow & 511) + wr * 64 + fr, c0 = bcol + wc * 32 + 8 * fq;
#pragma unroll
        for (int bj = 0; bj < 2; ++bj) {
            const f32x4 s0 = *(const f32x4*)((const float*)(lds + 4096) + wc * 32 + 8 * fq + bj * HALF), s1 = *(const f32x4*)((const float*)(lds + 4096) + wc * 32 + 8 * fq + bj * HALF + 4);
#pragma unroll
            for (int ai = 0; ai < 2; ++ai)
#pragma unroll
                for (int m = 0; m < 4; ++m) {
                    const f32x4 v0 = acc[ai][bj][m][0] * s0, v1 = acc[ai][bj][m][1] * s1;
                    u32x4 w; w.x = cvt_pk_bf16(v0[0], v0[1]); w.y = cvt_pk_bf16(v0[2], v0[3]); w.z = cvt_pk_bf16(v1[0], v1[1]); w.w = cvt_pk_bf16(v1[2], v1[3]);
                    *(u32x4*)(dst + vt_off(r0 + ai * HALF + m * 16, (size_t)(c0 + bj * HALF))) = w;
                }
        }
    }
};
struct EpiF32 {
    EPI_HEAD
    float* C; int ldc;
    __device__ __forceinline__ void operator()(EPI_ARGS) const { EPI_RC
#pragma unroll
        for (int ai = 0; ai < 2; ++ai)
#pragma unroll
            for (int m = 0; m < 4; ++m) {
                float* rp = C + (size_t)(brow + ai * HALF + wr * 64 + m * 16 + fr) * ldc + bcol + wc * 32 + 8 * fq;
#pragma unroll
                for (int bj = 0; bj < 2; ++bj) { *(f32x4*)(rp + bj * HALF) = acc[ai][bj][m][0]; *(f32x4*)(rp + bj * HALF + 4) = acc[ai][bj][m][1]; }
            }
    }
};
struct EpiBf16 {
    EPI_HEAD
    bf16_t* C; int ldc;
    __device__ __forceinline__ void operator()(EPI_ARGS) const { EPI_RC
#pragma unroll
        for (int ai = 0; ai < 2; ++ai)
#pragma unroll
            for (int m = 0; m < 4; ++m) {
                bf16_t* rp = C + (size_t)(brow + ai * HALF + wr * 64 + m * 16 + fr) * ldc + bcol + wc * 32 + 8 * fq;
#pragma unroll
                for (int bj = 0; bj < 2; ++bj) {
                    const f32x4 v0 = acc[ai][bj][m][0], v1 = acc[ai][bj][m][1];
                    u32x4 w; w.x = cvt_pk_bf16(v0[0], v0[1]); w.y = cvt_pk_bf16(v0[2], v0[3]); w.z = cvt_pk_bf16(v1[0], v1[1]); w.w = cvt_pk_bf16(v1[2], v1[3]);
                    *(u32x4*)(rp + bj * HALF) = w;
                }
            }
    }
};
struct EpiAct {
    EPI_HEAD_PRE(f32x4)
    const float* rh; bf16_t* act; char* lds;
    __device__ __forceinline__ f32x4 pre_issue(const pg8::Unit& u) const { return threadIdx.x < 256 ? *(const f32x4*)(rh + (size_t)(u.pm * 256 + threadIdx.x) * 4) : (f32x4){0.f, 0.f, 0.f, 0.f}; }
    __device__ __forceinline__ void pre_commit(f32x4 q) const { if (threadIdx.x < 256) ((float*)(lds + 4096))[threadIdx.x] = rsqrtf(((q[0] + q[1]) + (q[2] + q[3])) * (1.0f / DM) + EPS); }
    __device__ __forceinline__ void operator()(EPI_ARGS) const { EPI_RC
        const int c0 = (bcol >> 1) + wc * 32 + 8 * fq;
        float rsv[2][4];
#pragma unroll
        for (int ai = 0; ai < 2; ++ai)
#pragma unroll
            for (int m = 0; m < 4; ++m) rsv[ai][m] = ((const float*)(lds + 4096))[ai * HALF + wr * 64 + m * 16 + fr];
#pragma unroll
        for (int ai = 0; ai < 2; ++ai)
#pragma unroll
            for (int m = 0; m < 4; ++m) {
                const int row = brow + ai * HALF + wr * 64 + m * 16 + fr;
                const float rs = rsv[ai][m];
                float o[8];
#pragma unroll
                for (int n = 0; n < 2; ++n)
#pragma unroll
                    for (int j = 0; j < 4; ++j) { const float g = acc[ai][0][m][n][j] * rs, u = acc[ai][1][m][n][j] * rs; o[n * 4 + j] = siluf_(g) * u; }
                u32x4 w; w.x = cvt_pk_bf16(o[0], o[1]); w.y = cvt_pk_bf16(o[2], o[3]); w.z = cvt_pk_bf16(o[4], o[5]); w.w = cvt_pk_bf16(o[6], o[7]);
                *(u32x4*)(act + (size_t)row * DFF + c0) = w;
            }
    }
};
struct EpiFinal {
    EPI_HEAD
    float* out; const bf16_t* ple; const bf16_t* h2;
    __device__ __forceinline__ void operator()(EPI_ARGS) const { EPI_RC
#pragma unroll
        for (int ai = 0; ai < 2; ++ai)
#pragma unroll
            for (int mp = 0; mp < 1; ++mp) {
                u32x4 pv[4][2], hv[4][2];
#pragma unroll
                for (int mm = 0; mm < 4; ++mm)
#pragma unroll
                    for (int bj = 0; bj < 2; ++bj) {
                        const size_t ro = (size_t)(brow + ai * HALF + wr * 64 + (4 * mp + mm) * 16 + fr) * DM + bcol + wc * 32 + 8 * fq + bj * HALF;
                        pv[mm][bj] = *(const u32x4*)(ple + ro); hv[mm][bj] = *(const u32x4*)(h2 + ro);
                    }
#pragma unroll
                for (int mm = 0; mm < 4; ++mm)
#pragma unroll
                    for (int bj = 0; bj < 2; ++bj) {
                        const int m = 4 * mp + mm;
                        const size_t ro = (size_t)(brow + ai * HALF + wr * 64 + m * 16 + fr) * DM + bcol + wc * 32 + 8 * fq + bj * HALF;
                        const f32x4 a0 = acc[ai][bj][m][0], a1 = acc[ai][bj][m][1]; const u32x4 q = pv[mm][bj], hq = hv[mm][bj]; f32x4 x0, x1;
                        x0[0] = bflo(hq.x) + bflo(q.x) * sigmoidf_(a0[0]); x0[1] = bfhi(hq.x) + bfhi(q.x) * sigmoidf_(a0[1]); x0[2] = bflo(hq.y) + bflo(q.y) * sigmoidf_(a0[2]); x0[3] = bfhi(hq.y) + bfhi(q.y) * sigmoidf_(a0[3]);
                        x1[0] = bflo(hq.z) + bflo(q.z) * sigmoidf_(a1[0]); x1[1] = bfhi(hq.z) + bfhi(q.z) * sigmoidf_(a1[1]); x1[2] = bflo(hq.w) + bflo(q.w) * sigmoidf_(a1[2]); x1[3] = bfhi(hq.w) + bfhi(q.w) * sigmoidf_(a1[3]);
                        *(f32x4*)(out + ro) = x0; *(f32x4*)(out + ro + 4) = x1;
                    }
            }
    }
};

template <int WHICH> struct EpiRes {
    static constexpr bool PERM = true, AFTER_DRAIN = false, MIDSCALE = (WHICH == 1), ROWPRE = false; typedef int Pre; static constexpr int MID_T = 8;
    const float* gain; bf16_t* hb; float* part; unsigned* cnt; float* part2; char* lds; const float* parth;
    __device__ __forceinline__ void load_mid(const pg8::Unit& u) const {
        if (threadIdx.x < 256) { const f32x4 q = *(const f32x4*)(parth + (size_t)(u.pm * 256 + threadIdx.x) * 4); ((float*)(lds + 4096))[threadIdx.x] = rsqrtf(((q[0] + q[1]) + (q[2] + q[3])) * (1.0f / 512) + EPS); }
    }
    __device__ __forceinline__ float mid_scale(int r) const { return ((const float*)(lds + 4096))[r]; }
    __device__ __forceinline__ void operator()(EPI_ARGS) const { EPI_RC
        float* red = (float*)lds; const int tid = threadIdx.x;
#pragma unroll
        for (int ai = 0; ai < 2; ++ai)
#pragma unroll
            for (int m = 0; m < 4; ++m) {
                float s = 0.f;
#pragma unroll
                for (int bj = 0; bj < 2; ++bj)
#pragma unroll
                    for (int n = 0; n < 2; ++n) { const f32x4 v = acc[ai][bj][m][n]; s += (v[0] * v[0] + v[1] * v[1]) + (v[2] * v[2] + v[3] * v[3]); }
                s += __shfl_xor(s, 16); s += __shfl_xor(s, 32);
                if (fq == 0) red[(ai * HALF + wr * 64 + m * 16 + fr) * 4 + wc] = s;
            }
        f32x4 g[2][2]; u32x4 bv[4][2];
#pragma unroll
        for (int bj = 0; bj < 2; ++bj) { g[bj][0] = *(const f32x4*)(gain + bcol + bj * HALF + wc * 32 + 8 * fq); g[bj][1] = *(const f32x4*)(gain + bcol + bj * HALF + wc * 32 + 8 * fq + 4); }
#pragma unroll
        for (int m = 0; m < 4; ++m)
#pragma unroll
            for (int bj = 0; bj < 2; ++bj) bv[m][bj] = *(const u32x4*)(hb + (size_t)(brow + wr * 64 + m * 16 + fr) * DM + bcol + bj * HALF + wc * 32 + 8 * fq);
        __syncthreads();
        if (tid < 256) { const f32x4 v = *(const f32x4*)(red + tid * 4); __hip_atomic_store(part + (size_t)(brow + tid) * 4 + u.pn, (v[0] + v[1]) + (v[2] + v[3]), __ATOMIC_RELAXED, __HIP_MEMORY_SCOPE_AGENT); }
        asm volatile("s_waitcnt vmcnt(0)" ::: "memory");
        __syncthreads();
        if (tid == 0) {
            unsigned* c = cnt + u.pm * 64;
            __hip_atomic_fetch_add(c, 1u, __ATOMIC_RELAXED, __HIP_MEMORY_SCOPE_AGENT);
            unsigned sp = 0;
            while (__hip_atomic_load(c, __ATOMIC_RELAXED, __HIP_MEMORY_SCOPE_AGENT) < 4u && ++sp < (1u << 20)) __builtin_amdgcn_s_sleep(1);
        }
        __syncthreads();
#pragma unroll
        for (int ai = 0; ai < 2; ++ai) {
            float pq[4][4];
#pragma unroll
            for (int m = 0; m < 4; ++m) {
                const float* pp = part + (size_t)(brow + ai * HALF + wr * 64 + m * 16 + fr) * 4;
#pragma unroll
                for (int q = 0; q < 4; ++q) pq[m][q] = __hip_atomic_load(pp + q, __ATOMIC_RELAXED, __HIP_MEMORY_SCOPE_AGENT);
            }
            if (ai == 1) {
#pragma unroll
                for (int m = 0; m < 4; ++m)
#pragma unroll
                    for (int bj = 0; bj < 2; ++bj) bv[m][bj] = *(const u32x4*)(hb + (size_t)(brow + HALF + wr * 64 + m * 16 + fr) * DM + bcol + bj * HALF + wc * 32 + 8 * fq);
            }
#pragma unroll
            for (int m = 0; m < 4; ++m) {
                float s2 = 0.f; const float r = rsqrtf(((pq[m][0] + pq[m][1]) + (pq[m][2] + pq[m][3])) * (1.0f / DM) + EPS);
#pragma unroll
                for (int bj = 0; bj < 2; ++bj) { const size_t ro = (size_t)(brow + ai * HALF + wr * 64 + m * 16 + fr) * DM + bcol + bj * HALF + wc * 32 + 8 * fq;
                    const u32x4 q = bv[m][bj]; const f32x4 b0 = {bflo(q.x), bfhi(q.x), bflo(q.y), bfhi(q.y)}, b1 = {bflo(q.z), bfhi(q.z), bflo(q.w), bfhi(q.w)};
                    f32x4 h0, h1;
#pragma unroll
                    for (int j = 0; j < 4; ++j) { h0[j] = b0[j] + acc[ai][bj][m][0][j] * r * g[bj][0][j]; h1[j] = b1[j] + acc[ai][bj][m][1][j] * r * g[bj][1][j]; s2 += h0[j] * h0[j] + h1[j] * h1[j]; }
                    u32x4 w; w.x = cvt_pk_bf16(h0[0], h0[1]); w.y = cvt_pk_bf16(h0[2], h0[3]); w.z = cvt_pk_bf16(h1[0], h1[1]); w.w = cvt_pk_bf16(h1[2], h1[3]);
                    *(u32x4*)(hb + ro) = w; }
                if (WHICH == 1) { s2 += __shfl_xor(s2, 16); s2 += __shfl_xor(s2, 32); if (fq == 0) red[(ai * HALF + wr * 64 + m * 16 + fr) * 4 + wc] = s2; }
            }
        }
        if (WHICH == 1) {
            __syncthreads();
            if (tid < 256) { const f32x4 v = *(const f32x4*)(red + tid * 4); part2[(size_t)(brow + tid) * 4 + u.pn] = (v[0] + v[1]) + (v[2] + v[3]); }
        }
    }
};

template <class Epi>
__device__ __forceinline__ void run_gemm(const bf16_t* A, const bf16_t* Bt, int M, int N, int K, char* shm, const Epi& epi) {
    asm volatile("" : "+s"(K));
    pg8::Gemm g{A, Bt, M, N, K}; pg8::StaticOrder S; S.init(M, N, (int)gridDim.x, (int)blockIdx.x);
    pg8::gemm_phase<Epi, pg8::StaticOrder, true, true>((PG8_LAS unsigned char*)shm, g, S, epi);
}

__device__ __forceinline__ int src_col(int r, int mode) {
    if (mode == 0) return r;
    if (mode == 2) { const int g = r >> 9; const int sg = g == 0 ? 0 : g == 1 ? 1 : g == 2 ? 3 : g == 3 ? 4 : g == 4 ? 5 : g == 5 ? 2 : 6; return sg * 512 + (r & 511); }
    const int tile = r >> 8, w = r & 255, bj = w >> 7, j = w & 127;
    return bj * DFF + tile * 128 + j;
}
__device__ void conv_weight(const float* __restrict__ W, int K, int ldw, bf16_t* __restrict__ Wt, int Nrows, int mode, const float* __restrict__ gain, float* lds, int vb, int nvb) {
    const int nk = K / 64, nr = Nrows / 256, tid = threadIdx.x;
    for (int it = vb; it < nk * nr; it += nvb) {
        const int k0 = (it % nk) * 64, r0 = (it / nk) * 256;
        f32x4 v[8];
        const int sc = src_col(r0 + (tid & 63) * 4, mode);
#pragma unroll
        for (int i = 0; i < 8; ++i) v[i] = __builtin_nontemporal_load((const f32x4*)(W + (size_t)(k0 + (tid >> 6) + 8 * i) * ldw + sc));
        __syncthreads();
#pragma unroll
        for (int i = 0; i < 8; ++i) *(f32x4*)(lds + ((tid >> 6) + 8 * i) * 260 + (tid & 63) * 4) = v[i];
        __syncthreads();
#pragma unroll
        for (int j = 0; j < 4; ++j) {
            const int e = tid + 512 * j, r = e & 255, kg = e >> 8;
            float f[8];
#pragma unroll
            for (int i = 0; i < 8; ++i) { f[i] = lds[(8 * kg + i) * 260 + r]; if (gain) f[i] *= gain[k0 + 8 * kg + i]; }
            u32x4 w; w.x = cvt_pk_bf16(f[0], f[1]); w.y = cvt_pk_bf16(f[2], f[3]); w.z = cvt_pk_bf16(f[4], f[5]); w.w = cvt_pk_bf16(f[6], f[7]);
            *(u32x4*)(Wt + (size_t)(r0 + r) * K + k0 + 8 * kg) = w;
        }
    }
}
__device__ void phase0_rest(const Params& p, char* shm) {
    float* lds = (float*)shm; char* ws = p.ws;
    const int vb = blockIdx.x, nvb = gridDim.x;
    conv_weight(p.w_out, DM, DM, (bf16_t*)(ws + OFF_WOUT), DM, 0, nullptr, lds, vb, nvb);
    conv_weight(p.w_gu, DM, 2 * DFF, (bf16_t*)(ws + OFF_WGU), 2 * DFF, 1, p.g_ffn_pre, lds, vb, nvb);
    conv_weight(p.w_down, DFF, DM, (bf16_t*)(ws + OFF_WDN), DM, 0, nullptr, lds, vb, nvb);
    conv_weight(p.w_pp, PLE, DM, (bf16_t*)(ws + OFF_WPP), DM, 0, nullptr, lds, vb, nvb);
    conv_weight(p.w_pg, DM, DM, (bf16_t*)(ws + OFF_WPG), DM, 0, nullptr, lds, vb, nvb);
    __syncthreads();
    bf16_t* pb = (bf16_t*)(ws + OFF_PB);
    for (size_t i0 = (size_t)blockIdx.x * 512 + threadIdx.x; i0 < (size_t)MT * PLE / 4; i0 += (size_t)gridDim.x * 512 * 4) {
        f32x4 v[4];
#pragma unroll
        for (int j = 0; j < 4; ++j) { const size_t i = i0 + (size_t)j * gridDim.x * 512; if (i < (size_t)MT * PLE / 4) v[j] = __builtin_nontemporal_load((const f32x4*)(p.p + i * 4)); }
#pragma unroll
        for (int j = 0; j < 4; ++j) { const size_t i = i0 + (size_t)j * gridDim.x * 512; if (i < (size_t)MT * PLE / 4) { u32x2 w; w.x = cvt_pk_bf16(v[j][0], v[j][1]); w.y = cvt_pk_bf16(v[j][2], v[j][3]); *(u32x2*)(pb + i * 4) = w; } }
    }
    __syncthreads();
}
__device__ void phase0(const Params& p, char* shm) {
    float* lds = (float*)shm; char* ws = p.ws;
    const int vb = blockIdx.x, nvb = gridDim.x;
    conv_weight(p.w_in, DM, NIN, (bf16_t*)(ws + OFF_WIN), NIN, 2, p.g_attn_pre, lds, vb, nvb);
    if (blockIdx.x == 0) { float* lb = (float*)(ws + OFF_LB); const int c = threadIdx.x; const float l = sigmoidf_(p.gamma[c] - p.gamma[512 + c]); lb[c] = l; lb[512 + c] = 1.0f - l; }
    const int wid = threadIdx.x >> 6, lane = threadIdx.x & 63;
    bf16_t* xb = (bf16_t*)(ws + OFF_XB); float* rx = (float*)(ws + OFF_RX);
    for (int row0 = (blockIdx.x * 8 + wid) * 4; row0 < MT; row0 += gridDim.x * 32) {
        f32x4 v[4][4];
#pragma unroll
        for (int r = 0; r < 4; ++r)
#pragma unroll
            for (int i = 0; i < 4; ++i) v[r][i] = __builtin_nontemporal_load((const f32x4*)(p.x + (size_t)(row0 + r) * DM + i * 256 + lane * 4));
#pragma unroll
        for (int r = 0; r < 4; ++r) {
            float ss = 0.f;
#pragma unroll
            for (int i = 0; i < 4; ++i) { const f32x4 t = v[r][i]; ss += t[0] * t[0] + t[1] * t[1] + t[2] * t[2] + t[3] * t[3];
                u32x2 w; w.x = cvt_pk_bf16(t[0], t[1]); w.y = cvt_pk_bf16(t[2], t[3]); *(u32x2*)(xb + (size_t)(row0 + r) * DM + i * 256 + lane * 4) = w; }
            ss = wave_sum(ss);
            if (lane == 0) rx[row0 + r] = rsqrtf(ss * (1.0f / DM) + EPS);
        }
    }
}

template <int WHICH>
__device__ void phase_res(const Params& p) {
    char* ws = p.ws; const int wid = threadIdx.x >> 6, lane = threadIdx.x & 63;
    const float* src = (const float*)(ws + (WHICH == 1 ? OFF_QT : OFF_Y)); const float* base = WHICH == 1 ? p.x : p.out; const float* gn = WHICH == 1 ? p.g_attn_post : p.g_ffn_post;
    bf16_t* hb = (bf16_t*)(ws + (WHICH == 1 ? OFF_XB : OFF_H2B)); float* rh = (float*)(ws + OFF_RH1);
    f32x4 g[4];
#pragma unroll
    for (int i = 0; i < 4; ++i) g[i] = *(const f32x4*)(gn + i * 256 + lane * 4);
    for (int row0 = (blockIdx.x * 8 + wid) * 2; row0 < MT; row0 += gridDim.x * 16) {
        f32x4 mv[2][4], xv[2][4];
#pragma unroll
        for (int r = 0; r < 2; ++r)
#pragma unroll
            for (int i = 0; i < 4; ++i) { mv[r][i] = __builtin_nontemporal_load((const f32x4*)(src + (size_t)(row0 + r) * DM + i * 256 + lane * 4)); xv[r][i] = __builtin_nontemporal_load((const f32x4*)(base + (size_t)(row0 + r) * DM + i * 256 + lane * 4)); }
#pragma unroll
        for (int r = 0; r < 2; ++r) {
            float ss = 0.f;
#pragma unroll
            for (int i = 0; i < 4; ++i) ss += mv[r][i][0] * mv[r][i][0] + mv[r][i][1] * mv[r][i][1] + mv[r][i][2] * mv[r][i][2] + mv[r][i][3] * mv[r][i][3];
            ss = wave_sum(ss); const float rr = rsqrtf(ss * (1.0f / DM) + EPS); float s2 = 0.f;
#pragma unroll
            for (int i = 0; i < 4; ++i) { const int c = i * 256 + lane * 4; f32x4 h;
#pragma unroll
                for (int j = 0; j < 4; ++j) { h[j] = xv[r][i][j] + mv[r][i][j] * rr * g[i][j]; s2 += h[j] * h[j]; }
                *(f32x4*)(p.out + (size_t)(row0 + r) * DM + c) = h; u32x2 w; w.x = cvt_pk_bf16(h[0], h[1]); w.y = cvt_pk_bf16(h[2], h[3]); *(u32x2*)(hb + (size_t)(row0 + r) * DM + c) = w; }
            if (WHICH == 1) { s2 = wave_sum(s2); if (lane == 0) rh[row0 + r] = rsqrtf(s2 * (1.0f / DM) + EPS); }
        }
    }
}

#define MFMA32(a, b, c) __builtin_amdgcn_mfma_f32_32x32x16_bf16((a), (b), (c), 0, 0, 0)
#define MFMA16(a, b, c) __builtin_amdgcn_mfma_f32_16x16x32_bf16((a), (b), (c), 0, 0, 0)
__device__ __forceinline__ bf16x8 mk8(u32x2 a, u32x2 b) { u32x4 t; t.x = a.x; t.y = a.y; t.z = b.x; t.w = b.y; return __builtin_bit_cast(bf16x8, t); }
__device__ void phase_attn(const Params& p, char* shm, unsigned* queue) {
    char* ws = p.ws; const int tid = opaque_tid(), h = tid >> 6, lane = tid & 63, n = lane & 31, hh = lane >> 5;
    const bf16_t* SQ = (const bf16_t*)(ws + OFF_SQ); const bf16_t* SK = (const bf16_t*)(ws + OFF_SQ + SZ_HALF); const bf16_t* SVT = (const bf16_t*)(ws + OFF_SVT);
    bf16_t* am = (bf16_t*)(ws + OFF_AMIX); float* red = (float*)shm;
    int* itp = (int*)(shm + 2048);
    unsigned nxt_it = 0;
    if (threadIdx.x == 0) nxt_it = __hip_atomic_fetch_add(queue, 1u, __ATOMIC_RELAXED, __HIP_MEMORY_SCOPE_AGENT);
    for (;;) {
        __syncthreads();
        if (threadIdx.x == 0) { *itp = (int)nxt_it; if (nxt_it < NB * 128) nxt_it = __hip_atomic_fetch_add(queue, 1u, __ATOMIC_RELAXED, __HIP_MEMORY_SCOPE_AGENT); }
        __syncthreads();
        const int it0 = *itp; if (it0 >= NB * 128) break;
        const int it = NB * 128 - 1 - it0;
        const int b = it >> 7, qb = it & 127, t0 = qb * 32;
        const size_t tokq = (size_t)b * NT + t0 + n;
        bf16x8 qf[4];
#pragma unroll
        for (int ks = 0; ks < 4; ++ks) qf[ks] = *(const bf16x8*)(SQ + tokq * 512 + h * 64 + 16 * ks + 8 * hh);
        f32x16 o0, o1;
#pragma unroll
        for (int r = 0; r < 16; ++r) { o0[r] = 0.f; o1[r] = 0.f; }
        float R = 1.0f;
        char* sK = shm + 4096 + h * 9728; char* sV = sK + 4608;
        const int kr = lane >> 3, kc = lane & 7, vr = lane >> 2, vc = lane & 3;
        u32x4 kcur[4], vcur[4];
#define ATT_TILE(kd, vd, tokb) do { const size_t _tb = (tokb); \
            _Pragma("unroll") for (int i = 0; i < 4; ++i) { kd[i] = *(const u32x4*)(SK + (_tb + kr + 8 * i) * 512 + h * 64 + kc * 8); \
                                                           vd[i] = *(const u32x4*)(SVT + vt_off(h * 64 + vr + 16 * i, _tb) + vc * 8); } } while (0)
        ATT_TILE(kcur, vcur, (size_t)b * NT + t0);
        for (int kb = qb; kb >= 0; --kb) {
            const int s1 = (kb > 0 ? kb - 1 : 0) * 32;
            u32x4 knx[4], vnx[4];
            ATT_TILE(knx, vnx, (size_t)b * NT + s1);
            asm volatile("" ::: "memory");
#pragma unroll
            for (int i = 0; i < 4; ++i) { *(u32x4*)(sK + (kr + 8 * i) * 144 + kc * 16) = kcur[i]; *(u32x4*)(sV + (vr + 16 * i) * 80 + vc * 16) = vcur[i]; }
            asm volatile("" ::: "memory");
            bf16x8 kf[4]; u32x2 vf[2][2][2];
#pragma unroll
            for (int ks = 0; ks < 4; ++ks) kf[ks] = *(const bf16x8*)(sK + n * 144 + (16 * ks + 8 * hh) * 2);
#pragma unroll
            for (int db = 0; db < 2; ++db)
#pragma unroll
                for (int s = 0; s < 2; ++s)
#pragma unroll
                    for (int hf = 0; hf < 2; ++hf) vf[db][s][hf] = *(const u32x2*)(sV + (32 * db + n) * 80 + (16 * s + 8 * hf + 4 * hh) * 2);
            f32x16 st;
#pragma unroll
            for (int r = 0; r < 16; ++r) st[r] = 0.f;
#pragma unroll
            for (int ks = 0; ks < 4; ++ks) st = MFMA32(kf[ks], qf[ks], st);
            float mm[16], be[16];
#pragma unroll
            for (int r = 0; r < 16; ++r) { const float e = fexp2(st[r]); mm[r] = frcp(1.0f + e); be[r] = 1.0f - mm[r]; }
            if (kb == qb) {
#pragma unroll
                for (int r = 0; r < 16; ++r) { const bool act = ((r & 3) + 8 * (r >> 2) + 4 * hh) < n; mm[r] = act ? mm[r] : 1.0f; be[r] = act ? be[r] : 0.0f; }
            }
            float go[4], gp[4], T[4];
#pragma unroll
            for (int g = 0; g < 4; ++g) { go[g] = (mm[4 * g] * mm[4 * g + 1]) * (mm[4 * g + 2] * mm[4 * g + 3]); gp[g] = __shfl_xor(go[g], 32); }
            T[3] = 1.0f; T[2] = go[3] * gp[3]; T[1] = T[2] * (go[2] * gp[2]); T[0] = T[1] * (go[1] * gp[1]);
            const float tot = T[0] * (go[0] * gp[0]);
            float aa[16];
#pragma unroll
            for (int g = 0; g < 4; ++g) {
                float x = R * T[g] * (hh == 0 ? gp[g] : 1.0f);
                aa[4 * g + 3] = be[4 * g + 3] * x; x *= mm[4 * g + 3];
                aa[4 * g + 2] = be[4 * g + 2] * x; x *= mm[4 * g + 2];
                aa[4 * g + 1] = be[4 * g + 1] * x; x *= mm[4 * g + 1];
                aa[4 * g + 0] = be[4 * g + 0] * x;
            }
            u32x4 p0, p1;
            p0.x = cvt_pk_bf16(aa[0], aa[1]); p0.y = cvt_pk_bf16(aa[2], aa[3]); p0.z = cvt_pk_bf16(aa[4], aa[5]); p0.w = cvt_pk_bf16(aa[6], aa[7]);
            p1.x = cvt_pk_bf16(aa[8], aa[9]); p1.y = cvt_pk_bf16(aa[10], aa[11]); p1.z = cvt_pk_bf16(aa[12], aa[13]); p1.w = cvt_pk_bf16(aa[14], aa[15]);
            const bf16x8 pf0 = __builtin_bit_cast(bf16x8, p0), pf1 = __builtin_bit_cast(bf16x8, p1);
            o0 = MFMA32(mk8(vf[0][0][0], vf[0][0][1]), pf0, o0); o0 = MFMA32(mk8(vf[0][1][0], vf[0][1][1]), pf1, o0);
            o1 = MFMA32(mk8(vf[1][0][0], vf[1][0][1]), pf0, o1); o1 = MFMA32(mk8(vf[1][1][0], vf[1][1][1]), pf1, o1);
            R *= tot;
            if (__ballot(R >= 0x1p-134f) == 0ull) break;
#pragma unroll
            for (int i = 0; i < 4; ++i) { kcur[i] = knx[i]; vcur[i] = vnx[i]; }
        }
        float ss = 0.f;
#pragma unroll
        for (int r = 0; r < 16; ++r) ss += o0[r] * o0[r] + o1[r] * o1[r];
        ss += __shfl_xor(ss, 32);
        __syncthreads();
        if (hh == 0) red[h * 32 + n] = ss;
        __syncthreads();
        float tsum = 0.f;
#pragma unroll
        for (int w = 0; w < 8; ++w) tsum += red[w * 32 + n];
        const float rr = rsqrtf(tsum * (1.0f / 512) + EPS);
        f32x4 gwv[2][4];
#pragma unroll
        for (int db = 0; db < 2; ++db)
#pragma unroll
            for (int g = 0; g < 4; ++g) gwv[db][g] = *(const f32x4*)(p.g_sb + h * 64 + 32 * db + 8 * g + 4 * hh);
#pragma unroll
        for (int db = 0; db < 2; ++db)
#pragma unroll
            for (int g = 0; g < 4; ++g) {
                const int d0 = 32 * db + 8 * g + 4 * hh; const f32x4 gw = gwv[db][g];
                float v[4];
#pragma unroll
                for (int j = 0; j < 4; ++j) v[j] = (db == 0 ? o0[4 * g + j] : o1[4 * g + j]) * rr * gw[j];
                u32x2 w; w.x = cvt_pk_bf16(v[0], v[1]); w.y = cvt_pk_bf16(v[2], v[3]);
                *(u32x2*)(am + tokq * DM + 512 + h * 64 + d0) = w;
            }
    }
}

#define LDS_BAR() do { asm volatile("s_waitcnt lgkmcnt(0)" ::: "memory"); __builtin_amdgcn_s_barrier(); asm volatile("" ::: "memory"); } while (0)
constexpr int HSEG = 8;
__device__ __forceinline__ int seg_first(int s) { return s < 2 ? 9 * s : (s < 6 ? 18 + 8 * (s - 2) : 50 + 7 * (s - 6)); }
__device__ __forceinline__ int seg_len(int s) { return s < 2 ? 9 : (s < 6 ? 8 : 7); }
template <bool FULL>
__device__ void phase_hgseg(const Params& p, char* shm, int bh, int seg) {
    char* ws = p.ws; const int tid = opaque_tid(), w = tid >> 6, lane = tid & 63, fr = lane & 15, fq = lane >> 4, kp = tid & 63, r8 = tid >> 6;
    const int b = bh >> 2, h = bh & 3;
    const unsigned short* LF = (const unsigned short*)(ws + OFF_BC); const bf16_t* QT = (const bf16_t*)(ws + OFF_QT);
    const bf16_t* G = (const bf16_t*)(ws + OFF_QT + 3 * SZ_HALF); const bf16_t* VHT = (const bf16_t*)(ws + OFF_VHT);
    bf16_t* am = (bf16_t*)(ws + OFF_AMIX); float* parth = (float*)(ws + OFF_DC); float* SLOC = (float*)(ws + OFF_SLOC); float* DSEG = (float*)(ws + OFF_SLOC + 32 * MiB);
    float* qs = (float*)shm; float* dvec = (float*)(shm + 4096); float* red = (float*)(shm + 4608);
    char* sQs = shm + 8192; char* sQd = sQs + 17408; char* sKd = sQd + 17408; char* sP = sKd + 17408; char* keT = sP + 9216;
    f32x4 S[8];
#pragma unroll
    for (int kb = 0; kb < 8; ++kb) S[kb] = (f32x4){0.f, 0.f, 0.f, 0.f};
    f32x2 lfn[8]; unsigned qn[8]; bf16x8 vn[2]; u32x2 gn[4];
#define HG_LOAD(cc) do { const size_t _t0 = (size_t)b * NT + 64 * (cc); \
        _Pragma("unroll") for (int i = 0; i < 8; ++i) { const size_t a_ = (_t0 + 8 * r8 + i) * 512 + h * 128 + 2 * kp; lfn[i] = unpk_f16(*(const unsigned*)(LF + a_)); if (FULL) qn[i] = *(const unsigned*)(QT + a_); } \
        _Pragma("unroll") for (int ks = 0; ks < 2; ++ks) vn[ks] = *(const bf16x8*)(VHT + vt_off(h * 128 + 16 * w + fr, _t0) + 32 * ks + 8 * fq); \
        if (FULL) { _Pragma("unroll") for (int tb = 0; tb < 4; ++tb) gn[tb] = *(const u32x2*)(G + (_t0 + 16 * tb + fr) * 512 + h * 128 + 16 * w + 4 * fq); } } while (0)
    const int c0 = seg_first(seg), HCH = seg_len(seg);
    HG_LOAD(c0);
    if (FULL) {
        for (int s = 0; s < seg; ++s) {
            const float* sl = SLOC + ((size_t)(bh * HSEG + s) * 128 + 16 * w + fr) * 128 + 4 * fq; const float* ds = DSEG + (size_t)(bh * HSEG + s) * 128 + 4 * fq;
            f32x4 lv[8], dv[8];
#pragma unroll
            for (int kb = 0; kb < 8; ++kb) { lv[kb] = *(const f32x4*)(sl + 16 * kb); dv[kb] = *(const f32x4*)(ds + 16 * kb); }
#pragma unroll
            for (int kb = 0; kb < 8; ++kb) S[kb] = S[kb] * dv[kb] + lv[kb];
        }
    }
    f32x4 gw = {0.f, 0.f, 0.f, 0.f};
    if (FULL) gw = *(const f32x4*)(p.g_hg + h * 128 + 16 * w + 4 * fq);
    float dsum0 = 0.f, dsum1 = 0.f;
    for (int ci = 0; ci < HCH; ++ci) {
        const int c = c0 + ci; const size_t tok0 = (size_t)b * NT + 64 * c;
        f32x2 lfv[8], kkv[8]; unsigned qv[8]; bf16x8 vfr[2]; u32x2 gv[4];
#pragma unroll
        for (int i = 0; i < 8; ++i) { lfv[i] = lfn[i]; kkv[i].x = 1.0f - fexp2(lfn[i].x); kkv[i].y = 1.0f - fexp2(lfn[i].y); if (FULL) qv[i] = qn[i]; }
        vfr[0] = vn[0]; vfr[1] = vn[1];
        if (FULL) {
#pragma unroll
            for (int tb = 0; tb < 4; ++tb) gv[tb] = gn[tb];
        }
        { const int cn = ci < HCH - 1 ? c + 1 : c; HG_LOAD(cn); }
        f32x2 run = {0.f, 0.f};
#pragma unroll
        for (int i = 0; i < 8; ++i) { run += lfv[i]; lfv[i] = run; }
        *(f32x2*)(qs + r8 * 128 + 2 * kp) = run;
        LDS_BAR();
        if (FULL && ci > 0 && tid < 64) { float s = 0.f;
#pragma unroll
            for (int ww = 0; ww < 8; ++ww) s += red[ww * 64 + tid];
            parth[(tok0 - 64 + tid) * 4 + h] = s; }
        f32x2 off = {0.f, 0.f}, bmid = {0.f, 0.f}, blast = {0.f, 0.f};
#pragma unroll
        for (int j = 0; j < 8; ++j) { const f32x2 q = *(const f32x2*)(qs + j * 128 + 2 * kp); if (j < r8) off += q; if (j < 4) bmid += q; blast += q; }
        if (r8 == 0) { f32x2 d; d.x = fexp2(blast.x); d.y = fexp2(blast.y); *(f32x2*)(dvec + 2 * kp) = d; dsum0 += blast.x; dsum1 += blast.y; }
        f32x2 emid, elast;
        emid.x = fexp2(bmid.x); emid.y = fexp2(bmid.y); elast.x = fexp2(blast.x - bmid.x); elast.y = fexp2(blast.y - bmid.y);
        float ke0[8], ke1[8];
#pragma unroll
        for (int i = 0; i < 8; ++i) {
            const int t = 8 * r8 + i; const f32x2 bb = off + lfv[i];
            const float k0 = kkv[i].x, k1 = kkv[i].y;
            const float f0 = fexp2(bmid.x - bb.x), f1 = fexp2(bmid.y - bb.y);
            const float kd0 = k0 * f0, kd1 = k1 * f1;
            ke0[i] = kd0 * elast.x; ke1[i] = kd1 * elast.y;
            if (FULL) {
                const float e0 = fexp2(bb.x - bmid.x), e1 = fexp2(bb.y - bmid.y);
                const float qd0 = bflo(qv[i]) * e0, qd1 = bfhi(qv[i]) * e1;
                *(unsigned*)(sQd + t * 272 + kp * 4) = cvt_pk_bf16(qd0, qd1);
                *(unsigned*)(sQs + t * 272 + kp * 4) = cvt_pk_bf16(qd0 * emid.x, qd1 * emid.y);
                *(unsigned*)(sKd + t * 272 + kp * 4) = cvt_pk_bf16(kd0, kd1);
            }
        }
        { u32x4 a0, a1;
          a0.x = cvt_pk_bf16(ke0[0], ke0[1]); a0.y = cvt_pk_bf16(ke0[2], ke0[3]); a0.z = cvt_pk_bf16(ke0[4], ke0[5]); a0.w = cvt_pk_bf16(ke0[6], ke0[7]);
          a1.x = cvt_pk_bf16(ke1[0], ke1[1]); a1.y = cvt_pk_bf16(ke1[2], ke1[3]); a1.z = cvt_pk_bf16(ke1[4], ke1[5]); a1.w = cvt_pk_bf16(ke1[6], ke1[7]);
          *(u32x4*)(keT + (2 * kp) * 144 + r8 * 16) = a0; *(u32x4*)(keT + (2 * kp + 1) * 144 + r8 * 16) = a1; }
        LDS_BAR();
        if (FULL) {
            {
                const int tb = w >> 1;
                bf16x8 qf[4], kf[2][4];
#pragma unroll
                for (int ks = 0; ks < 4; ++ks) { qf[ks] = *(const bf16x8*)(sQd + (16 * tb + fr) * 272 + 64 * ks + 16 * fq);
#pragma unroll
                    for (int u = 0; u < 2; ++u) kf[u][ks] = *(const bf16x8*)(sKd + (16 * (2 * (w & 1) + u) + fr) * 272 + 64 * ks + 16 * fq); }
                __builtin_amdgcn_sched_barrier(0);
#pragma unroll
                for (int u = 0; u < 2; ++u) {
                    const int sb = 2 * (w & 1) + u;
                    f32x4 acc = {0.f, 0.f, 0.f, 0.f};
                    if (sb <= tb) {
#pragma unroll
                        for (int ks = 0; ks < 4; ++ks) acc = MFMA16(kf[u][ks], qf[ks], acc);
                    }
                    const int t = 16 * tb + fr, s0 = 16 * sb + 4 * fq;
#pragma unroll
                    for (int j = 0; j < 4; ++j) acc[j] = (s0 + j <= t) ? acc[j] : 0.f;
                    u32x2 o; o.x = cvt_pk_bf16(acc[0], acc[1]); o.y = cvt_pk_bf16(acc[2], acc[3]);
                    *(u32x2*)(sP + t * 144 + s0 * 2) = o;
                }
            }
            LDS_BAR();
            bf16x8 sb16[4];
#pragma unroll
            for (int ks = 0; ks < 4; ++ks) { u32x4 t4; t4.x = cvt_pk_bf16(S[2 * ks][0], S[2 * ks][1]); t4.y = cvt_pk_bf16(S[2 * ks][2], S[2 * ks][3]); t4.z = cvt_pk_bf16(S[2 * ks + 1][0], S[2 * ks + 1][1]); t4.w = cvt_pk_bf16(S[2 * ks + 1][2], S[2 * ks + 1][3]); sb16[ks] = __builtin_bit_cast(bf16x8, t4); }
            bf16x8 qsf[4][4], pf[4][2];
#pragma unroll
            for (int tb = 0; tb < 4; ++tb) {
#pragma unroll
                for (int ks = 0; ks < 4; ++ks) { const u32x2 lo = *(const u32x2*)(sQs + (16 * tb + fr) * 272 + (32 * ks + 4 * fq) * 2), hi = *(const u32x2*)(sQs + (16 * tb + fr) * 272 + (32 * ks + 16 + 4 * fq) * 2); qsf[tb][ks] = mk8(lo, hi); }
#pragma unroll
                for (int ks = 0; ks < 2; ++ks) pf[tb][ks] = *(const bf16x8*)(sP + (16 * tb + fr) * 144 + 64 * ks + 16 * fq);
            }
            __builtin_amdgcn_sched_barrier(0);
#pragma unroll
            for (int tb = 0; tb < 4; ++tb) {
                f32x4 acc = {0.f, 0.f, 0.f, 0.f};
#pragma unroll
                for (int ks = 0; ks < 4; ++ks) acc = MFMA16(sb16[ks], qsf[tb][ks], acc);
#pragma unroll
                for (int ks = 0; ks < 2; ++ks) acc = MFMA16(vfr[ks], pf[tb][ks], acc);
                float s = (acc[0] * acc[0] + acc[1] * acc[1]) + (acc[2] * acc[2] + acc[3] * acc[3]);
                s += __shfl_xor(s, 16); s += __shfl_xor(s, 32);
                if (fq == 0) red[w * 64 + 16 * tb + fr] = s;
                const u32x2 g2 = gv[tb];
                u32x2 o; o.x = cvt_pk_bf16(acc[0] * gw[0] * bflo(g2.x), acc[1] * gw[1] * bfhi(g2.x)); o.y = cvt_pk_bf16(acc[2] * gw[2] * bflo(g2.y), acc[3] * gw[3] * bfhi(g2.y));
                *(u32x2*)(am + (tok0 + 16 * tb + fr) * DM + h * 128 + 16 * w + 4 * fq) = o;
            }
        }
#pragma unroll
        for (int kg = 0; kg < 2; ++kg) {
            f32x4 dd[4]; bf16x8 kf[4][2];
#pragma unroll
            for (int q = 0; q < 4; ++q) { const int kb = 4 * kg + q; dd[q] = *(const f32x4*)(dvec + 16 * kb + 4 * fq);
#pragma unroll
                for (int ks = 0; ks < 2; ++ks) kf[q][ks] = *(const bf16x8*)(keT + (16 * kb + fr) * 144 + 64 * ks + 16 * fq); }
            __builtin_amdgcn_sched_barrier(0);
#pragma unroll
            for (int q = 0; q < 4; ++q) { const int kb = 4 * kg + q;
                f32x4 acc = S[kb] * dd[q];
#pragma unroll
                for (int ks = 0; ks < 2; ++ks) acc = MFMA16(kf[q][ks], vfr[ks], acc);
                S[kb] = acc; }
        }
    }
    if (FULL) {
        __syncthreads();
        if (tid < 64) { float s = 0.f;
#pragma unroll
            for (int ww = 0; ww < 8; ++ww) s += red[ww * 64 + tid];
            parth[((size_t)b * NT + 64 * (c0 + HCH - 1) + tid) * 4 + h] = s; }
    } else {
#pragma unroll
        for (int kb = 0; kb < 8; ++kb) *(f32x4*)(SLOC + ((size_t)(bh * HSEG + seg) * 128 + 16 * w + fr) * 128 + 16 * kb + 4 * fq) = S[kb];
        if (r8 == 0) { f32x2 d; d.x = fexp2(dsum0); d.y = fexp2(dsum1); *(f32x2*)(DSEG + (size_t)(bh * HSEG + seg) * 128 + 2 * kp) = d; }
    }
    __syncthreads();
#undef HG_LOAD
}

#define XB_TMO      128
#define XB_XCNT(j)  (256  + 64 * (j))
#define XB_XSUB(j)  (1280 + 64 * (j))
#define XB_XGEN(j)  (2304 + 64 * (j))
#define XB_TOP      3328
#define XB_TOPGEN   3392
#define XCD_BAR_WORDS 3456
#define XB_SPIN_CAP (1u << 18)
#define LAS __attribute__((address_space(3)))

__device__ __forceinline__ unsigned xb_ld(unsigned* p)              { return __hip_atomic_load(p, __ATOMIC_RELAXED, __HIP_MEMORY_SCOPE_AGENT); }
__device__ __forceinline__ unsigned xb_add(unsigned* p, unsigned v) { return __hip_atomic_fetch_add(p, v, __ATOMIC_RELAXED, __HIP_MEMORY_SCOPE_AGENT); }
__device__ __forceinline__ unsigned xb_xcc_id() { return (unsigned)__builtin_amdgcn_s_getreg((3 << 11) | 20) & 0xFu; }
#define XB_SPIN(cond, bar) do { unsigned _sp = 0; while (cond) { __builtin_amdgcn_s_sleep(1); \
    if ((++_sp & 255u) == 0u) { if (xb_ld(&(bar)[XB_TMO])) break; if (_sp > XB_SPIN_CAP) { atomicAdd(&(bar)[XB_TMO], 1u); break; } } } } while (0)

struct XcdBarrier {
    unsigned* bar; unsigned x;
    volatile LAS unsigned* st;
};

__device__ __forceinline__ XcdBarrier xcd_barrier_post(unsigned* bar, volatile LAS unsigned* st) {
    XcdBarrier b; b.bar = bar; b.x = xb_xcc_id(); b.st = st;
    if (threadIdx.x == 0) (void)xb_add(&bar[XB_XCNT(b.x)], 1u);
    return b;
}
__device__ __forceinline__ void xcd_barrier_complete(unsigned* bar, unsigned x, unsigned& nloc, unsigned& nx) {
    const unsigned G = gridDim.x * gridDim.y * gridDim.z;
    unsigned sum, cnt, mine, sp = 0u;
    for (;;) {
        sum = 0u; cnt = 0u; mine = 0u;
#pragma unroll
        for (unsigned j = 0; j < 16; ++j) { const unsigned c = xb_ld(&bar[XB_XCNT(j)]); sum += c; cnt += (c > 0u) ? 1u : 0u; mine = (j == x) ? c : mine; }
        if (sum == G) break;
        __builtin_amdgcn_s_sleep(1);
        if ((++sp & 255u) == 0u) { if (xb_ld(&bar[XB_TMO])) break; if (sp > XB_SPIN_CAP) { atomicAdd(&bar[XB_TMO], 1u); break; } }
    }
    nloc = mine > 0u ? mine : 1u; nx = cnt > 0u ? cnt : 1u;
}

__device__ __forceinline__ void xcd_barrier(const XcdBarrier& b) {
    asm volatile("s_waitcnt vmcnt(0)" ::: "memory");
    __syncthreads();
    if (threadIdx.x == 0) {
        unsigned* bar = b.bar;
        __builtin_amdgcn_s_waitcnt(0);
        unsigned nloc = b.st[0], nx = b.st[1];
        if (nloc == 0u) { xcd_barrier_complete(bar, b.x, nloc, nx); b.st[0] = nloc; b.st[1] = nx; }
        const unsigned old = xb_add(&bar[XB_XSUB(b.x)], 1u);
        const unsigned gen = old / nloc;
        if (old + 1u == (gen + 1u) * nloc) {
            __builtin_amdgcn_fence(__ATOMIC_RELEASE, "agent");
            asm volatile("s_waitcnt vmcnt(0)" ::: "memory");
            const unsigned og = xb_add(&bar[XB_TOP], 1u);
            const unsigned tg = og / nx;
            if (og + 1u == (tg + 1u) * nx) xb_add(&bar[XB_TOPGEN], 1u);
            else XB_SPIN(xb_ld(&bar[XB_TOPGEN]) == tg, bar);
            __builtin_amdgcn_fence(__ATOMIC_ACQUIRE, "agent");
            xb_add(&bar[XB_XGEN(b.x)], 1u);
            asm volatile("s_waitcnt vmcnt(0)" ::: "memory");
        } else {
            XB_SPIN(xb_ld(&bar[XB_XGEN(b.x)]) == gen, bar);
            __builtin_amdgcn_fence(__ATOMIC_ACQUIRE, "agent");
            asm volatile("s_waitcnt vmcnt(0)" ::: "memory");
        }
    }
    __syncthreads();
}


template <int PH> __device__ __forceinline__ void do_phase(const Params& p, char* shm) {
    char* ws = p.ws; char* epl = shm + SHM_B + 16;
    if (PH == 0) phase0(p, shm);
    if (PH == 1) {
        if (blockIdx.x & 1) phase0_rest(p, shm);
        run_gemm((const bf16_t*)(ws + OFF_XB), (const bf16_t*)(ws + OFF_WIN), MT, 2560, DM, shm, EpiIn{(const float*)(ws + OFF_RX), ws, epl});
        run_gemm((const bf16_t*)(ws + OFF_WIN) + (size_t)2560 * DM, (const bf16_t*)(ws + OFF_XB), 1024, MT, DM, shm, EpiVT{(const float*)(ws + OFF_RX), ws, epl});
        if (!(blockIdx.x & 1)) phase0_rest(p, shm);
    }
    if (PH == 2) { for (int u = blockIdx.x; u < 32 * HSEG; u += gridDim.x) if ((u & (HSEG - 1)) != HSEG - 1) phase_hgseg<false>(p, shm, u / HSEG, u & (HSEG - 1));
                   phase_attn(p, shm, (unsigned*)(ws + OFF_CNT) + 2 * 128 * 64); }
    if (PH == 3) { for (int u = blockIdx.x; u < 32 * HSEG; u += gridDim.x) phase_hgseg<true>(p, shm, u / HSEG, u & (HSEG - 1)); }
    if (PH == 5) run_gemm((const bf16_t*)(ws + OFF_AMIX), (const bf16_t*)(ws + OFF_WOUT), MT, DM, DM, shm,
                          EpiRes<1>{p.g_attn_post, (bf16_t*)(ws + OFF_XB), (float*)(ws + OFF_PART1), (unsigned*)(ws + OFF_CNT), (float*)(ws + OFF_PART2), epl, (const float*)(ws + OFF_DC)});
    if (PH == 7) {
        const bool ple_first = ((blockIdx.x >> 3) & 1) != 0;
        if (ple_first) run_gemm((const bf16_t*)(ws + OFF_PB), (const bf16_t*)(ws + OFF_WPP), MT, DM, PLE, shm, EpiBf16{(bf16_t*)(ws + OFF_PLE), DM});
        run_gemm((const bf16_t*)(ws + OFF_XB), (const bf16_t*)(ws + OFF_WGU), MT, 2 * DFF, DM, shm, EpiAct{(const float*)(ws + OFF_PART2), (bf16_t*)(ws + OFF_ACT), epl});
        if (!ple_first) run_gemm((const bf16_t*)(ws + OFF_PB), (const bf16_t*)(ws + OFF_WPP), MT, DM, PLE, shm, EpiBf16{(bf16_t*)(ws + OFF_PLE), DM});
    }
    if (PH == 8) run_gemm((const bf16_t*)(ws + OFF_ACT), (const bf16_t*)(ws + OFF_WDN), MT, DM, DFF, shm,
                          EpiRes<2>{p.g_ffn_post, (bf16_t*)(ws + OFF_XB), (float*)(ws + OFF_PART3), (unsigned*)(ws + OFF_CNT) + 128 * 64, nullptr, epl, nullptr});
    if (PH == 10) run_gemm((const bf16_t*)(ws + OFF_XB), (const bf16_t*)(ws + OFF_WPG), MT, DM, DM, shm, EpiFinal{p.out, (const bf16_t*)(ws + OFF_PLE), (const bf16_t*)(ws + OFF_XB)});
}
#if MEGA
__global__ __launch_bounds__(512) void k_mega(Params p) {
    extern __shared__ __attribute__((aligned(16))) char shm[];
    cg::grid_group grid = cg::this_grid();
    volatile LAS unsigned* st = (volatile LAS unsigned*)(shm + SHM_B);
    if (threadIdx.x < 2) st[threadIdx.x] = 0u;
    __syncthreads();
    const XcdBarrier xb = xcd_barrier_post((unsigned*)(p.ws + OFF_BAR), st);
    if (p.ws == nullptr) grid.sync();
    do_phase<0>(p, shm); xcd_barrier(xb);
    do_phase<1>(p, shm); xcd_barrier(xb);
    do_phase<2>(p, shm); xcd_barrier(xb);
    do_phase<3>(p, shm); xcd_barrier(xb);
    do_phase<5>(p, shm); xcd_barrier(xb);
    do_phase<7>(p, shm); xcd_barrier(xb);
    do_phase<8>(p, shm); xcd_barrier(xb);
    do_phase<10>(p, shm);
}
#else
template <int PH> __global__ __launch_bounds__(512) void k_phase(Params p) {
    extern __shared__ __attribute__((aligned(16))) char shm[];
    do_phase<PH>(p, shm);
}
template <int PH> static void launch_phase(const Params& p, hipStream_t s) {
    static bool attr = false;
    if (!attr) { (void)hipFuncSetAttribute((const void*)k_phase<PH>, hipFuncAttributeMaxDynamicSharedMemorySize, SHM_B); attr = true; }
    hipLaunchKernelGGL(k_phase<PH>, dim3(256), dim3(512), SHM_B, s, p);
}
#endif

extern "C" void kernel_launch(void* const* d_in, const int* in_sizes, int n_in, void* d_out, int out_size, void* d_ws, size_t ws_size, hipStream_t stream) {
    Params p{};
    p.x = (const float*)d_in[0]; p.p = (const float*)d_in[1]; p.g_attn_pre = (const float*)d_in[2]; p.w_in = (const float*)d_in[3]; p.gamma = (const float*)d_in[4];
    p.g_hg = (const float*)d_in[5]; p.g_sb = (const float*)d_in[6]; p.w_out = (const float*)d_in[7]; p.g_attn_post = (const float*)d_in[8]; p.g_ffn_pre = (const float*)d_in[9];
    p.w_gu = (const float*)d_in[10]; p.w_down = (const float*)d_in[11]; p.g_ffn_post = (const float*)d_in[12]; p.w_pp = (const float*)d_in[13]; p.w_pg = (const float*)d_in[14];
    p.out = (float*)d_out; p.ws = (char*)d_ws;
#if MEGA
    static int grid_blocks = 0;
    if (!grid_blocks) {
        int dev = 0, cus = 0, per_cu = 0;
        (void)hipGetDevice(&dev); (void)hipDeviceGetAttribute(&cus, hipDeviceAttributeMultiprocessorCount, dev);
        (void)hipFuncSetAttribute((const void*)k_mega, hipFuncAttributeMaxDynamicSharedMemorySize, LDS_TOTAL);
        (void)hipOccupancyMaxActiveBlocksPerMultiprocessor(&per_cu, (const void*)k_mega, 512, LDS_TOTAL);
        if (per_cu < 1) per_cu = 1;
        grid_blocks = cus * per_cu;
    }
    (void)hipMemsetAsync((char*)d_ws + OFF_BAR, 0, CTL_BYTES, stream);
    void* args[] = {&p};
    hipError_t e = hipLaunchCooperativeKernel((const void*)k_mega, dim3(grid_blocks), dim3(512), args, LDS_TOTAL, stream);
    if (e != hipSuccess) fprintf(stderr, "cooperative launch failed: %s (grid %d)\n", hipGetErrorString(e), grid_blocks);
#else
    launch_phase<0>(p, stream); launch_phase<1>(p, stream); launch_phase<2>(p, stream); launch_phase<3>(p, stream); launch_phase<5>(p, stream);
    launch_phase<7>(p, stream); launch_phase<8>(p, stream); launch_phase<10>(p, stream);
#endif
}
```

```cpp
#include <hip/hip_runtime.h>
#include <hip/hip_cooperative_groups.h>
#include <cstdio>
#include <cstdint>
namespace cg = cooperative_groups;

#ifndef MEGA
#define MEGA 1
#endif

typedef unsigned short bf16_t;
typedef short bf16x8 __attribute__((ext_vector_type(8)));
typedef float f32x4 __attribute__((ext_vector_type(4)));
typedef unsigned u32x4 __attribute__((ext_vector_type(4)));
typedef unsigned u32x2 __attribute__((ext_vector_type(2)));

constexpr int NB = 8, NT = 4096, DM = 1024, MT = NB * NT;
constexpr int NIN = 3584, DFF = 2816, PLE = 256;
constexpr float EPS = 1e-6f;
constexpr float LOG2E = 1.4426950408889634f;

constexpr size_t MiB = 1ull << 20;
constexpr size_t OFF_WIN = 0;
constexpr size_t OFF_WOUT = 7 * MiB;
constexpr size_t OFF_WGU = 9 * MiB;
constexpr size_t OFF_WDN = 20 * MiB;
constexpr size_t OFF_WPP = 26 * MiB;
constexpr size_t OFF_WPG = 27 * MiB;
constexpr size_t OFF_RX = 30 * MiB;
constexpr size_t OFF_RH1 = 31 * MiB;
constexpr size_t OFF_LB = 32 * MiB;
constexpr size_t OFF_PB = 40 * MiB;
constexpr size_t OFF_XB = 56 * MiB;
constexpr size_t OFF_SQ = 120 * MiB;
constexpr size_t OFF_Y = 56 * MiB;
constexpr size_t OFF_QT = 216 * MiB;
constexpr size_t OFF_BC = 344 * MiB;
constexpr size_t OFF_ACT = 216 * MiB;
constexpr size_t OFF_H2B = 216 * MiB;
constexpr size_t OFF_PLE = 408 * MiB;
constexpr size_t OFF_SLOC = 472 * MiB;
constexpr size_t OFF_AMIX = 408 * MiB;
constexpr size_t OFF_PART1 = 35 * MiB;
constexpr size_t OFF_PART2 = 36 * MiB;
constexpr size_t OFF_PART3 = 37 * MiB;
constexpr size_t OFF_CNT = 34 * MiB + 16384;
constexpr size_t CTL_BYTES = 16384 + 2 * 128 * 64 * 4 + 256;
constexpr size_t OFF_BAR = 34 * MiB;
constexpr size_t OFF_DC = 33 * MiB;
constexpr size_t OFF_U = 56 * MiB;
constexpr size_t OFF_SC = 120 * MiB;
constexpr size_t OFF_VHT = 216 * MiB + 2 * (32 * MiB);
constexpr size_t OFF_SVT = 120 * MiB + 2 * (32 * MiB);
constexpr size_t SZ_HALF = 32 * MiB;

struct Params {
    const float *x, *p, *g_attn_pre, *w_in, *gamma, *g_hg, *g_sb, *w_out, *g_attn_post, *g_ffn_pre, *w_gu, *w_down, *g_ffn_post, *w_pp, *w_pg;
    float* out; char* ws;
};

typedef __bf16 bf2_t __attribute__((ext_vector_type(2)));
typedef float f32x2 __attribute__((ext_vector_type(2)));
typedef float f32x16 __attribute__((ext_vector_type(16)));
typedef _Float16 h16x2 __attribute__((ext_vector_type(2)));
__device__ __forceinline__ unsigned cvt_pk_f16(float lo, float hi) { f32x2 v = {lo, hi}; return __builtin_bit_cast(unsigned, __builtin_convertvector(v, h16x2)); }
__device__ __forceinline__ f32x2 unpk_f16(unsigned u) { return __builtin_convertvector(__builtin_bit_cast(h16x2, u), f32x2); }
__device__ __forceinline__ unsigned cvt_pk_bf16(float lo, float hi) { f32x2 v = {lo, hi}; return __builtin_bit_cast(unsigned, __builtin_convertvector(v, bf2_t)); }
__device__ __forceinline__ size_t vt_off(int ch, size_t tok) { return ((tok >> 6) * 512 + (size_t)ch) * 64 + (tok & 63); }
__device__ __forceinline__ float bf2f(bf16_t h) { return __uint_as_float(((unsigned)h) << 16); }
__device__ __forceinline__ float bflo(unsigned u) { return __uint_as_float(u << 16); }
__device__ __forceinline__ float bfhi(unsigned u) { return __uint_as_float(u & 0xffff0000u); }
__device__ __forceinline__ float fexp2(float x) { return __builtin_amdgcn_exp2f(x); }
__device__ __forceinline__ float frcp(float x) { return __builtin_amdgcn_rcpf(x); }
__device__ __forceinline__ float sigmoidf_(float x) { return frcp(1.0f + fexp2(-x * LOG2E)); }
__device__ __forceinline__ float siluf_(float x) { return x * sigmoidf_(x); }
__device__ __forceinline__ float wave_sum(float v) {
#pragma unroll
    for (int o = 32; o >= 1; o >>= 1) v += __shfl_xor(v, o);
    return v;
}

__device__ __forceinline__ int opaque_tid() { int t = threadIdx.x; asm volatile("" : "+v"(t)); return t; }

namespace pg8 {
#define PG8_LAS __attribute__((address_space(3)))
typedef unsigned short bf16_t;
typedef short bf16x8 __attribute__((ext_vector_type(8)));
typedef float f32x4 __attribute__((ext_vector_type(4)));
typedef unsigned u32x4 __attribute__((ext_vector_type(4)));
constexpr int BM = 256, BK = 64, HALF = 128, HTB = HALF * BK * 2  , STAGE_BYTES = 8 * HTB, NXCD = 8, WGM = 8;

__host__ __device__ __forceinline__ int lds_byte(int r, int c) { const int st = (r >> 4) * 2 + (c >> 5), rr = r & 15, cc = c & 31, ob = rr * 64 + cc * 2; return st * 1024 + (ob ^ (((ob >> 9) & 1) << 5)); }
__host__ __device__ __forceinline__ void stage_rc(int b, int& R, int& C) { const int st = b / 1024, sb = b % 1024, swz = sb ^ (((sb >> 9) & 1) << 5); R = (st >> 1) * 16 + swz / 64; C = (st & 1) * 32 + (swz % 64) / 2; }
__host__ __device__ __forceinline__ int perm32(int rho) { const int n = rho >> 4, i = rho & 15; return 8 * (i >> 2) + 4 * n + (i & 3); }

struct Unit { int pm, pn; };
struct Gemm { const bf16_t* A; const bf16_t* Bt; int M, N, K; };

struct StaticOrder {
    int nM, nN, nwg, G, c;
    __host__ __device__ void init(int M, int N, int G_, int c_) { nM = M / BM; nN = N / BM; nwg = nM * nN; G = G_; c = c_; }
    __host__ __device__ bool next(int i, Unit& u) const {
        const long L = (long)i * G + c; if (L >= nwg) return false;
        int wgid = (int)L; { const int q = nwg / NXCD, r = nwg % NXCD, xcd = wgid % NXCD, off = wgid / NXCD; wgid = (xcd < r ? xcd * (q + 1) : r * (q + 1) + (xcd - r) * q) + off; }
        const int nig = WGM * nN, gid = wgid / nig, fm = gid * WGM, gsz = (nM - fm) < WGM ? (nM - fm) : WGM;
        u.pm = fm + ((wgid % nig) % gsz); u.pn = (wgid % nig) / gsz; return true;
    }
    __device__ __forceinline__ void a_ready(const Unit&) const {}
    __device__ __forceinline__ void done(const Unit&) const {}
};
template <class Epi, class Sched, bool ALIGN_EPI = false, bool SP2 = false>
__device__ __forceinline__ void gemm_phase(PG8_LAS unsigned char* lds, const Gemm g, const Sched& S, const Epi& E) {
    const int tid = opaque_tid(), wid = __builtin_amdgcn_readfirstlane(tid >> 6), lane = tid & 63, wr = wid >> 2, wc = wid & 3, fr = lane & 15, fq = lane >> 4;
    const int K = g.K, nt = K / BK;
    unsigned voffA[2], voffB[2];
#pragma unroll
    for (int i = 0; i < 2; ++i) { int R, C; stage_rc(tid * 16 + i * 8192, R, C); const int Rb = Epi::PERM ? ((R & ~31) + perm32(R & 31)) : R;
        voffA[i] = (unsigned)(R * K + C) * 2u; voffB[i] = (unsigned)(Rb * K + C) * 2u; }
    const size_t kstep = (size_t)(BK * 2);
    const size_t hstep = (size_t)HALF * K * 2;
    const size_t tstep = 2 * hstep;
    const unsigned ldsw = (unsigned)wid * 1024u;
    const int aoff = lds_byte(wr * 64 + fr, fq * 8), boff = lds_byte(wc * 32 + fr, fq * 8);
#define PG8_SA(b, h) (((b) * 2 + (h)) * HTB)
#define PG8_SB(b, h) ((4 + (b) * 2 + (h)) * HTB)
#define PG8_STAGE(bufoff, gbase, voff) do { _Pragma("unroll") for (int _i = 0; _i < 2; ++_i) \
        __builtin_amdgcn_global_load_lds((const unsigned*)((const char*)(gbase) + (voff)[_i]), (PG8_LAS unsigned*)(lds + (bufoff) + ldsw + _i * 8192), 16, 0, 0); } while (0)
#define PG8_LDA(dst, b, h) do { _Pragma("unroll") for (int m = 0; m < 4; ++m) _Pragma("unroll") for (int k = 0; k < 2; ++k) dst[m][k] = *(const PG8_LAS bf16x8*)(lds + PG8_SA(b, h) + aoff + m * 2048 + k * 1024); } while (0)
#define PG8_LDB(dst, b, h) do { _Pragma("unroll") for (int n = 0; n < 2; ++n) _Pragma("unroll") for (int k = 0; k < 2; ++k) dst[n][k] = *(const PG8_LAS bf16x8*)(lds + PG8_SB(b, h) + boff + n * 2048 + k * 1024); } while (0)
#define PG8_MMA(ai, bj, At, Bt) do { __builtin_amdgcn_s_setprio(1); _Pragma("unroll") for (int m = 0; m < 4; ++m) _Pragma("unroll") for (int n = 0; n < 2; ++n) _Pragma("unroll") for (int k = 0; k < 2; ++k) \
        acc[ai][bj][m][n] = __builtin_amdgcn_mfma_f32_16x16x32_bf16(Bt[n][k], At[m][k], acc[ai][bj][m][n], 0, 0, 0); __builtin_amdgcn_s_setprio(0); } while (0)
#define PG8_WAIT_V(n) asm volatile("s_waitcnt vmcnt(" #n ")" ::: "memory")
#define PG8_WAIT_L(n) asm volatile("s_waitcnt lgkmcnt(" #n ")" ::: "memory")
#define PG8_BAR __builtin_amdgcn_s_barrier()
#define PG8_SCHED __builtin_amdgcn_sched_barrier(0)
    Unit cur, nxt; int ui = 0;
    if (!S.next(0, cur)) return;
    f32x4 acc[2][2][4][2];
#pragma unroll
    for (int a = 0; a < 2; ++a)
#pragma unroll
        for (int b = 0; b < 2; ++b)
#pragma unroll
            for (int m = 0; m < 4; ++m)
#pragma unroll
                for (int n = 0; n < 2; ++n) acc[a][b][m][n] = (f32x4){0.f, 0.f, 0.f, 0.f};
    bf16x8 At[4][2], B0[2][2], B1[2][2];
    const char* cA = (const char*)g.A + (size_t)cur.pm * tstep; const char* cB = (const char*)g.Bt + (size_t)cur.pn * tstep;
    S.a_ready(cur);
    if constexpr (Epi::MIDSCALE) E.load_mid(cur);
    typename Epi::Pre pre = {};
    if constexpr (Epi::ROWPRE) pre = E.pre_issue(cur);
    if constexpr (SP2) {
        PG8_STAGE(PG8_SB(0, 0), cB, voffB); PG8_STAGE(PG8_SB(0, 1), cB + hstep, voffB); PG8_STAGE(PG8_SA(0, 0), cA, voffA); PG8_STAGE(PG8_SA(0, 1), cA + hstep, voffA);
        if (wr == 1) PG8_BAR;
        PG8_WAIT_V(2); PG8_BAR;
        PG8_STAGE(PG8_SB(1, 0), cB + kstep, voffB); PG8_STAGE(PG8_SA(1, 0), cA + kstep, voffA); PG8_STAGE(PG8_SB(1, 1), cB + hstep + kstep, voffB);
        PG8_WAIT_V(6); PG8_BAR;
    } else {
        PG8_STAGE(PG8_SB(0, 0), cB, voffB); PG8_STAGE(PG8_SA(0, 0), cA, voffA); PG8_STAGE(PG8_SB(0, 1), cB + hstep, voffB); PG8_STAGE(PG8_SA(0, 1), cA + hstep, voffA);
        if (wr == 1) PG8_BAR;
        PG8_WAIT_V(4); PG8_BAR;
        PG8_STAGE(PG8_SB(1, 0), cB + kstep, voffB); PG8_STAGE(PG8_SA(1, 0), cA + kstep, voffA); PG8_STAGE(PG8_SB(1, 1), cB + hstep + kstep, voffB);
        PG8_WAIT_V(6); PG8_BAR;
    }
    for (;;) {
        const bool has_next = S.next(ui + 1, nxt);
        const char* nA = has_next ? (const char*)g.A + (size_t)nxt.pm * tstep : cA; const char* nB = has_next ? (const char*)g.Bt + (size_t)nxt.pn * tstep : cB;
        for (int t = 0; t < nt; t += 2) {
            const bool last = (t == nt - 2);
            const char* a1 = cA + (size_t)(t + 1) * kstep;
            const char* a2 = last ? nA : cA + (size_t)(t + 2) * kstep; const char* b2 = last ? nB : cB + (size_t)(t + 2) * kstep;
            const char* a3 = a2 + kstep; const char* b3 = b2 + kstep;
            if (last && has_next) S.a_ready(nxt);
            if constexpr (Epi::ROWPRE) { if (t == 8) E.pre_commit(pre); }
            if constexpr (Epi::MIDSCALE) { if (t == Epi::MID_T) {
_Pragma("unroll") for (int a = 0; a < 2; ++a) _Pragma("unroll") for (int m = 0; m < 4; ++m) { const float sc_ = E.mid_scale(a * HALF + wr * 64 + m * 16 + fr);
_Pragma("unroll") for (int b = 0; b < 2; ++b) _Pragma("unroll") for (int n = 0; n < 2; ++n) acc[a][b][m][n] = acc[a][b][m][n] * sc_; } } }
            if constexpr (SP2) {
            PG8_LDB(B0, 0, 0); PG8_LDB(B1, 0, 1); PG8_SCHED; PG8_LDA(At, 0, 0); PG8_STAGE(PG8_SA(1, 1), a1 + hstep, voffA);
            PG8_WAIT_V(8); PG8_WAIT_L(0); PG8_BAR; PG8_MMA(0, 0, At, B0); PG8_MMA(0, 1, At, B1); PG8_BAR; PG8_SCHED;
            PG8_LDA(At, 0, 1); PG8_STAGE(PG8_SB(0, 0), b2, voffB); PG8_STAGE(PG8_SB(0, 1), b2 + hstep, voffB); PG8_STAGE(PG8_SA(0, 0), a2, voffA);
            PG8_WAIT_V(8); PG8_WAIT_L(0); PG8_BAR; PG8_MMA(1, 0, At, B0); PG8_MMA(1, 1, At, B1); PG8_BAR; PG8_SCHED;
            PG8_LDB(B0, 1, 0); PG8_LDB(B1, 1, 1); PG8_SCHED; PG8_LDA(At, 1, 0); PG8_STAGE(PG8_SA(0, 1), a2 + hstep, voffA);
            PG8_WAIT_V(8); PG8_WAIT_L(0); PG8_BAR; PG8_MMA(0, 0, At, B0); PG8_MMA(0, 1, At, B1); PG8_BAR; PG8_SCHED;
            PG8_LDA(At, 1, 1); PG8_STAGE(PG8_SB(1, 0), b3, voffB); PG8_STAGE(PG8_SB(1, 1), b3 + hstep, voffB); PG8_STAGE(PG8_SA(1, 0), a3, voffA);
            PG8_WAIT_V(8); PG8_WAIT_L(0); PG8_BAR; PG8_MMA(1, 0, At, B0); PG8_MMA(1, 1, At, B1); PG8_BAR; PG8_SCHED;
            } else {
            PG8_LDB(B0, 0, 0); PG8_SCHED; PG8_LDA(At, 0, 0); PG8_STAGE(PG8_SA(1, 1), a1 + hstep, voffA);
            PG8_WAIT_L(8); PG8_BAR; PG8_WAIT_L(0); PG8_MMA(0, 0, At, B0); PG8_BAR; PG8_SCHED;
            PG8_LDB(B1, 0, 1); PG8_STAGE(PG8_SB(0, 0), b2, voffB);
            PG8_BAR; PG8_WAIT_L(0); PG8_MMA(0, 1, At, B1); PG8_BAR;
            PG8_LDA(At, 0, 1); PG8_STAGE(PG8_SA(0, 0), a2, voffA);
            PG8_BAR; PG8_WAIT_L(0); PG8_MMA(1, 0, At, B0); PG8_BAR; PG8_SCHED;
            PG8_STAGE(PG8_SB(0, 1), b2 + hstep, voffB);
            PG8_WAIT_V(6); PG8_BAR; PG8_MMA(1, 1, At, B1); PG8_BAR;
            PG8_LDB(B0, 1, 0); PG8_SCHED; PG8_LDA(At, 1, 0); PG8_STAGE(PG8_SA(0, 1), a2 + hstep, voffA);
            PG8_WAIT_L(8); PG8_BAR; PG8_WAIT_L(0); PG8_MMA(0, 0, At, B0); PG8_BAR; PG8_SCHED;
            PG8_LDB(B1, 1, 1); PG8_STAGE(PG8_SB(1, 0), b3, voffB);
            PG8_BAR; PG8_WAIT_L(0); PG8_MMA(0, 1, At, B1); PG8_BAR;
            PG8_LDA(At, 1, 1); PG8_STAGE(PG8_SA(1, 0), a3, voffA);
            PG8_BAR; PG8_WAIT_L(0); PG8_MMA(1, 0, At, B0); PG8_BAR; PG8_SCHED;
            PG8_STAGE(PG8_SB(1, 1), b3 + hstep, voffB);
            PG8_WAIT_V(6); PG8_BAR; PG8_MMA(1, 1, At, B1); PG8_BAR;
            }
        }
        if constexpr (ALIGN_EPI) { if (wr == 0) PG8_BAR; }
        if constexpr (!Epi::AFTER_DRAIN) { E(acc, cur, wr, wc, fr, fq); S.done(cur); }
        if (!has_next) break;
#pragma unroll
        for (int a = 0; a < 2; ++a)
#pragma unroll
            for (int b = 0; b < 2; ++b)
#pragma unroll
                for (int m = 0; m < 4; ++m)
#pragma unroll
                    for (int n = 0; n < 2; ++n) acc[a][b][m][n] = (f32x4){0.f, 0.f, 0.f, 0.f};
        cur = nxt; cA = nA; cB = nB; ++ui;
        if constexpr (Epi::MIDSCALE) E.load_mid(cur);
        if constexpr (Epi::ROWPRE) pre = E.pre_issue(cur);
        if constexpr (ALIGN_EPI) { if (wr == 1) PG8_BAR; }
    }
    PG8_WAIT_V(0);
    if constexpr (!ALIGN_EPI) { if (wr == 0) PG8_BAR; }
    PG8_BAR;
    if constexpr (Epi::AFTER_DRAIN) { E.fused(acc, cur, wr, wc, fr, fq, lds, wid, lane); S.done(cur); }
#undef PG8_SA
#undef PG8_SB
#undef PG8_STAGE
#undef PG8_LDA
#undef PG8_LDB
#undef PG8_MMA
#undef PG8_WAIT_V
#undef PG8_WAIT_L
#undef PG8_BAR
#undef PG8_SCHED
}
}

#define EPI_ARGS const f32x4 (&acc)[2][2][4][2], const pg8::Unit& u, int wr, int wc, int fr, int fq
#define EPI_HEAD static constexpr bool PERM = true, AFTER_DRAIN = false, MIDSCALE = false, ROWPRE = false; typedef int Pre;
#define EPI_HEAD_PRE(T) static constexpr bool PERM = true, AFTER_DRAIN = false, MIDSCALE = false, ROWPRE = true; typedef T Pre;
#define EPI_RC const int brow = u.pm * 256, bcol = u.pn * 256;
constexpr int HALF = 128, SHM_B = 131072, LDS_TOTAL = SHM_B + 16 + 4096 + 1024;
struct EpiIn {
    EPI_HEAD_PRE(float)
    const float* rx; char* ws; char* lds;
    __device__ __forceinline__ float pre_issue(const pg8::Unit& u) const { return threadIdx.x < 256 ? rx[u.pm * 256 + threadIdx.x] : 0.f; }
    __device__ __forceinline__ void pre_commit(float v) const { if (threadIdx.x < 256) ((float*)(lds + 4096))[threadIdx.x] = v; }
    __device__ __forceinline__ void operator()(EPI_ARGS) const { EPI_RC
        const int kind = bcol >> 9;
        const int lc0 = (bcol & 256) + wc * 32 + 8 * fq;
        bf16_t* dst = (bf16_t*)(ws + (kind == 0 ? OFF_QT : kind == 1 ? OFF_QT + SZ_HALF : kind == 2 ? OFF_QT + 3 * SZ_HALF : kind == 3 ? OFF_SQ : OFF_SQ + SZ_HALF));
        if (kind == 1) {
            float* dstf = (float*)(ws + OFF_BC); const float* lbp = (const float*)(ws + OFF_LB);
#pragma unroll
            for (int bj = 0; bj < 2; ++bj)
#pragma unroll
                for (int n = 0; n < 2; ++n) {
                    const f32x4 l0 = *(const f32x4*)(lbp + lc0 + bj * HALF + 4 * n), m0 = *(const f32x4*)(lbp + 512 + lc0 + bj * HALF + 4 * n);
                    float rsv[2][4];
#pragma unroll
                    for (int ai = 0; ai < 2; ++ai)
#pragma unroll
                        for (int m = 0; m < 4; ++m) rsv[ai][m] = ((const float*)(lds + 4096))[ai * HALF + wr * 64 + m * 16 + fr];
#pragma unroll
                    for (int ai = 0; ai < 2; ++ai)
#pragma unroll
                        for (int m = 0; m < 4; ++m) {
                            const int row = brow + ai * HALF + wr * 64 + m * 16 + fr; const float rs = rsv[ai][m];
                            const f32x4 z = acc[ai][bj][m][n] * rs; f32x4 lf;
#pragma unroll
                            for (int j = 0; j < 4; ++j) { const float s = sigmoidf_(z[j]); lf[j] = __builtin_amdgcn_logf(l0[j] + m0[j] * s)  ; }
                            const size_t o = (size_t)row * 512 + lc0 + bj * HALF + 4 * n;
                            u32x2 w; w.x = cvt_pk_f16(lf[0], lf[1]); w.y = cvt_pk_f16(lf[2], lf[3]); *(u32x2*)((unsigned short*)dstf + o) = w;
                        }
                }
            return;
        }
        float rsv[2][4];
#pragma unroll
        for (int ai = 0; ai < 2; ++ai)
#pragma unroll
            for (int m = 0; m < 4; ++m) rsv[ai][m] = ((const float*)(lds + 4096))[ai * HALF + wr * 64 + m * 16 + fr] * (kind == 3 ? 0.125f * LOG2E : 1.0f);
#pragma unroll
        for (int ai = 0; ai < 2; ++ai)
#pragma unroll
            for (int m = 0; m < 4; ++m) {
                const int row = brow + ai * HALF + wr * 64 + m * 16 + fr;
                const float rs = rsv[ai][m];
#pragma unroll
                for (int bj = 0; bj < 2; ++bj) {
                    f32x4 v0 = acc[ai][bj][m][0] * rs, v1 = acc[ai][bj][m][1] * rs;
                    if (kind == 0 || kind == 2) {
#pragma unroll
                        for (int j = 0; j < 4; ++j) { v0[j] = siluf_(v0[j]); v1[j] = siluf_(v1[j]); }
                    }
                    u32x4 w; w.x = cvt_pk_bf16(v0[0], v0[1]); w.y = cvt_pk_bf16(v0[2], v0[3]); w.z = cvt_pk_bf16(v1[0], v1[1]); w.w = cvt_pk_bf16(v1[2], v1[3]);
                    *(u32x4*)(dst + (size_t)row * 512 + lc0 + bj * HALF) = w;
                }
            }
    }
};
struct EpiVT {
    EPI_HEAD_PRE(float)
    const float* rx; char* ws; char* lds;
    __device__ __forceinline__ float pre_issue(const pg8::Unit& u) const { return threadIdx.x < 256 ? rx[u.pn * 256 + threadIdx.x] : 0.f; }
    __device__ __forceinline__ void pre_commit(float v) const { if (threadIdx.x < 256) ((float*)(lds + 4096))[threadIdx.x] = v; }
    __device__ __forceinline__ void operator()(EPI_ARGS) const { EPI_RC
        bf16_t* dst = (bf16_t*)(ws + (brow < 512 ? OFF_VHT : OFF_SVT));
        const int r0 = (brow & 511) + wr * 64 + fr, c0 = bcol + wc * 32 + 8 * fq;
#pragma unroll
        for (int bj = 0; bj < 2; ++bj) {
            const f32x4 s0 = *(const f32x4*)((const float*)(lds + 4096) + wc * 32 + 8 * fq + bj * HALF), s1 = *(const f32x4*)((const float*)(lds + 4096) + wc * 32 + 8 * fq + bj * HALF + 4);
#pragma unroll
            for (int ai = 0; ai < 2; ++ai)
#pragma unroll
                for (int m = 0; m < 4; ++m) {
                    const f32x4 v0 = acc[ai][bj][m][0] * s0, v1 = acc[ai][bj][m][1] * s1;
                    u32x4 w; w.x = cvt_pk_bf16(v0[0], v0[1]); w.y = cvt_pk_bf16(v0[2], v0[3]); w.z = cvt_pk_bf16(v1[0], v1[1]); w.w = cvt_pk_bf16(v1[2], v1[3]);
                    *(u32x4*)(dst + vt_off(r0 + ai * HALF + m * 16, (size_t)(c0 + bj * HALF))) = w;
                }
        }
    }
};
struct EpiF32 {
    EPI_HEAD
    float* C; int ldc;
    __device__ __forceinline__ void operator()(EPI_ARGS) const { EPI_RC
#pragma unroll
        for (int ai = 0; ai < 2; ++ai)
#pragma unroll
            for (int m = 0; m < 4; ++m) {
                float* rp = C + (size_t)(brow + ai * HALF + wr * 64 + m * 16 + fr) * ldc + bcol + wc * 32 + 8 * fq;
#pragma unroll
                for (int bj = 0; bj < 2; ++bj) { *(f32x4*)(rp + bj * HALF) = acc[ai][bj][m][0]; *(f32x4*)(rp + bj * HALF + 4) = acc[ai][bj][m][1]; }
            }
    }
};
struct EpiBf16 {
    EPI_HEAD
    bf16_t* C; int ldc;
    __device__ __forceinline__ void operator()(EPI_ARGS) const { EPI_RC
#pragma unroll
        for (int ai = 0; ai < 2; ++ai)
#pragma unroll
            for (int m = 0; m < 4; ++m) {
                bf16_t* rp = C + (size_t)(brow + ai * HALF + wr * 64 + m * 16 + fr) * ldc + bcol + wc * 32 + 8 * fq;
#pragma unroll
                for (int bj = 0; bj < 2; ++bj) {
                    const f32x4 v0 = acc[ai][bj][m][0], v1 = acc[ai][bj][m][1];
                    u32x4 w; w.x = cvt_pk_bf16(v0[0], v0[1]); w.y = cvt_pk_bf16(v0[2], v0[3]); w.z = cvt_pk_bf16(v1[0], v1[1]); w.w = cvt_pk_bf16(v1[2], v1[3]);
                    *(u32x4*)(rp + bj * HALF) = w;
                }
            }
    }
};
struct EpiAct {
    EPI_HEAD_PRE(f32x4)
    const float* rh; bf16_t* act; char* lds;
    __device__ __forceinline__ f32x4 pre_issue(const pg8::Unit& u) const { return threadIdx.x < 256 ? *(const f32x4*)(rh + (size_t)(u.pm * 256 + threadIdx.x) * 4) : (f32x4){0.f, 0.f, 0.f, 0.f}; }
    __device__ __forceinline__ void pre_commit(f32x4 q) const { if (threadIdx.x < 256) ((float*)(lds + 4096))[threadIdx.x] = rsqrtf(((q[0] + q[1]) + (q[2] + q[3])) * (1.0f / DM) + EPS); }
    __device__ __forceinline__ void operator()(EPI_ARGS) const { EPI_RC
        const int c0 = (bcol >> 1) + wc * 32 + 8 * fq;
        float rsv[2][4];
#pragma unroll
        for (int ai = 0; ai < 2; ++ai)
#pragma unroll
            for (int m = 0; m < 4; ++m) rsv[ai][m] = ((const float*)(lds + 4096))[ai * HALF + wr * 64 + m * 16 + fr];
#pragma unroll
        for (int ai = 0; ai < 2; ++ai)
#pragma unroll
            for (int m = 0; m < 4; ++m) {
                const int row = brow + ai * HALF + wr * 64 + m * 16 + fr;
                const float rs = rsv[ai][m];
                float o[8];
#pragma unroll
                for (int n = 0; n < 2; ++n)
#pragma unroll
                    for (int j = 0; j < 4; ++j) { const float g = acc[ai][0][m][n][j] * rs, u = acc[ai][1][m][n][j] * rs; o[n * 4 + j] = siluf_(g) * u; }
                u32x4 w; w.x = cvt_pk_bf16(o[0], o[1]); w.y = cvt_pk_bf16(o[2], o[3]); w.z = cvt_pk_bf16(o[4], o[5]); w.w = cvt_pk_bf16(o[6], o[7]);
                *(u32x4*)(act + (size_t)row * DFF + c0) = w;
            }
    }
};
struct EpiFinal {
    EPI_HEAD
    float* out; const bf16_t* ple; const bf16_t* h2;
    __device__ __forceinline__ void operator()(EPI_ARGS) const { EPI_RC
#pragma unroll
        for (int ai = 0; ai < 2; ++ai)
#pragma unroll
            for (int mp = 0; mp < 1; ++mp) {
                u32x4 pv[4][2], hv[4][2];
#pragma unroll
                for (int mm = 0; mm < 4; ++mm)
#pragma unroll
                    for (int bj = 0; bj < 2; ++bj) {
                        const size_t ro = (size_t)(brow + ai * HALF + wr * 64 + (4 * mp + mm) * 16 + fr) * DM + bcol + wc * 32 + 8 * fq + bj * HALF;
                        pv[mm][bj] = *(const u32x4*)(ple + ro); hv[mm][bj] = *(const u32x4*)(h2 + ro);
                    }
#pragma unroll
                for (int mm = 0; mm < 4; ++mm)
#pragma unroll
                    for (int bj = 0; bj < 2; ++bj) {
                        const int m = 4 * mp + mm;
                        const size_t ro = (size_t)(brow + ai * HALF + wr * 64 + m * 16 + fr) * DM + bcol + wc * 32 + 8 * fq + bj * HALF;
                        const f32x4 a0 = acc[ai][bj][m][0], a1 = acc[ai][bj][m][1]; const u32x4 q = pv[mm][bj], hq = hv[mm][bj]; f32x4 x0, x1;
                        x0[0] = bflo(hq.x) + bflo(q.x) * sigmoidf_(a0[0]); x0[1] = bfhi(hq.x) + bfhi(q.x) * sigmoidf_(a0[1]); x0[2] = bflo(hq.y) + bflo(q.y) * sigmoidf_(a0[2]); x0[3] = bfhi(hq.y) + bfhi(q.y) * sigmoidf_(a0[3]);
                        x1[0] = bflo(hq.z) + bflo(q.z) * sigmoidf_(a1[0]); x1[1] = bfhi(hq.z) + bfhi(q.z) * sigmoidf_(a1[1]); x1[2] = bflo(hq.w) + bflo(q.w) * sigmoidf_(a1[2]); x1[3] = bfhi(hq.w) + bfhi(q.w) * sigmoidf_(a1[3]);
                        *(f32x4*)(out + ro) = x0; *(f32x4*)(out + ro + 4) = x1;
                    }
            }
    }
};

template <int WHICH> struct EpiRes {
    static constexpr bool PERM = true, AFTER_DRAIN = false, MIDSCALE = (WHICH == 1), ROWPRE = false; typedef int Pre; static constexpr int MID_T = 8;
    const float* gain; bf16_t* hb; float* part; unsigned* cnt; float* part2; char* lds; const float* parth;
    __device__ __forceinline__ void load_mid(const pg8::Unit& u) const {
        if (threadIdx.x < 256) { const f32x4 q = *(const f32x4*)(parth + (size_t)(u.pm * 256 + threadIdx.x) * 4); ((float*)(lds + 4096))[threadIdx.x] = rsqrtf(((q[0] + q[1]) + (q[2] + q[3])) * (1.0f / 512) + EPS); }
    }
    __device__ __forceinline__ float mid_scale(int r) const { return ((const float*)(lds + 4096))[r]; }
    __device__ __forceinline__ void operator()(EPI_ARGS) const { EPI_RC
        float* red = (float*)lds; const int tid = threadIdx.x;
#pragma unroll
        for (int ai = 0; ai < 2; ++ai)
#pragma unroll
            for (int m = 0; m < 4; ++m) {
                float s = 0.f;
#pragma unroll
                for (int bj = 0; bj < 2; ++bj)
#pragma unroll
                    for (int n = 0; n < 2; ++n) { const f32x4 v = acc[ai][bj][m][n]; s += (v[0] * v[0] + v[1] * v[1]) + (v[2] * v[2] + v[3] * v[3]); }
                s += __shfl_xor(s, 16); s += __shfl_xor(s, 32);
                if (fq == 0) red[(ai * HALF + wr * 64 + m * 16 + fr) * 4 + wc] = s;
            }
        f32x4 g[2][2]; u32x4 bv[4][2];
#pragma unroll
        for (int bj = 0; bj < 2; ++bj) { g[bj][0] = *(const f32x4*)(gain + bcol + bj * HALF + wc * 32 + 8 * fq); g[bj][1] = *(const f32x4*)(gain + bcol + bj * HALF + wc * 32 + 8 * fq + 4); }
#pragma unroll
        for (int m = 0; m < 4; ++m)
#pragma unroll
            for (int bj = 0; bj < 2; ++bj) bv[m][bj] = *(const u32x4*)(hb + (size_t)(brow + wr * 64 + m * 16 + fr) * DM + bcol + bj * HALF + wc * 32 + 8 * fq);
        __syncthreads();
        if (tid < 256) { const f32x4 v = *(const f32x4*)(red + tid * 4); __hip_atomic_store(part + (size_t)(brow + tid) * 4 + u.pn, (v[0] + v[1]) + (v[2] + v[3]), __ATOMIC_RELAXED, __HIP_MEMORY_SCOPE_AGENT); }
        asm volatile("s_waitcnt vmcnt(0)" ::: "memory");
        __syncthreads();
        if (tid == 0) {
            unsigned* c = cnt + u.pm * 64;
            __hip_atomic_fetch_add(c, 1u, __ATOMIC_RELAXED, __HIP_MEMORY_SCOPE_AGENT);
            unsigned sp = 0;
            while (__hip_atomic_load(c, __ATOMIC_RELAXED, __HIP_MEMORY_SCOPE_AGENT) < 4u && ++sp < (1u << 20)) __builtin_amdgcn_s_sleep(1);
        }
        __syncthreads();
#pragma unroll
        for (int ai = 0; ai < 2; ++ai) {
            float pq[4][4];
#pragma unroll
            for (int m = 0; m < 4; ++m) {
                const float* pp = part + (size_t)(brow + ai * HALF + wr * 64 + m * 16 + fr) * 4;
#pragma unroll
                for (int q = 0; q < 4; ++q) pq[m][q] = __hip_atomic_load(pp + q, __ATOMIC_RELAXED, __HIP_MEMORY_SCOPE_AGENT);
            }
            if (ai == 1) {
#pragma unroll
                for (int m = 0; m < 4; ++m)
#pragma unroll
                    for (int bj = 0; bj < 2; ++bj) bv[m][bj] = *(const u32x4*)(hb + (size_t)(brow + HALF + wr * 64 + m * 16 + fr) * DM + bcol + bj * HALF + wc * 32 + 8 * fq);
            }
#pragma unroll
            for (int m = 0; m < 4; ++m) {
                float s2 = 0.f; const float r = rsqrtf(((pq[m][0] + pq[m][1]) + (pq[m][2] + pq[m][3])) * (1.0f / DM) + EPS);
#pragma unroll
                for (int bj = 0; bj < 2; ++bj) { const size_t ro = (size_t)(brow + ai * HALF + wr * 64 + m * 16 + fr) * DM + bcol + bj * HALF + wc * 32 + 8 * fq;
                    const u32x4 q = bv[m][bj]; const f32x4 b0 = {bflo(q.x), bfhi(q.x), bflo(q.y), bfhi(q.y)}, b1 = {bflo(q.z), bfhi(q.z), bflo(q.w), bfhi(q.w)};
                    f32x4 h0, h1;
#pragma unroll
                    for (int j = 0; j < 4; ++j) { h0[j] = b0[j] + acc[ai][bj][m][0][j] * r * g[bj][0][j]; h1[j] = b1[j] + acc[ai][bj][m][1][j] * r * g[bj][1][j]; s2 += h0[j] * h0[j] + h1[j] * h1[j]; }
                    u32x4 w; w.x = cvt_pk_bf16(h0[0], h0[1]); w.y = cvt_pk_bf16(h0[2], h0[3]); w.z = cvt_pk_bf16(h1[0], h1[1]); w.w = cvt_pk_bf16(h1[2], h1[3]);
                    *(u32x4*)(hb + ro) = w; }
                if (WHICH == 1) { s2 += __shfl_xor(s2, 16); s2 += __shfl_xor(s2, 32); if (fq == 0) red[(ai * HALF + wr * 64 + m * 16 + fr) * 4 + wc] = s2; }
            }
        }
        if (WHICH == 1) {
            __syncthreads();
            if (tid < 256) { const f32x4 v = *(const f32x4*)(red + tid * 4); part2[(size_t)(brow + tid) * 4 + u.pn] = (v[0] + v[1]) + (v[2] + v[3]); }
        }
    }
};

template <class Epi>
__device__ __forceinline__ void run_gemm(const bf16_t* A, const bf16_t* Bt, int M, int N, int K, char* shm, const Epi& epi) {
    asm volatile("" : "+s"(K));
    pg8::Gemm g{A, Bt, M, N, K}; pg8::StaticOrder S; S.init(M, N, (int)gridDim.x, (int)blockIdx.x);
    pg8::gemm_phase<Epi, pg8::StaticOrder, true, true>((PG8_LAS unsigned char*)shm, g, S, epi);
}

__device__ __forceinline__ int src_col(int r, int mode) {
    if (mode == 0) return r;
    if (mode == 2) { const int g = r >> 9; const int sg = g == 0 ? 0 : g == 1 ? 1 : g == 2 ? 3 : g == 3 ? 4 : g == 4 ? 5 : g == 5 ? 2 : 6; return sg * 512 + (r & 511); }
    const int tile = r >> 8, w = r & 255, bj = w >> 7, j = w & 127;
    return bj * DFF + tile * 128 + j;
}
__device__ void conv_weight(const float* __restrict__ W, int K, int ldw, bf16_t* __restrict__ Wt, int Nrows, int mode, const float* __restrict__ gain, float* lds, int vb, int nvb) {
    const int nk = K / 64, nr = Nrows / 256, tid = threadIdx.x;
    for (int it = vb; it < nk * nr; it += nvb) {
        const int k0 = (it % nk) * 64, r0 = (it / nk) * 256;
        f32x4 v[8];
        const int sc = src_col(r0 + (tid & 63) * 4, mode);
#pragma unroll
        for (int i = 0; i < 8; ++i) v[i] = __builtin_nontemporal_load((const f32x4*)(W + (size_t)(k0 + (tid >> 6) + 8 * i) * ldw + sc));
        __syncthreads();
#pragma unroll
        for (int i = 0; i < 8; ++i) *(f32x4*)(lds + ((tid >> 6) + 8 * i) * 260 + (tid & 63) * 4) = v[i];
        __syncthreads();
#pragma unroll
        for (int j = 0; j < 4; ++j) {
            const int e = tid + 512 * j, r = e & 255, kg = e >> 8;
            float f[8];
#pragma unroll
            for (int i = 0; i < 8; ++i) { f[i] = lds[(8 * kg + i) * 260 + r]; if (gain) f[i] *= gain[k0 + 8 * kg + i]; }
            u32x4 w; w.x = cvt_pk_bf16(f[0], f[1]); w.y = cvt_pk_bf16(f[2], f[3]); w.z = cvt_pk_bf16(f[4], f[5]); w.w = cvt_pk_bf16(f[6], f[7]);
            *(u32x4*)(Wt + (size_t)(r0 + r) * K + k0 + 8 * kg) = w;
        }
    }
}
__device__ void phase0_rest(const Params& p, char* shm) {
    float* lds = (float*)shm; char* ws = p.ws;
    const int vb = blockIdx.x, nvb = gridDim.x;
    conv_weight(p.w_out, DM, DM, (bf16_t*)(ws + OFF_WOUT), DM, 0, nullptr, lds, vb, nvb);
    conv_weight(p.w_gu, DM, 2 * DFF, (bf16_t*)(ws + OFF_WGU), 2 * DFF, 1, p.g_ffn_pre, lds, vb, nvb);
    conv_weight(p.w_down, DFF, DM, (bf16_t*)(ws + OFF_WDN), DM, 0, nullptr, lds, vb, nvb);
    conv_weight(p.w_pp, PLE, DM, (bf16_t*)(ws + OFF_WPP), DM, 0, nullptr, lds, vb, nvb);
    conv_weight(p.w_pg, DM, DM, (bf16_t*)(ws + OFF_WPG), DM, 0, nullptr, lds, vb, nvb);
    __syncthreads();
    bf16_t* pb = (bf16_t*)(ws + OFF_PB);
    for (size_t i0 = (size_t)blockIdx.x * 512 + threadIdx.x; i0 < (size_t)MT * PLE / 4; i0 += (size_t)gridDim.x * 512 * 4) {
        f32x4 v[4];
#pragma unroll
        for (int j = 0; j < 4; ++j) { const size_t i = i0 + (size_t)j * gridDim.x * 512; if (i < (size_t)MT * PLE / 4) v[j] = __builtin_nontemporal_load((const f32x4*)(p.p + i * 4)); }
#pragma unroll
        for (int j = 0; j < 4; ++j) { const size_t i = i0 + (size_t)j * gridDim.x * 512; if (i < (size_t)MT * PLE / 4) { u32x2 w; w.x = cvt_pk_bf16(v[j][0], v[j][1]); w.y = cvt_pk_bf16(v[j][2], v[j][3]); *(u32x2*)(pb + i * 4) = w; } }
    }
    __syncthreads();
}
__device__ void phase0(const Params& p, char* shm) {
    float* lds = (float*)shm; char* ws = p.ws;
    const int vb = blockIdx.x, nvb = gridDim.x;
    conv_weight(p.w_in, DM, NIN, (bf16_t*)(ws + OFF_WIN), NIN, 2, p.g_attn_pre, lds, vb, nvb);
    if (blockIdx.x == 0) { float* lb = (float*)(ws + OFF_LB); const int c = threadIdx.x; const float l = sigmoidf_(p.gamma[c] - p.gamma[512 + c]); lb[c] = l; lb[512 + c] = 1.0f - l; }
    const int wid = threadIdx.x >> 6, lane = threadIdx.x & 63;
    bf16_t* xb = (bf16_t*)(ws + OFF_XB); float* rx = (float*)(ws + OFF_RX);
    for (int row0 = (blockIdx.x * 8 + wid) * 4; row0 < MT; row0 += gridDim.x * 32) {
        f32x4 v[4][4];
#pragma unroll
        for (int r = 0; r < 4; ++r)
#pragma unroll
            for (int i = 0; i < 4; ++i) v[r][i] = __builtin_nontemporal_load((const f32x4*)(p.x + (size_t)(row0 + r) * DM + i * 256 + lane * 4));
#pragma unroll
        for (int r = 0; r < 4; ++r) {
            float ss = 0.f;
#pragma unroll
            for (int i = 0; i < 4; ++i) { const f32x4 t = v[r][i]; ss += t[0] * t[0] + t[1] * t[1] + t[2] * t[2] + t[3] * t[3];
                u32x2 w; w.x = cvt_pk_bf16(t[0], t[1]); w.y = cvt_pk_bf16(t[2], t[3]); *(u32x2*)(xb + (size_t)(row0 + r) * DM + i * 256 + lane * 4) = w; }
            ss = wave_sum(ss);
            if (lane == 0) rx[row0 + r] = rsqrtf(ss * (1.0f / DM) + EPS);
        }
    }
}

template <int WHICH>
__device__ void phase_res(const Params& p) {
    char* ws = p.ws; const int wid = threadIdx.x >> 6, lane = threadIdx.x & 63;
    const float* src = (const float*)(ws + (WHICH == 1 ? OFF_QT : OFF_Y)); const float* base = WHICH == 1 ? p.x : p.out; const float* gn = WHICH == 1 ? p.g_attn_post : p.g_ffn_post;
    bf16_t* hb = (bf16_t*)(ws + (WHICH == 1 ? OFF_XB : OFF_H2B)); float* rh = (float*)(ws + OFF_RH1);
    f32x4 g[4];
#pragma unroll
    for (int i = 0; i < 4; ++i) g[i] = *(const f32x4*)(gn + i * 256 + lane * 4);
    for (int row0 = (blockIdx.x * 8 + wid) * 2; row0 < MT; row0 += gridDim.x * 16) {
        f32x4 mv[2][4], xv[2][4];
#pragma unroll
        for (int r = 0; r < 2; ++r)
#pragma unroll
            for (int i = 0; i < 4; ++i) { mv[r][i] = __builtin_nontemporal_load((const f32x4*)(src + (size_t)(row0 + r) * DM + i * 256 + lane * 4)); xv[r][i] = __builtin_nontemporal_load((const f32x4*)(base + (size_t)(row0 + r) * DM + i * 256 + lane * 4)); }
#pragma unroll
        for (int r = 0; r < 2; ++r) {
            float ss = 0.f;
#pragma unroll
            for (int i = 0; i < 4; ++i) ss += mv[r][i][0] * mv[r][i][0] + mv[r][i][1] * mv[r][i][1] + mv[r][i][2] * mv[r][i][2] + mv[r][i][3] * mv[r][i][3];
            ss = wave_sum(ss); const float rr = rsqrtf(ss * (1.0f / DM) + EPS); float s2 = 0.f;
#pragma unroll
            for (int i = 0; i < 4; ++i) { const int c = i * 256 + lane * 4; f32x4 h;
#pragma unroll
                for (int j = 0; j < 4; ++j) { h[j] = xv[r][i][j] + mv[r][i][j] * rr * g[i][j]; s2 += h[j] * h[j]; }
                *(f32x4*)(p.out + (size_t)(row0 + r) * DM + c) = h; u32x2 w; w.x = cvt_pk_bf16(h[0], h[1]); w.y = cvt_pk_bf16(h[2], h[3]); *(u32x2*)(hb + (size_t)(row0 + r) * DM + c) = w; }
            if (WHICH == 1) { s2 = wave_sum(s2); if (lane == 0) rh[row0 + r] = rsqrtf(s2 * (1.0f / DM) + EPS); }
        }
    }
}

#define MFMA32(a, b, c) __builtin_amdgcn_mfma_f32_32x32x16_bf16((a), (b), (c), 0, 0, 0)
#define MFMA16(a, b, c) __builtin_amdgcn_mfma_f32_16x16x32_bf16((a), (b), (c), 0, 0, 0)
__device__ __forceinline__ bf16x8 mk8(u32x2 a, u32x2 b) { u32x4 t; t.x = a.x; t.y = a.y; t.z = b.x; t.w = b.y; return __builtin_bit_cast(bf16x8, t); }
__device__ void phase_attn(const Params& p, char* shm, unsigned* queue) {
    char* ws = p.ws; const int tid = opaque_tid(), h = tid >> 6, lane = tid & 63, n = lane & 31, hh = lane >> 5;
    const bf16_t* SQ = (const bf16_t*)(ws + OFF_SQ); const bf16_t* SK = (const bf16_t*)(ws + OFF_SQ + SZ_HALF); const bf16_t* SVT = (const bf16_t*)(ws + OFF_SVT);
    bf16_t* am = (bf16_t*)(ws + OFF_AMIX); float* red = (float*)shm;
    int* itp = (int*)(shm + 2048);
    unsigned nxt_it = 0;
    if (threadIdx.x == 0) nxt_it = __hip_atomic_fetch_add(queue, 1u, __ATOMIC_RELAXED, __HIP_MEMORY_SCOPE_AGENT);
    for (;;) {
        __syncthreads();
        if (threadIdx.x == 0) { *itp = (int)nxt_it; if (nxt_it < NB * 128) nxt_it = __hip_atomic_fetch_add(queue, 1u, __ATOMIC_RELAXED, __HIP_MEMORY_SCOPE_AGENT); }
        __syncthreads();
        const int it0 = *itp; if (it0 >= NB * 128) break;
        const int it = NB * 128 - 1 - it0;
        const int b = it >> 7, qb = it & 127, t0 = qb * 32;
        const size_t tokq = (size_t)b * NT + t0 + n;
        f32x16 o0, o1;
#pragma unroll
        for (int r = 0; r < 16; ++r) { o0[r] = 0.f; o1[r] = 0.f; }
        float R = 1.0f;
        char* sK = shm + 4096 + h * 9728; char* sV = sK + 4608;
        const int kr = lane >> 3, kc = lane & 7, vr = lane >> 2, vc = lane & 3;
        u32x4 kcur[4], vcur[4];
#define ATT_TILE(kd, vd, tokb) do { const size_t _tb = (tokb); \
            _Pragma("unroll") for (int i = 0; i < 4; ++i) { kd[i] = *(const u32x4*)(SK + (_tb + kr + 8 * i) * 512 + h * 64 + kc * 8); \
                                                           vd[i] = *(const u32x4*)(SVT + vt_off(h * 64 + vr + 16 * i, _tb) + vc * 8); } } while (0)
        ATT_TILE(kcur, vcur, (size_t)b * NT + t0);
        bf16x8 qf[4];
        {
            u32x4 qc[4];
#pragma unroll
            for (int i = 0; i < 4; ++i) qc[i] = *(const u32x4*)(SQ + ((size_t)b * NT + t0 + kr + 8 * i) * 512 + h * 64 + kc * 8);
            asm volatile("" ::: "memory");
#pragma unroll
            for (int i = 0; i < 4; ++i) *(u32x4*)(sK + (kr + 8 * i) * 144 + kc * 16) = qc[i];
            asm volatile("" ::: "memory");
#pragma unroll
            for (int ks = 0; ks < 4; ++ks) qf[ks] = *(const bf16x8*)(sK + n * 144 + (16 * ks + 8 * hh) * 2);
            asm volatile("" ::: "memory");
        }
        for (int kb = qb; kb >= 0; --kb) {
            const int s1 = (kb > 0 ? kb - 1 : 0) * 32;
            u32x4 knx[4], vnx[4];
            ATT_TILE(knx, vnx, (size_t)b * NT + s1);
            asm volatile("" ::: "memory");
#pragma unroll
            for (int i = 0; i < 4; ++i) { *(u32x4*)(sK + (kr + 8 * i) * 144 + kc * 16) = kcur[i]; *(u32x4*)(sV + (vr + 16 * i) * 80 + vc * 16) = vcur[i]; }
            asm volatile("" ::: "memory");
            bf16x8 kf[4]; u32x2 vf[2][2][2];
#pragma unroll
            for (int ks = 0; ks < 4; ++ks) kf[ks] = *(const bf16x8*)(sK + n * 144 + (16 * ks + 8 * hh) * 2);
#pragma unroll
            for (int db = 0; db < 2; ++db)
#pragma unroll
                for (int s = 0; s < 2; ++s)
#pragma unroll
                    for (int hf = 0; hf < 2; ++hf) vf[db][s][hf] = *(const u32x2*)(sV + (32 * db + n) * 80 + (16 * s + 8 * hf + 4 * hh) * 2);
            f32x16 st;
#pragma unroll
            for (int r = 0; r < 16; ++r) st[r] = 0.f;
#pragma unroll
            for (int ks = 0; ks < 4; ++ks) st = MFMA32(kf[ks], qf[ks], st);
            float mm[16], be[16];
#pragma unroll
            for (int r = 0; r < 16; ++r) { const float e = fexp2(st[r]); mm[r] = frcp(1.0f + e); be[r] = 1.0f - mm[r]; }
            if (kb == qb) {
#pragma unroll
                for (int r = 0; r < 16; ++r) { const bool act = ((r & 3) + 8 * (r >> 2) + 4 * hh) < n; mm[r] = act ? mm[r] : 1.0f; be[r] = act ? be[r] : 0.0f; }
            }
            float go[4], gp[4], T[4];
#pragma unroll
            for (int g = 0; g < 4; ++g) { go[g] = (mm[4 * g] * mm[4 * g + 1]) * (mm[4 * g + 2] * mm[4 * g + 3]); gp[g] = __shfl_xor(go[g], 32); }
            T[3] = 1.0f; T[2] = go[3] * gp[3]; T[1] = T[2] * (go[2] * gp[2]); T[0] = T[1] * (go[1] * gp[1]);
            const float tot = T[0] * (go[0] * gp[0]);
            float aa[16];
#pragma unroll
            for (int g = 0; g < 4; ++g) {
                float x = R * T[g] * (hh == 0 ? gp[g] : 1.0f);
                aa[4 * g + 3] = be[4 * g + 3] * x; x *= mm[4 * g + 3];
                aa[4 * g + 2] = be[4 * g + 2] * x; x *= mm[4 * g + 2];
                aa[4 * g + 1] = be[4 * g + 1] * x; x *= mm[4 * g + 1];
                aa[4 * g + 0] = be[4 * g + 0] * x;
            }
            u32x4 p0, p1;
            p0.x = cvt_pk_bf16(aa[0], aa[1]); p0.y = cvt_pk_bf16(aa[2], aa[3]); p0.z = cvt_pk_bf16(aa[4], aa[5]); p0.w = cvt_pk_bf16(aa[6], aa[7]);
            p1.x = cvt_pk_bf16(aa[8], aa[9]); p1.y = cvt_pk_bf16(aa[10], aa[11]); p1.z = cvt_pk_bf16(aa[12], aa[13]); p1.w = cvt_pk_bf16(aa[14], aa[15]);
            const bf16x8 pf0 = __builtin_bit_cast(bf16x8, p0), pf1 = __builtin_bit_cast(bf16x8, p1);
            o0 = MFMA32(mk8(vf[0][0][0], vf[0][0][1]), pf0, o0); o0 = MFMA32(mk8(vf[0][1][0], vf[0][1][1]), pf1, o0);
            o1 = MFMA32(mk8(vf[1][0][0], vf[1][0][1]), pf0, o1); o1 = MFMA32(mk8(vf[1][1][0], vf[1][1][1]), pf1, o1);
            R *= tot;
            if (__ballot(R >= 0x1p-134f) == 0ull) break;
#pragma unroll
            for (int i = 0; i < 4; ++i) { kcur[i] = knx[i]; vcur[i] = vnx[i]; }
        }
        float ss = 0.f;
#pragma unroll
        for (int r = 0; r < 16; ++r) ss += o0[r] * o0[r] + o1[r] * o1[r];
        ss += __shfl_xor(ss, 32);
        __syncthreads();
        if (hh == 0) red[h * 32 + n] = ss;
        __syncthreads();
        float tsum = 0.f;
#pragma unroll
        for (int w = 0; w < 8; ++w) tsum += red[w * 32 + n];
        const float rr = rsqrtf(tsum * (1.0f / 512) + EPS);
        f32x4 gwv[2][4];
#pragma unroll
        for (int db = 0; db < 2; ++db)
#pragma unroll
            for (int g = 0; g < 4; ++g) gwv[db][g] = *(const f32x4*)(p.g_sb + h * 64 + 32 * db + 8 * g + 4 * hh);
#pragma unroll
        for (int db = 0; db < 2; ++db)
#pragma unroll
            for (int g = 0; g < 4; ++g) {
                const int d0 = 32 * db + 8 * g + 4 * hh; const f32x4 gw = gwv[db][g];
                float v[4];
#pragma unroll
                for (int j = 0; j < 4; ++j) v[j] = (db == 0 ? o0[4 * g + j] : o1[4 * g + j]) * rr * gw[j];
                u32x2 w; w.x = cvt_pk_bf16(v[0], v[1]); w.y = cvt_pk_bf16(v[2], v[3]);
                *(u32x2*)(am + tokq * DM + 512 + h * 64 + d0) = w;
            }
    }
}

#define LDS_BAR() do { asm volatile("s_waitcnt lgkmcnt(0)" ::: "memory"); __builtin_amdgcn_s_barrier(); asm volatile("" ::: "memory"); } while (0)
constexpr int HSEG = 8;
__device__ __forceinline__ int seg_first(int s) { return s < 2 ? 9 * s : (s < 6 ? 18 + 8 * (s - 2) : 50 + 7 * (s - 6)); }
__device__ __forceinline__ int seg_len(int s) { return s < 2 ? 9 : (s < 6 ? 8 : 7); }
template <bool FULL>
__device__ void phase_hgseg(const Params& p, char* shm, int bh, int seg) {
    char* ws = p.ws; const int tid = opaque_tid(), w = tid >> 6, lane = tid & 63, fr = lane & 15, fq = lane >> 4, kp = tid & 63, r8 = tid >> 6;
    const int b = bh >> 2, h = bh & 3;
    const unsigned short* LF = (const unsigned short*)(ws + OFF_BC); const bf16_t* QT = (const bf16_t*)(ws + OFF_QT);
    const bf16_t* G = (const bf16_t*)(ws + OFF_QT + 3 * SZ_HALF); const bf16_t* VHT = (const bf16_t*)(ws + OFF_VHT);
    bf16_t* am = (bf16_t*)(ws + OFF_AMIX); float* parth = (float*)(ws + OFF_DC); float* SLOC = (float*)(ws + OFF_SLOC); float* DSEG = (float*)(ws + OFF_SLOC + 32 * MiB);
    float* qs = (float*)shm; float* dvec = (float*)(shm + 4096); float* red = (float*)(shm + 4608);
    char* sQs = shm + 8192; char* sQd = sQs + 17408; char* sKd = sQd + 17408; char* sP = sKd + 17408; char* keT = sP + 9216;
    f32x4 S[8];
#pragma unroll
    for (int kb = 0; kb < 8; ++kb) S[kb] = (f32x4){0.f, 0.f, 0.f, 0.f};
    f32x2 lfn[8]; unsigned qn[8]; bf16x8 vn[2]; u32x2 gn[4];
#define HG_LOAD(cc) do { const size_t _t0 = (size_t)b * NT + 64 * (cc); \
        _Pragma("unroll") for (int i = 0; i < 8; ++i) { const size_t a_ = (_t0 + 8 * r8 + i) * 512 + h * 128 + 2 * kp; lfn[i] = unpk_f16(*(const unsigned*)(LF + a_)); if (FULL) qn[i] = *(const unsigned*)(QT + a_); } \
        _Pragma("unroll") for (int ks = 0; ks < 2; ++ks) vn[ks] = *(const bf16x8*)(VHT + vt_off(h * 128 + 16 * w + fr, _t0) + 32 * ks + 8 * fq); \
        if (FULL) { _Pragma("unroll") for (int tb = 0; tb < 4; ++tb) gn[tb] = *(const u32x2*)(G + (_t0 + 16 * tb + fr) * 512 + h * 128 + 16 * w + 4 * fq); } } while (0)
    const int c0 = seg_first(seg), HCH = seg_len(seg);
    HG_LOAD(c0);
    if (FULL) {
        for (int s = 0; s < seg; ++s) {
            const float* sl = SLOC + ((size_t)(bh * HSEG + s) * 128 + 16 * w + fr) * 128 + 4 * fq; const float* ds = DSEG + (size_t)(bh * HSEG + s) * 128 + 4 * fq;
            f32x4 lv[8], dv[8];
#pragma unroll
            for (int kb = 0; kb < 8; ++kb) { lv[kb] = *(const f32x4*)(sl + 16 * kb); dv[kb] = *(const f32x4*)(ds + 16 * kb); }
#pragma unroll
            for (int kb = 0; kb < 8; ++kb) S[kb] = S[kb] * dv[kb] + lv[kb];
        }
    }
    f32x4 gw = {0.f, 0.f, 0.f, 0.f};
    if (FULL) gw = *(const f32x4*)(p.g_hg + h * 128 + 16 * w + 4 * fq);
    float dsum0 = 0.f, dsum1 = 0.f;
    for (int ci = 0; ci < HCH; ++ci) {
        const int c = c0 + ci; const size_t tok0 = (size_t)b * NT + 64 * c;
        f32x2 lfv[8], kkv[8]; unsigned qv[8]; bf16x8 vfr[2]; u32x2 gv[4];
#pragma unroll
        for (int i = 0; i < 8; ++i) { lfv[i] = lfn[i]; kkv[i].x = 1.0f - fexp2(lfn[i].x); kkv[i].y = 1.0f - fexp2(lfn[i].y); if (FULL) qv[i] = qn[i]; }
        vfr[0] = vn[0]; vfr[1] = vn[1];
        if (FULL) {
#pragma unroll
            for (int tb = 0; tb < 4; ++tb) gv[tb] = gn[tb];
        }
        { const int cn = ci < HCH - 1 ? c + 1 : c; HG_LOAD(cn); }
        f32x2 run = {0.f, 0.f};
#pragma unroll
        for (int i = 0; i < 8; ++i) { run += lfv[i]; lfv[i] = run; }
        *(f32x2*)(qs + r8 * 128 + 2 * kp) = run;
        LDS_BAR();
        if (FULL && ci > 0 && tid < 64) { float s = 0.f;
#pragma unroll
            for (int ww = 0; ww < 8; ++ww) s += red[ww * 64 + tid];
            parth[(tok0 - 64 + tid) * 4 + h] = s; }
        f32x2 off = {0.f, 0.f}, bmid = {0.f, 0.f}, blast = {0.f, 0.f};
#pragma unroll
        for (int j = 0; j < 8; ++j) { const f32x2 q = *(const f32x2*)(qs + j * 128 + 2 * kp); if (j < r8) off += q; if (j < 4) bmid += q; blast += q; }
        if (r8 == 0) { f32x2 d; d.x = fexp2(blast.x); d.y = fexp2(blast.y); *(f32x2*)(dvec + 2 * kp) = d; dsum0 += blast.x; dsum1 += blast.y; }
        f32x2 emid, elast;
        emid.x = fexp2(bmid.x); emid.y = fexp2(bmid.y); elast.x = fexp2(blast.x - bmid.x); elast.y = fexp2(blast.y - bmid.y);
        float ke0[8], ke1[8];
#pragma unroll
        for (int i = 0; i < 8; ++i) {
            const int t = 8 * r8 + i; const f32x2 bb = off + lfv[i];
            const float k0 = kkv[i].x, k1 = kkv[i].y;
            const float f0 = fexp2(bmid.x - bb.x), f1 = fexp2(bmid.y - bb.y);
            const float kd0 = k0 * f0, kd1 = k1 * f1;
            ke0[i] = kd0 * elast.x; ke1[i] = kd1 * elast.y;
            if (FULL) {
                const float e0 = fexp2(bb.x - bmid.x), e1 = fexp2(bb.y - bmid.y);
                const float qd0 = bflo(qv[i]) * e0, qd1 = bfhi(qv[i]) * e1;
                *(unsigned*)(sQd + t * 272 + kp * 4) = cvt_pk_bf16(qd0, qd1);
                *(unsigned*)(sQs + t * 272 + kp * 4) = cvt_pk_bf16(qd0 * emid.x, qd1 * emid.y);
                *(unsigned*)(sKd + t * 272 + kp * 4) = cvt_pk_bf16(kd0, kd1);
            }
        }
        { u32x4 a0, a1;
          a0.x = cvt_pk_bf16(ke0[0], ke0[1]); a0.y = cvt_pk_bf16(ke0[2], ke0[3]); a0.z = cvt_pk_bf16(ke0[4], ke0[5]); a0.w = cvt_pk_bf16(ke0[6], ke0[7]);
          a1.x = cvt_pk_bf16(ke1[0], ke1[1]); a1.y = cvt_pk_bf16(ke1[2], ke1[3]); a1.z = cvt_pk_bf16(ke1[4], ke1[5]); a1.w = cvt_pk_bf16(ke1[6], ke1[7]);
          *(u32x4*)(keT + (2 * kp) * 144 + r8 * 16) = a0; *(u32x4*)(keT + (2 * kp + 1) * 144 + r8 * 16) = a1; }
        LDS_BAR();
        if (FULL) {
            {
                const int tb = w >> 1;
                bf16x8 qf[4], kf[2][4];
#pragma unroll
                for (int ks = 0; ks < 4; ++ks) { qf[ks] = *(const bf16x8*)(sQd + (16 * tb + fr) * 272 + 64 * ks + 16 * fq);
#pragma unroll
                    for (int u = 0; u < 2; ++u) kf[u][ks] = *(const bf16x8*)(sKd + (16 * (2 * (w & 1) + u) + fr) * 272 + 64 * ks + 16 * fq); }
                __builtin_amdgcn_sched_barrier(0);
#pragma unroll
                for (int u = 0; u < 2; ++u) {
                    const int sb = 2 * (w & 1) + u;
                    f32x4 acc = {0.f, 0.f, 0.f, 0.f};
                    if (sb <= tb) {
#pragma unroll
                        for (int ks = 0; ks < 4; ++ks) acc = MFMA16(kf[u][ks], qf[ks], acc);
                    }
                    const int t = 16 * tb + fr, s0 = 16 * sb + 4 * fq;
#pragma unroll
                    for (int j = 0; j < 4; ++j) acc[j] = (s0 + j <= t) ? acc[j] : 0.f;
                    u32x2 o; o.x = cvt_pk_bf16(acc[0], acc[1]); o.y = cvt_pk_bf16(acc[2], acc[3]);
                    *(u32x2*)(sP + t * 144 + s0 * 2) = o;
                }
            }
            LDS_BAR();
            bf16x8 sb16[4];
#pragma unroll
            for (int ks = 0; ks < 4; ++ks) { u32x4 t4; t4.x = cvt_pk_bf16(S[2 * ks][0], S[2 * ks][1]); t4.y = cvt_pk_bf16(S[2 * ks][2], S[2 * ks][3]); t4.z = cvt_pk_bf16(S[2 * ks + 1][0], S[2 * ks + 1][1]); t4.w = cvt_pk_bf16(S[2 * ks + 1][2], S[2 * ks + 1][3]); sb16[ks] = __builtin_bit_cast(bf16x8, t4); }
            bf16x8 qsf[4][4], pf[4][2];
#pragma unroll
            for (int tb = 0; tb < 4; ++tb) {
#pragma unroll
                for (int ks = 0; ks < 4; ++ks) { const u32x2 lo = *(const u32x2*)(sQs + (16 * tb + fr) * 272 + (32 * ks + 4 * fq) * 2), hi = *(const u32x2*)(sQs + (16 * tb + fr) * 272 + (32 * ks + 16 + 4 * fq) * 2); qsf[tb][ks] = mk8(lo, hi); }
#pragma unroll
                for (int ks = 0; ks < 2; ++ks) pf[tb][ks] = *(const bf16x8*)(sP + (16 * tb + fr) * 144 + 64 * ks + 16 * fq);
            }
            __builtin_amdgcn_sched_barrier(0);
#pragma unroll
            for (int tb = 0; tb < 4; ++tb) {
                f32x4 acc = {0.f, 0.f, 0.f, 0.f};
#pragma unroll
                for (int ks = 0; ks < 4; ++ks) acc = MFMA16(sb16[ks], qsf[tb][ks], acc);
#pragma unroll
                for (int ks = 0; ks < 2; ++ks) acc = MFMA16(vfr[ks], pf[tb][ks], acc);
                float s = (acc[0] * acc[0] + acc[1] * acc[1]) + (acc[2] * acc[2] + acc[3] * acc[3]);
                s += __shfl_xor(s, 16); s += __shfl_xor(s, 32);
                if (fq == 0) red[w * 64 + 16 * tb + fr] = s;
                const u32x2 g2 = gv[tb];
                u32x2 o; o.x = cvt_pk_bf16(acc[0] * gw[0] * bflo(g2.x), acc[1] * gw[1] * bfhi(g2.x)); o.y = cvt_pk_bf16(acc[2] * gw[2] * bflo(g2.y), acc[3] * gw[3] * bfhi(g2.y));
                *(u32x2*)(am + (tok0 + 16 * tb + fr) * DM + h * 128 + 16 * w + 4 * fq) = o;
            }
        }
#pragma unroll
        for (int kg = 0; kg < 2; ++kg) {
            f32x4 dd[4]; bf16x8 kf[4][2];
#pragma unroll
            for (int q = 0; q < 4; ++q) { const int kb = 4 * kg + q; dd[q] = *(const f32x4*)(dvec + 16 * kb + 4 * fq);
#pragma unroll
                for (int ks = 0; ks < 2; ++ks) kf[q][ks] = *(const bf16x8*)(keT + (16 * kb + fr) * 144 + 64 * ks + 16 * fq); }
            __builtin_amdgcn_sched_barrier(0);
#pragma unroll
            for (int q = 0; q < 4; ++q) { const int kb = 4 * kg + q;
                f32x4 acc = S[kb] * dd[q];
#pragma unroll
                for (int ks = 0; ks < 2; ++ks) acc = MFMA16(kf[q][ks], vfr[ks], acc);
                S[kb] = acc; }
        }
    }
    if (FULL) {
        __syncthreads();
        if (tid < 64) { float s = 0.f;
#pragma unroll
            for (int ww = 0; ww < 8; ++ww) s += red[ww * 64 + tid];
            parth[((size_t)b * NT + 64 * (c0 + HCH - 1) + tid) * 4 + h] = s; }
    } else {
#pragma unroll
        for (int kb = 0; kb < 8; ++kb) *(f32x4*)(SLOC + ((size_t)(bh * HSEG + seg) * 128 + 16 * w + fr) * 128 + 16 * kb + 4 * fq) = S[kb];
        if (r8 == 0) { f32x2 d; d.x = fexp2(dsum0); d.y = fexp2(dsum1); *(f32x2*)(DSEG + (size_t)(bh * HSEG + seg) * 128 + 2 * kp) = d; }
    }
    __syncthreads();
#undef HG_LOAD
}

#define XB_TMO      128
#define XB_XCNT(j)  (256  + 64 * (j))
#define XB_XSUB(j)  (1280 + 64 * (j))
#define XB_XGEN(j)  (2304 + 64 * (j))
#define XB_TOP      3328
#define XB_TOPGEN   3392
#define XCD_BAR_WORDS 3456
#define XB_SPIN_CAP (1u << 18)
#define LAS __attribute__((address_space(3)))

__device__ __forceinline__ unsigned xb_ld(unsigned* p)              { return __hip_atomic_load(p, __ATOMIC_RELAXED, __HIP_MEMORY_SCOPE_AGENT); }
__device__ __forceinline__ unsigned xb_add(unsigned* p, unsigned v) { return __hip_atomic_fetch_add(p, v, __ATOMIC_RELAXED, __HIP_MEMORY_SCOPE_AGENT); }
__device__ __forceinline__ unsigned xb_xcc_id() { return (unsigned)__builtin_amdgcn_s_getreg((3 << 11) | 20) & 0xFu; }
#define XB_SPIN(cond, bar) do { unsigned _sp = 0; while (cond) { __builtin_amdgcn_s_sleep(1); \
    if ((++_sp & 255u) == 0u) { if (xb_ld(&(bar)[XB_TMO])) break; if (_sp > XB_SPIN_CAP) { atomicAdd(&(bar)[XB_TMO], 1u); break; } } } } while (0)

struct XcdBarrier {
    unsigned* bar; unsigned x;
    volatile LAS unsigned* st;
};

__device__ __forceinline__ XcdBarrier xcd_barrier_post(unsigned* bar, volatile LAS unsigned* st) {
    XcdBarrier b; b.bar = bar; b.x = xb_xcc_id(); b.st = st;
    if (threadIdx.x == 0) (void)xb_add(&bar[XB_XCNT(b.x)], 1u);
    return b;
}
__device__ __forceinline__ void xcd_barrier_complete(unsigned* bar, unsigned x, unsigned& nloc, unsigned& nx) {
    const unsigned G = gridDim.x * gridDim.y * gridDim.z;
    unsigned sum, cnt, mine, sp = 0u;
    for (;;) {
        sum = 0u; cnt = 0u; mine = 0u;
#pragma unroll
        for (unsigned j = 0; j < 16; ++j) { const unsigned c = xb_ld(&bar[XB_XCNT(j)]); sum += c; cnt += (c > 0u) ? 1u : 0u; mine = (j == x) ? c : mine; }
        if (sum == G) break;
        __builtin_amdgcn_s_sleep(1);
        if ((++sp & 255u) == 0u) { if (xb_ld(&bar[XB_TMO])) break; if (sp > XB_SPIN_CAP) { atomicAdd(&bar[XB_TMO], 1u); break; } }
    }
    nloc = mine > 0u ? mine : 1u; nx = cnt > 0u ? cnt : 1u;
}

__device__ __forceinline__ void xcd_barrier(const XcdBarrier& b) {
    asm volatile("s_waitcnt vmcnt(0)" ::: "memory");
    __syncthreads();
    if (threadIdx.x == 0) {
        unsigned* bar = b.bar;
        __builtin_amdgcn_s_waitcnt(0);
        unsigned nloc = b.st[0], nx = b.st[1];
        if (nloc == 0u) { xcd_barrier_complete(bar, b.x, nloc, nx); b.st[0] = nloc; b.st[1] = nx; }
        const unsigned old = xb_add(&bar[XB_XSUB(b.x)], 1u);
        const unsigned gen = old / nloc;
        if (old + 1u == (gen + 1u) * nloc) {
            __builtin_amdgcn_fence(__ATOMIC_RELEASE, "agent");
            asm volatile("s_waitcnt vmcnt(0)" ::: "memory");
            const unsigned og = xb_add(&bar[XB_TOP], 1u);
            const unsigned tg = og / nx;
            if (og + 1u == (tg + 1u) * nx) xb_add(&bar[XB_TOPGEN], 1u);
            else XB_SPIN(xb_ld(&bar[XB_TOPGEN]) == tg, bar);
            __builtin_amdgcn_fence(__ATOMIC_ACQUIRE, "agent");
            xb_add(&bar[XB_XGEN(b.x)], 1u);
            asm volatile("s_waitcnt vmcnt(0)" ::: "memory");
        } else {
            XB_SPIN(xb_ld(&bar[XB_XGEN(b.x)]) == gen, bar);
            __builtin_amdgcn_fence(__ATOMIC_ACQUIRE, "agent");
            asm volatile("s_waitcnt vmcnt(0)" ::: "memory");
        }
    }
    __syncthreads();
}


template <int PH> __device__ __forceinline__ void do_phase(const Params& p, char* shm) {
    char* ws = p.ws; char* epl = shm + SHM_B + 16;
    if (PH == 0) phase0(p, shm);
    if (PH == 1) {
        if (blockIdx.x & 1) phase0_rest(p, shm);
        run_gemm((const bf16_t*)(ws + OFF_XB), (const bf16_t*)(ws + OFF_WIN), MT, 2560, DM, shm, EpiIn{(const float*)(ws + OFF_RX), ws, epl});
        run_gemm((const bf16_t*)(ws + OFF_WIN) + (size_t)2560 * DM, (const bf16_t*)(ws + OFF_XB), 1024, MT, DM, shm, EpiVT{(const float*)(ws + OFF_RX), ws, epl});
        if (!(blockIdx.x & 1)) phase0_rest(p, shm);
    }
    if (PH == 2) { for (int u = blockIdx.x; u < 32 * HSEG; u += gridDim.x) if ((u & (HSEG - 1)) != HSEG - 1) phase_hgseg<false>(p, shm, u / HSEG, u & (HSEG - 1));
                   phase_attn(p, shm, (unsigned*)(ws + OFF_CNT) + 2 * 128 * 64); }
    if (PH == 3) { for (int u = blockIdx.x; u < 32 * HSEG; u += gridDim.x) phase_hgseg<true>(p, shm, u / HSEG, u & (HSEG - 1)); }
    if (PH == 5) run_gemm((const bf16_t*)(ws + OFF_AMIX), (const bf16_t*)(ws + OFF_WOUT), MT, DM, DM, shm,
                          EpiRes<1>{p.g_attn_post, (bf16_t*)(ws + OFF_XB), (float*)(ws + OFF_PART1), (unsigned*)(ws + OFF_CNT), (float*)(ws + OFF_PART2), epl, (const float*)(ws + OFF_DC)});
    if (PH == 7) {
        const bool ple_first = ((blockIdx.x >> 3) & 1) != 0;
        if (ple_first) run_gemm((const bf16_t*)(ws + OFF_PB), (const bf16_t*)(ws + OFF_WPP), MT, DM, PLE, shm, EpiBf16{(bf16_t*)(ws + OFF_PLE), DM});
        run_gemm((const bf16_t*)(ws + OFF_XB), (const bf16_t*)(ws + OFF_WGU), MT, 2 * DFF, DM, shm, EpiAct{(const float*)(ws + OFF_PART2), (bf16_t*)(ws + OFF_ACT), epl});
        if (!ple_first) run_gemm((const bf16_t*)(ws + OFF_PB), (const bf16_t*)(ws + OFF_WPP), MT, DM, PLE, shm, EpiBf16{(bf16_t*)(ws + OFF_PLE), DM});
    }
    if (PH == 8) run_gemm((const bf16_t*)(ws + OFF_ACT), (const bf16_t*)(ws + OFF_WDN), MT, DM, DFF, shm,
                          EpiRes<2>{p.g_ffn_post, (bf16_t*)(ws + OFF_XB), (float*)(ws + OFF_PART3), (unsigned*)(ws + OFF_CNT) + 128 * 64, nullptr, epl, nullptr});
    if (PH == 10) run_gemm((const bf16_t*)(ws + OFF_XB), (const bf16_t*)(ws + OFF_WPG), MT, DM, DM, shm, EpiFinal{p.out, (const bf16_t*)(ws + OFF_PLE), (const bf16_t*)(ws + OFF_XB)});
}
#if MEGA
__global__ __launch_bounds__(512) void k_mega(Params p) {
    extern __shared__ __attribute__((aligned(16))) char shm[];
    cg::grid_group grid = cg::this_grid();
    volatile LAS unsigned* st = (volatile LAS unsigned*)(shm + SHM_B);
    if (threadIdx.x < 2) st[threadIdx.x] = 0u;
    __syncthreads();
    const XcdBarrier xb = xcd_barrier_post((unsigned*)(p.ws + OFF_BAR), st);
    if (p.ws == nullptr) grid.sync();
    do_phase<0>(p, shm); xcd_barrier(xb);
    do_phase<1>(p, shm); xcd_barrier(xb);
    do_phase<2>(p, shm); xcd_barrier(xb);
    do_phase<3>(p, shm); xcd_barrier(xb);
    do_phase<5>(p, shm); xcd_barrier(xb);
    do_phase<7>(p, shm); xcd_barrier(xb);
    do_phase<8>(p, shm); xcd_barrier(xb);
    do_phase<10>(p, shm);
}
#else
template <int PH> __global__ __launch_bounds__(512) void k_phase(Params p) {
    extern __shared__ __attribute__((aligned(16))) char shm[];
    do_phase<PH>(p, shm);
}
template <int PH> static void launch_phase(const Params& p, hipStream_t s) {
    static bool attr = false;
    if (!attr) { (void)hipFuncSetAttribute((const void*)k_phase<PH>, hipFuncAttributeMaxDynamicSharedMemorySize, SHM_B); attr = true; }
    hipLaunchKernelGGL(k_phase<PH>, dim3(256), dim3(512), SHM_B, s, p);
}
#endif

extern "C" void kernel_launch(void* const* d_in, const int* in_sizes, int n_in, void* d_out, int out_size, void* d_ws, size_t ws_size, hipStream_t stream) {
    Params p{};
    p.x = (const float*)d_in[0]; p.p = (const float*)d_in[1]; p.g_attn_pre = (const float*)d_in[2]; p.w_in = (const float*)d_in[3]; p.gamma = (const float*)d_in[4];
    p.g_hg = (const float*)d_in[5]; p.g_sb = (const float*)d_in[6]; p.w_out = (const float*)d_in[7]; p.g_attn_post = (const float*)d_in[8]; p.g_ffn_pre = (const float*)d_in[9];
    p.w_gu = (const float*)d_in[10]; p.w_down = (const float*)d_in[11]; p.g_ffn_post = (const float*)d_in[12]; p.w_pp = (const float*)d_in[13]; p.w_pg = (const float*)d_in[14];
    p.out = (float*)d_out; p.ws = (char*)d_ws;
#if MEGA
    static int grid_blocks = 0;
    if (!grid_blocks) {
        int dev = 0, cus = 0, per_cu = 0;
        (void)hipGetDevice(&dev); (void)hipDeviceGetAttribute(&cus, hipDeviceAttributeMultiprocessorCount, dev);
        (void)hipFuncSetAttribute((const void*)k_mega, hipFuncAttributeMaxDynamicSharedMemorySize, LDS_TOTAL);
        (void)hipOccupancyMaxActiveBlocksPerMultiprocessor(&per_cu, (const void*)k_mega, 512, LDS_TOTAL);
        if (per_cu < 1) per_cu = 1;
        grid_blocks = cus * per_cu;
    }
    (void)hipMemsetAsync((char*)d_ws + OFF_BAR, 0, CTL_BYTES, stream);
    void* args[] = {&p};
    hipError_t e = hipLaunchCooperativeKernel((const void*)k_mega, dim3(grid_blocks), dim3(512), args, LDS_TOTAL, stream);
    if (e != hipSuccess) fprintf(stderr, "cooperative launch failed: %s (grid %d)\n", hipGetErrorString(e), grid_blocks);
#else
    launch_phase<0>(p, stream); launch_phase<1>(p, stream); launch_phase<2>(p, stream); launch_phase<3>(p, stream); launch_phase<5>(p, stream);
    launch_phase<7>(p, stream); launch_phase<8>(p, stream); launch_phase<10>(p, stream);
#endif
}
```

```cpp
#include <hip/hip_runtime.h>
#include <hip/hip_cooperative_groups.h>
#include <cstdio>
#include <cstdint>
namespace cg = cooperative_groups;

#ifndef MEGA
#define MEGA 1
#endif

typedef unsigned short bf16_t;
typedef short bf16x8 __attribute__((ext_vector_type(8)));
typedef float f32x4 __attribute__((ext_vector_type(4)));
typedef unsigned u32x4 __attribute__((ext_vector_type(4)));
typedef unsigned u32x2 __attribute__((ext_vector_type(2)));

constexpr int NB = 8, NT = 4096, DM = 1024, MT = NB * NT;
constexpr int NIN = 3584, DFF = 2816, PLE = 256;
constexpr float EPS = 1e-6f;
constexpr float LOG2E = 1.4426950408889634f;

constexpr size_t MiB = 1ull << 20;
constexpr size_t OFF_WIN = 0;
constexpr size_t OFF_WOUT = 7 * MiB;
constexpr size_t OFF_WGU = 9 * MiB;
constexpr size_t OFF_WDN = 20 * MiB;
constexpr size_t OFF_WPP = 26 * MiB;
constexpr size_t OFF_WPG = 27 * MiB;
constexpr size_t OFF_RX = 30 * MiB;
constexpr size_t OFF_RH1 = 31 * MiB;
constexpr size_t OFF_LB = 32 * MiB;
constexpr size_t OFF_PB = 40 * MiB;
constexpr size_t OFF_XB = 56 * MiB;
constexpr size_t OFF_SQ = 120 * MiB;
constexpr size_t OFF_Y = 56 * MiB;
constexpr size_t OFF_QT = 216 * MiB;
constexpr size_t OFF_BC = 344 * MiB;
constexpr size_t OFF_ACT = 216 * MiB;
constexpr size_t OFF_H2B = 216 * MiB;
constexpr size_t OFF_PLE = 408 * MiB;
constexpr size_t OFF_SLOC = 472 * MiB;
constexpr size_t OFF_AMIX = 408 * MiB;
constexpr size_t OFF_PART1 = 35 * MiB;
constexpr size_t OFF_PART2 = 36 * MiB;
constexpr size_t OFF_PART3 = 37 * MiB;
constexpr size_t OFF_CNT = 34 * MiB + 16384;
constexpr size_t CTL_BYTES = 16384 + 2 * 128 * 64 * 4 + 256;
constexpr size_t OFF_BAR = 34 * MiB;
constexpr size_t OFF_DC = 33 * MiB;
constexpr size_t OFF_U = 56 * MiB;
constexpr size_t OFF_SC = 120 * MiB;
constexpr size_t OFF_VHT = 216 * MiB + 2 * (32 * MiB);
constexpr size_t OFF_SVT = 120 * MiB + 2 * (32 * MiB);
constexpr size_t SZ_HALF = 32 * MiB;

struct Params {
    const float *x, *p, *g_attn_pre, *w_in, *gamma, *g_hg, *g_sb, *w_out, *g_attn_post, *g_ffn_pre, *w_gu, *w_down, *g_ffn_post, *w_pp, *w_pg;
    float* out; char* ws;
};

typedef __bf16 bf2_t __attribute__((ext_vector_type(2)));
typedef float f32x2 __attribute__((ext_vector_type(2)));
typedef float f32x16 __attribute__((ext_vector_type(16)));
typedef _Float16 h16x2 __attribute__((ext_vector_type(2)));
__device__ __forceinline__ unsigned cvt_pk_f16(float lo, float hi) { f32x2 v = {lo, hi}; return __builtin_bit_cast(unsigned, __builtin_convertvector(v, h16x2)); }
__device__ __forceinline__ f32x2 unpk_f16(unsigned u) { return __builtin_convertvector(__builtin_bit_cast(h16x2, u), f32x2); }
__device__ __forceinline__ unsigned cvt_pk_bf16(float lo, float hi) { f32x2 v = {lo, hi}; return __builtin_bit_cast(unsigned, __builtin_convertvector(v, bf2_t)); }
__device__ __forceinline__ size_t vt_off(int ch, size_t tok) { return ((tok >> 6) * 512 + (size_t)ch) * 64 + (tok & 63); }
__device__ __forceinline__ float bf2f(bf16_t h) { return __uint_as_float(((unsigned)h) << 16); }
__device__ __forceinline__ float bflo(unsigned u) { return __uint_as_float(u << 16); }
__device__ __forceinline__ float bfhi(unsigned u) { return __uint_as_float(u & 0xffff0000u); }
__device__ __forceinline__ float fexp2(float x) { return __builtin_amdgcn_exp2f(x); }
__device__ __forceinline__ float frcp(float x) { return __builtin_amdgcn_rcpf(x); }
__device__ __forceinline__ float sigmoidf_(float x) { return frcp(1.0f + fexp2(-x * LOG2E)); }
__device__ __forceinline__ float siluf_(float x) { return x * sigmoidf_(x); }
__device__ __forceinline__ float wave_sum(float v) {
#pragma unroll
    for (int o = 32; o >= 1; o >>= 1) v += __shfl_xor(v, o);
    return v;
}

__device__ __forceinline__ int opaque_tid() { int t = threadIdx.x; asm volatile("" : "+v"(t)); return t; }

namespace pg8 {
#define PG8_LAS __attribute__((address_space(3)))
typedef unsigned short bf16_t;
typedef short bf16x8 __attribute__((ext_vector_type(8)));
typedef float f32x4 __attribute__((ext_vector_type(4)));
typedef unsigned u32x4 __attribute__((ext_vector_type(4)));
constexpr int BM = 256, BK = 64, HALF = 128, HTB = HALF * BK * 2  , STAGE_BYTES = 8 * HTB, NXCD = 8, WGM = 8;

__host__ __device__ __forceinline__ int lds_byte(int r, int c) { const int st = (r >> 4) * 2 + (c >> 5), rr = r & 15, cc = c & 31, ob = rr * 64 + cc * 2; return st * 1024 + (ob ^ (((ob >> 9) & 1) << 5)); }
__host__ __device__ __forceinline__ void stage_rc(int b, int& R, int& C) { const int st = b / 1024, sb = b % 1024, swz = sb ^ (((sb >> 9) & 1) << 5); R = (st >> 1) * 16 + swz / 64; C = (st & 1) * 32 + (swz % 64) / 2; }
__host__ __device__ __forceinline__ int perm32(int rho) { const int n = rho >> 4, i = rho & 15; return 8 * (i >> 2) + 4 * n + (i & 3); }

struct Unit { int pm, pn; };
struct Gemm { const bf16_t* A; const bf16_t* Bt; int M, N, K; };

struct StaticOrder {
    int nM, nN, nwg, G, c;
    __host__ __device__ void init(int M, int N, int G_, int c_) { nM = M / BM; nN = N / BM; nwg = nM * nN; G = G_; c = c_; }
    __host__ __device__ bool next(int i, Unit& u) const {
        const long L = (long)i * G + c; if (L >= nwg) return false;
        int wgid = (int)L; { const int q = nwg / NXCD, r = nwg % NXCD, xcd = wgid % NXCD, off = wgid / NXCD; wgid = (xcd < r ? xcd * (q + 1) : r * (q + 1) + (xcd - r) * q) + off; }
        const int nig = WGM * nN, gid = wgid / nig, fm = gid * WGM, gsz = (nM - fm) < WGM ? (nM - fm) : WGM;
        u.pm = fm + ((wgid % nig) % gsz); u.pn = (wgid % nig) / gsz; return true;
    }
    __device__ __forceinline__ void a_ready(const Unit&) const {}
    __device__ __forceinline__ void done(const Unit&) const {}
};
template <class Epi, class Sched, bool ALIGN_EPI = false, bool SP2 = false>
__device__ __forceinline__ void gemm_phase(PG8_LAS unsigned char* lds, const Gemm g, const Sched& S, const Epi& E) {
    const int tid = opaque_tid(), wid = __builtin_amdgcn_readfirstlane(tid >> 6), lane = tid & 63, wr = wid >> 2, wc = wid & 3, fr = lane & 15, fq = lane >> 4;
    const int K = g.K, nt = K / BK;
    unsigned voffA[2], voffB[2];
#pragma unroll
    for (int i = 0; i < 2; ++i) { int R, C; stage_rc(tid * 16 + i * 8192, R, C); const int Rb = Epi::PERM ? ((R & ~31) + perm32(R & 31)) : R;
        voffA[i] = (unsigned)(R * K + C) * 2u; voffB[i] = (unsigned)(Rb * K + C) * 2u; }
    const size_t kstep = (size_t)(BK * 2);
    const size_t hstep = (size_t)HALF * K * 2;
    const size_t tstep = 2 * hstep;
    const unsigned ldsw = (unsigned)wid * 1024u;
    const int aoff = lds_byte(wr * 64 + fr, fq * 8), boff = lds_byte(wc * 32 + fr, fq * 8);
#define PG8_SA(b, h) (((b) * 2 + (h)) * HTB)
#define PG8_SB(b, h) ((4 + (b) * 2 + (h)) * HTB)
#define PG8_STAGE(bufoff, gbase, voff) do { _Pragma("unroll") for (int _i = 0; _i < 2; ++_i) \
        __builtin_amdgcn_global_load_lds((const unsigned*)((const char*)(gbase) + (voff)[_i]), (PG8_LAS unsigned*)(lds + (bufoff) + ldsw + _i * 8192), 16, 0, 0); } while (0)
#define PG8_LDA(dst, b, h) do { _Pragma("unroll") for (int m = 0; m < 4; ++m) _Pragma("unroll") for (int k = 0; k < 2; ++k) dst[m][k] = *(const PG8_LAS bf16x8*)(lds + PG8_SA(b, h) + aoff + m * 2048 + k * 1024); } while (0)
#define PG8_LDB(dst, b, h) do { _Pragma("unroll") for (int n = 0; n < 2; ++n) _Pragma("unroll") for (int k = 0; k < 2; ++k) dst[n][k] = *(const PG8_LAS bf16x8*)(lds + PG8_SB(b, h) + boff + n * 2048 + k * 1024); } while (0)
#define PG8_MMA(ai, bj, At, Bt) do { __builtin_amdgcn_s_setprio(1); _Pragma("unroll") for (int m = 0; m < 4; ++m) _Pragma("unroll") for (int n = 0; n < 2; ++n) _Pragma("unroll") for (int k = 0; k < 2; ++k) \
        acc[ai][bj][m][n] = __builtin_amdgcn_mfma_f32_16x16x32_bf16(Bt[n][k], At[m][k], acc[ai][bj][m][n], 0, 0, 0); __builtin_amdgcn_s_setprio(0); } while (0)
#define PG8_WAIT_V(n) asm volatile("s_waitcnt vmcnt(" #n ")" ::: "memory")
#define PG8_WAIT_L(n) asm volatile("s_waitcnt lgkmcnt(" #n ")" ::: "memory")
#define PG8_BAR __builtin_amdgcn_s_barrier()
#define PG8_SCHED __builtin_amdgcn_sched_barrier(0)
    Unit cur, nxt; int ui = 0;
    if (!S.next(0, cur)) return;
    f32x4 acc[2][2][4][2];
#pragma unroll
    for (int a = 0; a < 2; ++a)
#pragma unroll
        for (int b = 0; b < 2; ++b)
#pragma unroll
            for (int m = 0; m < 4; ++m)
#pragma unroll
                for (int n = 0; n < 2; ++n) acc[a][b][m][n] = (f32x4){0.f, 0.f, 0.f, 0.f};
    bf16x8 At[4][2], B0[2][2], B1[2][2];
    const char* cA = (const char*)g.A + (size_t)cur.pm * tstep; const char* cB = (const char*)g.Bt + (size_t)cur.pn * tstep;
    S.a_ready(cur);
    if constexpr (Epi::MIDSCALE) E.load_mid(cur);
    typename Epi::Pre pre = {};
    if constexpr (Epi::ROWPRE) pre = E.pre_issue(cur);
    if constexpr (SP2) {
        PG8_STAGE(PG8_SB(0, 0), cB, voffB); PG8_STAGE(PG8_SB(0, 1), cB + hstep, voffB); PG8_STAGE(PG8_SA(0, 0), cA, voffA); PG8_STAGE(PG8_SA(0, 1), cA + hstep, voffA);
        if (wr == 1) PG8_BAR;
        PG8_WAIT_V(2); PG8_BAR;
        PG8_STAGE(PG8_SB(1, 0), cB + kstep, voffB); PG8_STAGE(PG8_SA(1, 0), cA + kstep, voffA); PG8_STAGE(PG8_SB(1, 1), cB + hstep + kstep, voffB);
        PG8_WAIT_V(6); PG8_BAR;
    } else {
        PG8_STAGE(PG8_SB(0, 0), cB, voffB); PG8_STAGE(PG8_SA(0, 0), cA, voffA); PG8_STAGE(PG8_SB(0, 1), cB + hstep, voffB); PG8_STAGE(PG8_SA(0, 1), cA + hstep, voffA);
        if (wr == 1) PG8_BAR;
        PG8_WAIT_V(4); PG8_BAR;
        PG8_STAGE(PG8_SB(1, 0), cB + kstep, voffB); PG8_STAGE(PG8_SA(1, 0), cA + kstep, voffA); PG8_STAGE(PG8_SB(1, 1), cB + hstep + kstep, voffB);
        PG8_WAIT_V(6); PG8_BAR;
    }
    for (;;) {
        const bool has_next = S.next(ui + 1, nxt);
        const char* nA = has_next ? (const char*)g.A + (size_t)nxt.pm * tstep : cA; const char* nB = has_next ? (const char*)g.Bt + (size_t)nxt.pn * tstep : cB;
        for (int t = 0; t < nt; t += 2) {
            const bool last = (t == nt - 2);
            const char* a1 = cA + (size_t)(t + 1) * kstep;
            const char* a2 = last ? nA : cA + (size_t)(t + 2) * kstep; const char* b2 = last ? nB : cB + (size_t)(t + 2) * kstep;
            const char* a3 = a2 + kstep; const char* b3 = b2 + kstep;
            if (last && has_next) S.a_ready(nxt);
            if constexpr (Epi::ROWPRE) { if (t == 8) E.pre_commit(pre); }
            if constexpr (Epi::MIDSCALE) { if (t == Epi::MID_T) {
_Pragma("unroll") for (int a = 0; a < 2; ++a) _Pragma("unroll") for (int m = 0; m < 4; ++m) { const float sc_ = E.mid_scale(a * HALF + wr * 64 + m * 16 + fr);
_Pragma("unroll") for (int b = 0; b < 2; ++b) _Pragma("unroll") for (int n = 0; n < 2; ++n) acc[a][b][m][n] = acc[a][b][m][n] * sc_; } } }
            if constexpr (SP2) {
            PG8_LDB(B0, 0, 0); PG8_LDB(B1, 0, 1); PG8_SCHED; PG8_LDA(At, 0, 0); PG8_STAGE(PG8_SA(1, 1), a1 + hstep, voffA);
            PG8_WAIT_V(8); PG8_WAIT_L(0); PG8_BAR; PG8_MMA(0, 0, At, B0); PG8_MMA(0, 1, At, B1); PG8_BAR; PG8_SCHED;
            PG8_LDA(At, 0, 1); PG8_STAGE(PG8_SB(0, 0), b2, voffB); PG8_STAGE(PG8_SB(0, 1), b2 + hstep, voffB); PG8_STAGE(PG8_SA(0, 0), a2, voffA);
            PG8_WAIT_V(8); PG8_WAIT_L(0); PG8_BAR; PG8_MMA(1, 0, At, B0); PG8_MMA(1, 1, At, B1); PG8_BAR; PG8_SCHED;
            PG8_LDB(B0, 1, 0); PG8_LDB(B1, 1, 1); PG8_SCHED; PG8_LDA(At, 1, 0); PG8_STAGE(PG8_SA(0, 1), a2 + hstep, voffA);
            PG8_WAIT_V(8); PG8_WAIT_L(0); PG8_BAR; PG8_MMA(0, 0, At, B0); PG8_MMA(0, 1, At, B1); PG8_BAR; PG8_SCHED;
            PG8_LDA(At, 1, 1); PG8_STAGE(PG8_SB(1, 0), b3, voffB); PG8_STAGE(PG8_SB(1, 1), b3 + hstep, voffB); PG8_STAGE(PG8_SA(1, 0), a3, voffA);
            PG8_WAIT_V(8); PG8_WAIT_L(0); PG8_BAR; PG8_MMA(1, 0, At, B0); PG8_MMA(1, 1, At, B1); PG8_BAR; PG8_SCHED;
            } else {
            PG8_LDB(B0, 0, 0); PG8_SCHED; PG8_LDA(At, 0, 0); PG8_STAGE(PG8_SA(1, 1), a1 + hstep, voffA);
            PG8_WAIT_L(8); PG8_BAR; PG8_WAIT_L(0); PG8_MMA(0, 0, At, B0); PG8_BAR; PG8_SCHED;
            PG8_LDB(B1, 0, 1); PG8_STAGE(PG8_SB(0, 0), b2, voffB);
            PG8_BAR; PG8_WAIT_L(0); PG8_MMA(0, 1, At, B1); PG8_BAR;
            PG8_LDA(At, 0, 1); PG8_STAGE(PG8_SA(0, 0), a2, voffA);
            PG8_BAR; PG8_WAIT_L(0); PG8_MMA(1, 0, At, B0); PG8_BAR; PG8_SCHED;
            PG8_STAGE(PG8_SB(0, 1), b2 + hstep, voffB);
            PG8_WAIT_V(6); PG8_BAR; PG8_MMA(1, 1, At, B1); PG8_BAR;
            PG8_LDB(B0, 1, 0); PG8_SCHED; PG8_LDA(At, 1, 0); PG8_STAGE(PG8_SA(0, 1), a2 + hstep, voffA);
            PG8_WAIT_L(8); PG8_BAR; PG8_WAIT_L(0); PG8_MMA(0, 0, At, B0); PG8_BAR; PG8_SCHED;
            PG8_LDB(B1, 1, 1); PG8_STAGE(PG8_SB(1, 0), b3, voffB);
            PG8_BAR; PG8_WAIT_L(0); PG8_MMA(0, 1, At, B1); PG8_BAR;
            PG8_LDA(At, 1, 1); PG8_STAGE(PG8_SA(1, 0), a3, voffA);
            PG8_BAR; PG8_WAIT_L(0); PG8_MMA(1, 0, At, B0); PG8_BAR; PG8_SCHED;
            PG8_STAGE(PG8_SB(1, 1), b3 + hstep, voffB);
            PG8_WAIT_V(6); PG8_BAR; PG8_MMA(1, 1, At, B1); PG8_BAR;
            }
        }
        if constexpr (ALIGN_EPI) { if (wr == 0) PG8_BAR; }
        if constexpr (!Epi::AFTER_DRAIN) { E(acc, cur, wr, wc, fr, fq); S.done(cur); }
        if (!has_next) break;
#pragma unroll
        for (int a = 0; a < 2; ++a)
#pragma unroll
            for (int b = 0; b < 2; ++b)
#pragma unroll
                for (int m = 0; m < 4; ++m)
#pragma unroll
                    for (int n = 0; n < 2; ++n) acc[a][b][m][n] = (f32x4){0.f, 0.f, 0.f, 0.f};
        cur = nxt; cA = nA; cB = nB; ++ui;
        if constexpr (Epi::MIDSCALE) E.load_mid(cur);
        if constexpr (Epi::ROWPRE) pre = E.pre_issue(cur);
        if constexpr (ALIGN_EPI) { if (wr == 1) PG8_BAR; }
    }
    PG8_WAIT_V(0);
    if constexpr (!ALIGN_EPI) { if (wr == 0) PG8_BAR; }
    PG8_BAR;
    if constexpr (Epi::AFTER_DRAIN) { E.fused(acc, cur, wr, wc, fr, fq, lds, wid, lane); S.done(cur); }
#undef PG8_SA
#undef PG8_SB
#undef PG8_STAGE
#undef PG8_LDA
#undef PG8_LDB
#undef PG8_MMA
#undef PG8_WAIT_V
#undef PG8_WAIT_L
#undef PG8_BAR
#undef PG8_SCHED
}
}

#define EPI_ARGS const f32x4 (&acc)[2][2][4][2], const pg8::Unit& u, int wr, int wc, int fr, int fq
#define EPI_HEAD static constexpr bool PERM = true, AFTER_DRAIN = false, MIDSCALE = false, ROWPRE = false; typedef int Pre;
#define EPI_HEAD_PRE(T) static constexpr bool PERM = true, AFTER_DRAIN = false, MIDSCALE = false, ROWPRE = true; typedef T Pre;
#define EPI_RC const int brow = u.pm * 256, bcol = u.pn * 256;
constexpr int HALF = 128, SHM_B = 131072, LDS_TOTAL = SHM_B + 16 + 4096 + 1024;
struct EpiIn {
    EPI_HEAD_PRE(float)
    const float* rx; char* ws; char* lds;
    __device__ __forceinline__ float pre_issue(const pg8::Unit& u) const { return threadIdx.x < 256 ? rx[u.pm * 256 + threadIdx.x] : 0.f; }
    __device__ __forceinline__ void pre_commit(float v) const { if (threadIdx.x < 256) ((float*)(lds + 4096))[threadIdx.x] = v; }
    __device__ __forceinline__ void operator()(EPI_ARGS) const { EPI_RC
        const int kind = bcol >> 9;
        const int lc0 = (bcol & 256) + wc * 32 + 8 * fq;
        bf16_t* dst = (bf16_t*)(ws + (kind == 0 ? OFF_QT : kind == 1 ? OFF_QT + SZ_HALF : kind == 2 ? OFF_QT + 3 * SZ_HALF : kind == 3 ? OFF_SQ : OFF_SQ + SZ_HALF));
        if (kind == 1) {
            float* dstf = (float*)(ws + OFF_BC); const float* lbp = (const float*)(ws + OFF_LB);
#pragma unroll
            for (int bj = 0; bj < 2; ++bj)
#pragma unroll
                for (int n = 0; n < 2; ++n) {
                    const f32x4 l0 = *(const f32x4*)(lbp + lc0 + bj * HALF + 4 * n), m0 = *(const f32x4*)(lbp + 512 + lc0 + bj * HALF + 4 * n);
                    float rsv[2][4];
#pragma unroll
                    for (int ai = 0; ai < 2; ++ai)
#pragma unroll
                        for (int m = 0; m < 4; ++m) rsv[ai][m] = ((const float*)(lds + 4096))[ai * HALF + wr * 64 + m * 16 + fr];
#pragma unroll
                    for (int ai = 0; ai < 2; ++ai)
#pragma unroll
                        for (int m = 0; m < 4; ++m) {
                            const int row = brow + ai * HALF + wr * 64 + m * 16 + fr; const float rs = rsv[ai][m];
                            const f32x4 z = acc[ai][bj][m][n] * rs; f32x4 lf;
#pragma unroll
                            for (int j = 0; j < 4; ++j) { const float s = sigmoidf_(z[j]); lf[j] = __builtin_amdgcn_logf(l0[j] + m0[j] * s)  ; }
                            const size_t o = (size_t)row * 512 + lc0 + bj * HALF + 4 * n;
                            u32x2 w; w.x = cvt_pk_f16(lf[0], lf[1]); w.y = cvt_pk_f16(lf[2], lf[3]); *(u32x2*)((unsigned short*)dstf + o) = w;
                        }
                }
            return;
        }
        float rsv[2][4];
#pragma unroll
        for (int ai = 0; ai < 2; ++ai)
#pragma unroll
            for (int m = 0; m < 4; ++m) rsv[ai][m] = ((const float*)(lds + 4096))[ai * HALF + wr * 64 + m * 16 + fr] * (kind == 3 ? 0.125f * LOG2E : 1.0f);
#pragma unroll
        for (int ai = 0; ai < 2; ++ai)
#pragma unroll
            for (int m = 0; m < 4; ++m) {
                const int row = brow + ai * HALF + wr * 64 + m * 16 + fr;
                const float rs = rsv[ai][m];
#pragma unroll
                for (int bj = 0; bj < 2; ++bj) {
                    f32x4 v0 = acc[ai][bj][m][0] * rs, v1 = acc[ai][bj][m][1] * rs;
                    if (kind == 0 || kind == 2) {
#pragma unroll
                        for (int j = 0; j < 4; ++j) { v0[j] = siluf_(v0[j]); v1[j] = siluf_(v1[j]); }
                    }
                    u32x4 w; w.x = cvt_pk_bf16(v0[0], v0[1]); w.y = cvt_pk_bf16(v0[2], v0[3]); w.z = cvt_pk_bf16(v1[0], v1[1]); w.w = cvt_pk_bf16(v1[2], v1[3]);
                    *(u32x4*)(dst + (size_t)row * 512 + lc0 + bj * HALF) = w;
                }
            }
    }
};
struct EpiVT {
    EPI_HEAD_PRE(float)
    const float* rx; char* ws; char* lds;
    __device__ __forceinline__ float pre_issue(const pg8::Unit& u) const { return threadIdx.x < 256 ? rx[u.pn * 256 + threadIdx.x] : 0.f; }
    __device__ __forceinline__ void pre_commit(float v) const { if (threadIdx.x < 256) ((float*)(lds + 4096))[threadIdx.x] = v; }
    __device__ __forceinline__ void operator()(EPI_ARGS) const { EPI_RC
        bf16_t* dst = (bf16_t*)(ws + (brow < 512 ? OFF_VHT : OFF_SVT));
        const int r0 = (brow & 511) + wr * 64 + fr, c0 = bcol + wc * 32 + 8 * fq;
#pragma unroll
        for (int bj = 0; bj < 2; ++bj) {
            const f32x4 s0 = *(const f32x4*)((const float*)(lds + 4096) + wc * 32 + 8 * fq + bj * HALF), s1 = *(const f32x4*)((const float*)(lds + 4096) + wc * 32 + 8 * fq + bj * HALF + 4);
#pragma unroll
            for (int ai = 0; ai < 2; ++ai)
#pragma unroll
                for (int m = 0; m < 4; ++m) {
                    const f32x4 v0 = acc[ai][bj][m][0] * s0, v1 = acc[ai][bj][m][1] * s1;
                    u32x4 w; w.x = cvt_pk_bf16(v0[0], v0[1]); w.y = cvt_pk_bf16(v0[2], v0[3]); w.z = cvt_pk_bf16(v1[0], v1[1]); w.w = cvt_pk_bf16(v1[2], v1[3]);
                    *(u32x4*)(dst + vt_off(r0 + ai * HALF + m * 16, (size_t)(c0 + bj * HALF))) = w;
                }
        }
    }
};
struct EpiF32 {
    EPI_HEAD
    float* C; int ldc;
    __device__ __forceinline__ void operator()(EPI_ARGS) const { EPI_RC
#pragma unroll
        for (int ai = 0; ai < 2; ++ai)
#pragma unroll
            for (int m = 0; m < 4; ++m) {
                float* rp = C + (size_t)(brow + ai * HALF + wr * 64 + m * 16 + fr) * ldc + bcol + wc * 32 + 8 * fq;
#pragma unroll
                for (int bj = 0; bj < 2; ++bj) { *(f32x4*)(rp + bj * HALF) = acc[ai][bj][m][0]; *(f32x4*)(rp + bj * HALF + 4) = acc[ai][bj][m][1]; }
            }
    }
};
struct EpiBf16 {
    EPI_HEAD
    bf16_t* C; int ldc;
    __device__ __forceinline__ void operator()(EPI_ARGS) const { EPI_RC
#pragma unroll
        for (int ai = 0; ai < 2; ++ai)
#pragma unroll
            for (int m = 0; m < 4; ++m) {
                bf16_t* rp = C + (size_t)(brow + ai * HALF + wr * 64 + m * 16 + fr) * ldc + bcol + wc * 32 + 8 * fq;
#pragma unroll
                for (int bj = 0; bj < 2; ++bj) {
                    const f32x4 v0 = acc[ai][bj][m][0], v1 = acc[ai][bj][m][1];
                    u32x4 w; w.x = cvt_pk_bf16(v0[0], v0[1]); w.y = cvt_pk_bf16(v0[2], v0[3]); w.z = cvt_pk_bf16(v1[0], v1[1]); w.w = cvt_pk_bf16(v1[2], v1[3]);
                    *(u32x4*)(rp + bj * HALF) = w;
                }
            }
    }
};
struct EpiAct {
    EPI_HEAD_PRE(f32x4)
    const float* rh; bf16_t* act; char* lds;
    __device__ __forceinline__ f32x4 pre_issue(const pg8::Unit& u) const { return threadIdx.x < 256 ? *(const f32x4*)(rh + (size_t)(u.pm * 256 + threadIdx.x) * 4) : (f32x4){0.f, 0.f, 0.f, 0.f}; }
    __device__ __forceinline__ void pre_commit(f32x4 q) const { if (threadIdx.x < 256) ((float*)(lds + 4096))[threadIdx.x] = rsqrtf(((q[0] + q[1]) + (q[2] + q[3])) * (1.0f / DM) + EPS); }
    __device__ __forceinline__ void operator()(EPI_ARGS) const { EPI_RC
        const int c0 = (bcol >> 1) + wc * 32 + 8 * fq;
        float rsv[2][4];
#pragma unroll
        for (int ai = 0; ai < 2; ++ai)
#pragma unroll
            for (int m = 0; m < 4; ++m) rsv[ai][m] = ((const float*)(lds + 4096))[ai * HALF + wr * 64 + m * 16 + fr];
#pragma unroll
        for (int ai = 0; ai < 2; ++ai)
#pragma unroll
            for (int m = 0; m < 4; ++m) {
                const int row = brow + ai * HALF + wr * 64 + m * 16 + fr;
                const float rs = rsv[ai][m];
                float o[8];
#pragma unroll
                for (int n = 0; n < 2; ++n)
#pragma unroll
                    for (int j = 0; j < 4; ++j) { const float g = acc[ai][0][m][n][j] * rs, u = acc[ai][1][m][n][j] * rs; o[n * 4 + j] = siluf_(g) * u; }
                u32x4 w; w.x = cvt_pk_bf16(o[0], o[1]); w.y = cvt_pk_bf16(o[2], o[3]); w.z = cvt_pk_bf16(o[4], o[5]); w.w = cvt_pk_bf16(o[6], o[7]);
                *(u32x4*)(act + (size_t)row * DFF + c0) = w;
            }
    }
};
struct EpiFinal {
    EPI_HEAD
    float* out; const bf16_t* ple; const bf16_t* h2;
    __device__ __forceinline__ void operator()(EPI_ARGS) const { EPI_RC
#pragma unroll
        for (int ai = 0; ai < 2; ++ai)
#pragma unroll
            for (int mp = 0; mp < 1; ++mp) {
                u32x4 pv[4][2], hv[4][2];
#pragma unroll
                for (int mm = 0; mm < 4; ++mm)
#pragma unroll
                    for (int bj = 0; bj < 2; ++bj) {
                        const size_t ro = (size_t)(brow + ai * HALF + wr * 64 + (4 * mp + mm) * 16 + fr) * DM + bcol + wc * 32 + 8 * fq + bj * HALF;
                        pv[mm][bj] = *(const u32x4*)(ple + ro); hv[mm][bj] = *(const u32x4*)(h2 + ro);
                    }
#pragma unroll
                for (int mm = 0; mm < 4; ++mm)
#pragma unroll
                    for (int bj = 0; bj < 2; ++bj) {
                        const int m = 4 * mp + mm;
                        const size_t ro = (size_t)(brow + ai * HALF + wr * 64 + m * 16 + fr) * DM + bcol + wc * 32 + 8 * fq + bj * HALF;
                        const f32x4 a0 = acc[ai][bj][m][0], a1 = acc[ai][bj][m][1]; const u32x4 q = pv[mm][bj], hq = hv[mm][bj]; f32x4 x0, x1;
                        x0[0] = bflo(hq.x) + bflo(q.x) * sigmoidf_(a0[0]); x0[1] = bfhi(hq.x) + bfhi(q.x) * sigmoidf_(a0[1]); x0[2] = bflo(hq.y) + bflo(q.y) * sigmoidf_(a0[2]); x0[3] = bfhi(hq.y) + bfhi(q.y) * sigmoidf_(a0[3]);
                        x1[0] = bflo(hq.z) + bflo(q.z) * sigmoidf_(a1[0]); x1[1] = bfhi(hq.z) + bfhi(q.z) * sigmoidf_(a1[1]); x1[2] = bflo(hq.w) + bflo(q.w) * sigmoidf_(a1[2]); x1[3] = bfhi(hq.w) + bfhi(q.w) * sigmoidf_(a1[3]);
                        *(f32x4*)(out + ro) = x0; *(f32x4*)(out + ro + 4) = x1;
                    }
            }
    }
};

template <int WHICH> struct EpiRes {
    static constexpr bool PERM = true, AFTER_DRAIN = false, MIDSCALE = (WHICH == 1), ROWPRE = false; typedef int Pre; static constexpr int MID_T = 8;
    const float* gain; bf16_t* hb; float* part; unsigned* cnt; float* part2; char* lds; const float* parth;
    __device__ __forceinline__ void load_mid(const pg8::Unit& u) const {
        if (threadIdx.x < 256) { const f32x4 q = *(const f32x4*)(parth + (size_t)(u.pm * 256 + threadIdx.x) * 4); ((float*)(lds + 4096))[threadIdx.x] = rsqrtf(((q[0] + q[1]) + (q[2] + q[3])) * (1.0f / 512) + EPS); }
    }
    __device__ __forceinline__ float mid_scale(int r) const { return ((const float*)(lds + 4096))[r]; }
    __device__ __forceinline__ void operator()(EPI_ARGS) const { EPI_RC
        float* red = (float*)lds; const int tid = threadIdx.x;
#pragma unroll
        for (int ai = 0; ai < 2; ++ai)
#pragma unroll
            for (int m = 0; m < 4; ++m) {
                float s = 0.f;
#pragma unroll
                for (int bj = 0; bj < 2; ++bj)
#pragma unroll
                    for (int n = 0; n < 2; ++n) { const f32x4 v = acc[ai][bj][m][n]; s += (v[0] * v[0] + v[1] * v[1]) + (v[2] * v[2] + v[3] * v[3]); }
                s += __shfl_xor(s, 16); s += __shfl_xor(s, 32);
                if (fq == 0) red[(ai * HALF + wr * 64 + m * 16 + fr) * 4 + wc] = s;
            }
        f32x4 g[2][2]; u32x4 bv[4][2];
#pragma unroll
        for (int bj = 0; bj < 2; ++bj) { g[bj][0] = *(const f32x4*)(gain + bcol + bj * HALF + wc * 32 + 8 * fq); g[bj][1] = *(const f32x4*)(gain + bcol + bj * HALF + wc * 32 + 8 * fq + 4); }
#pragma unroll
        for (int m = 0; m < 4; ++m)
#pragma unroll
            for (int bj = 0; bj < 2; ++bj) bv[m][bj] = *(const u32x4*)(hb + (size_t)(brow + wr * 64 + m * 16 + fr) * DM + bcol + bj * HALF + wc * 32 + 8 * fq);
        __syncthreads();
        if (tid < 256) { const f32x4 v = *(const f32x4*)(red + tid * 4); __hip_atomic_store(part + (size_t)(brow + tid) * 4 + u.pn, (v[0] + v[1]) + (v[2] + v[3]), __ATOMIC_RELAXED, __HIP_MEMORY_SCOPE_AGENT); }
        asm volatile("s_waitcnt vmcnt(0)" ::: "memory");
        __syncthreads();
        if (tid == 0) {
            unsigned* c = cnt + u.pm * 64;
            __hip_atomic_fetch_add(c, 1u, __ATOMIC_RELAXED, __HIP_MEMORY_SCOPE_AGENT);
            unsigned sp = 0;
            while (__hip_atomic_load(c, __ATOMIC_RELAXED, __HIP_MEMORY_SCOPE_AGENT) < 4u && ++sp < (1u << 20)) __builtin_amdgcn_s_sleep(1);
        }
        __syncthreads();
#pragma unroll
        for (int ai = 0; ai < 2; ++ai) {
            float pq[4][4];
#pragma unroll
            for (int m = 0; m < 4; ++m) {
                const float* pp = part + (size_t)(brow + ai * HALF + wr * 64 + m * 16 + fr) * 4;
#pragma unroll
                for (int q = 0; q < 4; ++q) pq[m][q] = __hip_atomic_load(pp + q, __ATOMIC_RELAXED, __HIP_MEMORY_SCOPE_AGENT);
            }
            if (ai == 1) {
#pragma unroll
                for (int m = 0; m < 4; ++m)
#pragma unroll
                    for (int bj = 0; bj < 2; ++bj) bv[m][bj] = *(const u32x4*)(hb + (size_t)(brow + HALF + wr * 64 + m * 16 + fr) * DM + bcol + bj * HALF + wc * 32 + 8 * fq);
            }
#pragma unroll
            for (int m = 0; m < 4; ++m) {
                float s2 = 0.f; const float r = rsqrtf(((pq[m][0] + pq[m][1]) + (pq[m][2] + pq[m][3])) * (1.0f / DM) + EPS);
#pragma unroll
                for (int bj = 0; bj < 2; ++bj) { const size_t ro = (size_t)(brow + ai * HALF + wr * 64 + m * 16 + fr) * DM + bcol + bj * HALF + wc * 32 + 8 * fq;
                    const u32x4 q = bv[m][bj]; const f32x4 b0 = {bflo(q.x), bfhi(q.x), bflo(q.y), bfhi(q.y)}, b1 = {bflo(q.z), bfhi(q.z), bflo(q.w), bfhi(q.w)};
                    f32x4 h0, h1;
#pragma unroll
                    for (int j = 0; j < 4; ++j) { h0[j] = b0[j] + acc[ai][bj][m][0][j] * r * g[bj][0][j]; h1[j] = b1[j] + acc[ai][bj][m][1][j] * r * g[bj][1][j]; s2 += h0[j] * h0[j] + h1[j] * h1[j]; }
                    u32x4 w; w.x = cvt_pk_bf16(h0[0], h0[1]); w.y = cvt_pk_bf16(h0[2], h0[3]); w.z = cvt_pk_bf16(h1[0], h1[1]); w.w = cvt_pk_bf16(h1[2], h1[3]);
                    *(u32x4*)(hb + ro) = w; }
                if (WHICH == 1) { s2 += __shfl_xor(s2, 16); s2 += __shfl_xor(s2, 32); if (fq == 0) red[(ai * HALF + wr * 64 + m * 16 + fr) * 4 + wc] = s2; }
            }
        }
        if (WHICH == 1) {
            __syncthreads();
            if (tid < 256) { const f32x4 v = *(const f32x4*)(red + tid * 4); part2[(size_t)(brow + tid) * 4 + u.pn] = (v[0] + v[1]) + (v[2] + v[3]); }
        }
    }
};

template <class Epi>
__device__ __forceinline__ void run_gemm(const bf16_t* A, const bf16_t* Bt, int M, int N, int K, char* shm, const Epi& epi) {
    asm volatile("" : "+s"(K));
    pg8::Gemm g{A, Bt, M, N, K}; pg8::StaticOrder S; S.init(M, N, (int)gridDim.x, (int)blockIdx.x);
    pg8::gemm_phase<Epi, pg8::StaticOrder, true, true>((PG8_LAS unsigned char*)shm, g, S, epi);
}

__device__ __forceinline__ int src_col(int r, int mode) {
    if (mode == 0) return r;
    if (mode == 2) { const int g = r >> 9; const int sg = g == 0 ? 0 : g == 1 ? 1 : g == 2 ? 3 : g == 3 ? 4 : g == 4 ? 5 : g == 5 ? 2 : 6; return sg * 512 + (r & 511); }
    const int tile = r >> 8, w = r & 255, bj = w >> 7, j = w & 127;
    return bj * DFF + tile * 128 + j;
}
__device__ void conv_weight(const float* __restrict__ W, int K, int ldw, bf16_t* __restrict__ Wt, int Nrows, int mode, const float* __restrict__ gain, float* lds, int vb, int nvb) {
    const int nk = K / 64, nr = Nrows / 256, tid = threadIdx.x;
    for (int it = vb; it < nk * nr; it += nvb) {
        const int k0 = (it % nk) * 64, r0 = (it / nk) * 256;
        f32x4 v[8];
        const int sc = src_col(r0 + (tid & 63) * 4, mode);
#pragma unroll
        for (int i = 0; i < 8; ++i) v[i] = __builtin_nontemporal_load((const f32x4*)(W + (size_t)(k0 + (tid >> 6) + 8 * i) * ldw + sc));
        __syncthreads();
#pragma unroll
        for (int i = 0; i < 8; ++i) *(f32x4*)(lds + ((tid >> 6) + 8 * i) * 260 + (((tid & 63) * 4 + 4 * i) & 255)) = v[i];
        __syncthreads();
#pragma unroll
        for (int j = 0; j < 4; ++j) {
            const int e = tid + 512 * j, kg = e & 7, r = e >> 3;
            float f[8];
#pragma unroll
            for (int i = 0; i < 8; ++i) { f[i] = lds[(8 * kg + i) * 260 + ((r + 4 * kg) & 255)]; if (gain) f[i] *= gain[k0 + 8 * kg + i]; }
            u32x4 w; w.x = cvt_pk_bf16(f[0], f[1]); w.y = cvt_pk_bf16(f[2], f[3]); w.z = cvt_pk_bf16(f[4], f[5]); w.w = cvt_pk_bf16(f[6], f[7]);
            *(u32x4*)(Wt + (size_t)(r0 + r) * K + k0 + 8 * kg) = w;
        }
    }
}
__device__ void phase0_rest(const Params& p, char* shm) {
    float* lds = (float*)shm; char* ws = p.ws;
    const int vb = blockIdx.x, nvb = gridDim.x;
    conv_weight(p.w_out, DM, DM, (bf16_t*)(ws + OFF_WOUT), DM, 0, nullptr, lds, vb, nvb);
    conv_weight(p.w_gu, DM, 2 * DFF, (bf16_t*)(ws + OFF_WGU), 2 * DFF, 1, p.g_ffn_pre, lds, vb, nvb);
    conv_weight(p.w_down, DFF, DM, (bf16_t*)(ws + OFF_WDN), DM, 0, nullptr, lds, vb, nvb);
    conv_weight(p.w_pp, PLE, DM, (bf16_t*)(ws + OFF_WPP), DM, 0, nullptr, lds, vb, nvb);
    conv_weight(p.w_pg, DM, DM, (bf16_t*)(ws + OFF_WPG), DM, 0, nullptr, lds, vb, nvb);
    __syncthreads();
    bf16_t* pb = (bf16_t*)(ws + OFF_PB);
    for (size_t i0 = (size_t)blockIdx.x * 512 + threadIdx.x; i0 < (size_t)MT * PLE / 4; i0 += (size_t)gridDim.x * 512 * 4) {
        f32x4 v[4];
#pragma unroll
        for (int j = 0; j < 4; ++j) { const size_t i = i0 + (size_t)j * gridDim.x * 512; if (i < (size_t)MT * PLE / 4) v[j] = __builtin_nontemporal_load((const f32x4*)(p.p + i * 4)); }
#pragma unroll
        for (int j = 0; j < 4; ++j) { const size_t i = i0 + (size_t)j * gridDim.x * 512; if (i < (size_t)MT * PLE / 4) { u32x2 w; w.x = cvt_pk_bf16(v[j][0], v[j][1]); w.y = cvt_pk_bf16(v[j][2], v[j][3]); *(u32x2*)(pb + i * 4) = w; } }
    }
    __syncthreads();
}
__device__ void phase0(const Params& p, char* shm) {
    float* lds = (float*)shm; char* ws = p.ws;
    const int vb = blockIdx.x, nvb = gridDim.x;
    conv_weight(p.w_in, DM, NIN, (bf16_t*)(ws + OFF_WIN), NIN, 2, p.g_attn_pre, lds, vb, nvb);
    if (blockIdx.x == 0) { float* lb = (float*)(ws + OFF_LB); const int c = threadIdx.x; const float l = sigmoidf_(p.gamma[c] - p.gamma[512 + c]); lb[c] = l; lb[512 + c] = 1.0f - l; }
    const int wid = threadIdx.x >> 6, lane = threadIdx.x & 63;
    bf16_t* xb = (bf16_t*)(ws + OFF_XB); float* rx = (float*)(ws + OFF_RX);
    for (int row0 = (blockIdx.x * 8 + wid) * 4; row0 < MT; row0 += gridDim.x * 32) {
        f32x4 v[4][4];
#pragma unroll
        for (int r = 0; r < 4; ++r)
#pragma unroll
            for (int i = 0; i < 4; ++i) v[r][i] = __builtin_nontemporal_load((const f32x4*)(p.x + (size_t)(row0 + r) * DM + i * 256 + lane * 4));
#pragma unroll
        for (int r = 0; r < 4; ++r) {
            float ss = 0.f;
#pragma unroll
            for (int i = 0; i < 4; ++i) { const f32x4 t = v[r][i]; ss += t[0] * t[0] + t[1] * t[1] + t[2] * t[2] + t[3] * t[3];
                u32x2 w; w.x = cvt_pk_bf16(t[0], t[1]); w.y = cvt_pk_bf16(t[2], t[3]); *(u32x2*)(xb + (size_t)(row0 + r) * DM + i * 256 + lane * 4) = w; }
            ss = wave_sum(ss);
            if (lane == 0) rx[row0 + r] = rsqrtf(ss * (1.0f / DM) + EPS);
        }
    }
}

template <int WHICH>
__device__ void phase_res(const Params& p) {
    char* ws = p.ws; const int wid = threadIdx.x >> 6, lane = threadIdx.x & 63;
    const float* src = (const float*)(ws + (WHICH == 1 ? OFF_QT : OFF_Y)); const float* base = WHICH == 1 ? p.x : p.out; const float* gn = WHICH == 1 ? p.g_attn_post : p.g_ffn_post;
    bf16_t* hb = (bf16_t*)(ws + (WHICH == 1 ? OFF_XB : OFF_H2B)); float* rh = (float*)(ws + OFF_RH1);
    f32x4 g[4];
#pragma unroll
    for (int i = 0; i < 4; ++i) g[i] = *(const f32x4*)(gn + i * 256 + lane * 4);
    for (int row0 = (blockIdx.x * 8 + wid) * 2; row0 < MT; row0 += gridDim.x * 16) {
        f32x4 mv[2][4], xv[2][4];
#pragma unroll
        for (int r = 0; r < 2; ++r)
#pragma unroll
            for (int i = 0; i < 4; ++i) { mv[r][i] = __builtin_nontemporal_load((const f32x4*)(src + (size_t)(row0 + r) * DM + i * 256 + lane * 4)); xv[r][i] = __builtin_nontemporal_load((const f32x4*)(base + (size_t)(row0 + r) * DM + i * 256 + lane * 4)); }
#pragma unroll
        for (int r = 0; r < 2; ++r) {
            float ss = 0.f;
#pragma unroll
            for (int i = 0; i < 4; ++i) ss += mv[r][i][0] * mv[r][i][0] + mv[r][i][1] * mv[r][i][1] + mv[r][i][2] * mv[r][i][2] + mv[r][i][3] * mv[r][i][3];
            ss = wave_sum(ss); const float rr = rsqrtf(ss * (1.0f / DM) + EPS); float s2 = 0.f;
#pragma unroll
            for (int i = 0; i < 4; ++i) { const int c = i * 256 + lane * 4; f32x4 h;
#pragma unroll
                for (int j = 0; j < 4; ++j) { h[j] = xv[r][i][j] + mv[r][i][j] * rr * g[i][j]; s2 += h[j] * h[j]; }
                *(f32x4*)(p.out + (size_t)(row0 + r) * DM + c) = h; u32x2 w; w.x = cvt_pk_bf16(h[0], h[1]); w.y = cvt_pk_bf16(h[2], h[3]); *(u32x2*)(hb + (size_t)(row0 + r) * DM + c) = w; }
            if (WHICH == 1) { s2 = wave_sum(s2); if (lane == 0) rh[row0 + r] = rsqrtf(s2 * (1.0f / DM) + EPS); }
        }
    }
}

#define MFMA32(a, b, c) __builtin_amdgcn_mfma_f32_32x32x16_bf16((a), (b), (c), 0, 0, 0)
#define MFMA16(a, b, c) __builtin_amdgcn_mfma_f32_16x16x32_bf16((a), (b), (c), 0, 0, 0)
__device__ __forceinline__ bf16x8 mk8(u32x2 a, u32x2 b) { u32x4 t; t.x = a.x; t.y = a.y; t.z = b.x; t.w = b.y; return __builtin_bit_cast(bf16x8, t); }
__device__ void phase_attn(const Params& p, char* shm, unsigned* queue) {
    char* ws = p.ws; const int tid = opaque_tid(), h = tid >> 6, lane = tid & 63, n = lane & 31, hh = lane >> 5;
    const bf16_t* SQ = (const bf16_t*)(ws + OFF_SQ); const bf16_t* SK = (const bf16_t*)(ws + OFF_SQ + SZ_HALF); const bf16_t* SVT = (const bf16_t*)(ws + OFF_SVT);
    bf16_t* am = (bf16_t*)(ws + OFF_AMIX); float* red = (float*)shm;
    int* itp = (int*)(shm + 2048);
    unsigned nxt_it = 0;
    if (threadIdx.x == 0) nxt_it = __hip_atomic_fetch_add(queue, 1u, __ATOMIC_RELAXED, __HIP_MEMORY_SCOPE_AGENT);
    for (;;) {
        __syncthreads();
        if (threadIdx.x == 0) { *itp = (int)nxt_it; if (nxt_it < NB * 128) nxt_it = __hip_atomic_fetch_add(queue, 1u, __ATOMIC_RELAXED, __HIP_MEMORY_SCOPE_AGENT); }
        __syncthreads();
        const int it0 = *itp; if (it0 >= NB * 128) break;
        const int it = NB * 128 - 1 - it0;
        const int b = it >> 7, qb = it & 127, t0 = qb * 32;
        const size_t tokq = (size_t)b * NT + t0 + n;
        f32x16 o0, o1;
#pragma unroll
        for (int r = 0; r < 16; ++r) { o0[r] = 0.f; o1[r] = 0.f; }
        float R = 1.0f;
        char* sK = shm + 4096 + h * 9728; char* sV = sK + 4608;
        const int kr = lane >> 3, kc = lane & 7, vr = lane >> 2, vc = lane & 3;
        u32x4 kcur[4], vcur[4];
#define ATT_TILE(kd, vd, tokb) do { const size_t _tb = (tokb); \
            _Pragma("unroll") for (int i = 0; i < 4; ++i) { kd[i] = *(const u32x4*)(SK + (_tb + kr + 8 * i) * 512 + h * 64 + kc * 8); \
                                                           vd[i] = *(const u32x4*)(SVT + vt_off(h * 64 + vr + 16 * i, _tb) + vc * 8); } } while (0)
        ATT_TILE(kcur, vcur, (size_t)b * NT + t0);
        bf16x8 qf[4];
        {
            u32x4 qc[4];
#pragma unroll
            for (int i = 0; i < 4; ++i) qc[i] = *(const u32x4*)(SQ + ((size_t)b * NT + t0 + kr + 8 * i) * 512 + h * 64 + kc * 8);
            asm volatile("" ::: "memory");
#pragma unroll
            for (int i = 0; i < 4; ++i) *(u32x4*)(sK + (kr + 8 * i) * 144 + kc * 16) = qc[i];
            asm volatile("" ::: "memory");
#pragma unroll
            for (int ks = 0; ks < 4; ++ks) qf[ks] = *(const bf16x8*)(sK + n * 144 + (16 * ks + 8 * hh) * 2);
            asm volatile("" ::: "memory");
        }
        for (int kb = qb; kb >= 0; --kb) {
            const int s1 = (kb > 0 ? kb - 1 : 0) * 32;
            u32x4 knx[4], vnx[4];
            ATT_TILE(knx, vnx, (size_t)b * NT + s1);
            asm volatile("" ::: "memory");
#pragma unroll
            for (int i = 0; i < 4; ++i) { *(u32x4*)(sK + (kr + 8 * i) * 144 + kc * 16) = kcur[i]; *(u32x4*)(sV + (vr + 16 * i) * 80 + vc * 16) = vcur[i]; }
            asm volatile("" ::: "memory");
            bf16x8 kf[4]; u32x2 vf[2][2][2];
#pragma unroll
            for (int ks = 0; ks < 4; ++ks) kf[ks] = *(const bf16x8*)(sK + n * 144 + (16 * ks + 8 * hh) * 2);
#pragma unroll
            for (int db = 0; db < 2; ++db)
#pragma unroll
                for (int s = 0; s < 2; ++s)
#pragma unroll
                    for (int hf = 0; hf < 2; ++hf) vf[db][s][hf] = *(const u32x2*)(sV + (32 * db + n) * 80 + (16 * s + 8 * hf + 4 * hh) * 2);
            f32x16 st;
#pragma unroll
            for (int r = 0; r < 16; ++r) st[r] = 0.f;
#pragma unroll
            for (int ks = 0; ks < 4; ++ks) st = MFMA32(kf[ks], qf[ks], st);
            float mm[16], be[16];
#pragma unroll
            for (int r = 0; r < 16; ++r) { const float e = fexp2(st[r]); mm[r] = frcp(1.0f + e); be[r] = 1.0f - mm[r]; }
            if (kb == qb) {
#pragma unroll
                for (int r = 0; r < 16; ++r) { const bool act = ((r & 3) + 8 * (r >> 2) + 4 * hh) < n; mm[r] = act ? mm[r] : 1.0f; be[r] = act ? be[r] : 0.0f; }
            }
            float go[4], gp[4], T[4];
#pragma unroll
            for (int g = 0; g < 4; ++g) { go[g] = (mm[4 * g] * mm[4 * g + 1]) * (mm[4 * g + 2] * mm[4 * g + 3]); gp[g] = __shfl_xor(go[g], 32); }
            T[3] = 1.0f; T[2] = go[3] * gp[3]; T[1] = T[2] * (go[2] * gp[2]); T[0] = T[1] * (go[1] * gp[1]);
            const float tot = T[0] * (go[0] * gp[0]);
            float aa[16];
#pragma unroll
            for (int g = 0; g < 4; ++g) {
                float x = R * T[g] * (hh == 0 ? gp[g] : 1.0f);
                aa[4 * g + 3] = be[4 * g + 3] * x; x *= mm[4 * g + 3];
                aa[4 * g + 2] = be[4 * g + 2] * x; x *= mm[4 * g + 2];
                aa[4 * g + 1] = be[4 * g + 1] * x; x *= mm[4 * g + 1];
                aa[4 * g + 0] = be[4 * g + 0] * x;
            }
            u32x4 p0, p1;
            p0.x = cvt_pk_bf16(aa[0], aa[1]); p0.y = cvt_pk_bf16(aa[2], aa[3]); p0.z = cvt_pk_bf16(aa[4], aa[5]); p0.w = cvt_pk_bf16(aa[6], aa[7]);
            p1.x = cvt_pk_bf16(aa[8], aa[9]); p1.y = cvt_pk_bf16(aa[10], aa[11]); p1.z = cvt_pk_bf16(aa[12], aa[13]); p1.w = cvt_pk_bf16(aa[14], aa[15]);
            const bf16x8 pf0 = __builtin_bit_cast(bf16x8, p0), pf1 = __builtin_bit_cast(bf16x8, p1);
            o0 = MFMA32(mk8(vf[0][0][0], vf[0][0][1]), pf0, o0); o0 = MFMA32(mk8(vf[0][1][0], vf[0][1][1]), pf1, o0);
            o1 = MFMA32(mk8(vf[1][0][0], vf[1][0][1]), pf0, o1); o1 = MFMA32(mk8(vf[1][1][0], vf[1][1][1]), pf1, o1);
            R *= tot;
            if (__ballot(R >= 0x1p-134f) == 0ull) break;
#pragma unroll
            for (int i = 0; i < 4; ++i) { kcur[i] = knx[i]; vcur[i] = vnx[i]; }
        }
        float ss = 0.f;
#pragma unroll
        for (int r = 0; r < 16; ++r) ss += o0[r] * o0[r] + o1[r] * o1[r];
        ss += __shfl_xor(ss, 32);
        __syncthreads();
        if (hh == 0) red[h * 32 + n] = ss;
        __syncthreads();
        float tsum = 0.f;
#pragma unroll
        for (int w = 0; w < 8; ++w) tsum += red[w * 32 + n];
        const float rr = rsqrtf(tsum * (1.0f / 512) + EPS);
        f32x4 gwv[2][4];
#pragma unroll
        for (int db = 0; db < 2; ++db)
#pragma unroll
            for (int g = 0; g < 4; ++g) gwv[db][g] = *(const f32x4*)(p.g_sb + h * 64 + 32 * db + 8 * g + 4 * hh);
#pragma unroll
        for (int db = 0; db < 2; ++db)
#pragma unroll
            for (int g = 0; g < 4; ++g) {
                const int d0 = 32 * db + 8 * g + 4 * hh; const f32x4 gw = gwv[db][g];
                float v[4];
#pragma unroll
                for (int j = 0; j < 4; ++j) v[j] = (db == 0 ? o0[4 * g + j] : o1[4 * g + j]) * rr * gw[j];
                u32x2 w; w.x = cvt_pk_bf16(v[0], v[1]); w.y = cvt_pk_bf16(v[2], v[3]);
                *(u32x2*)(sK + n * 144 + d0 * 2) = w;
            }
        asm volatile("" ::: "memory");
#pragma unroll
        for (int i = 0; i < 4; ++i) { const u32x4 x = *(const u32x4*)(sK + (kr + 8 * i) * 144 + kc * 16);
            *(u32x4*)(am + ((size_t)b * NT + t0 + kr + 8 * i) * DM + 512 + h * 64 + kc * 8) = x; }
        asm volatile("" ::: "memory");
    }
}

#define LDS_BAR() do { asm volatile("s_waitcnt lgkmcnt(0)" ::: "memory"); __builtin_amdgcn_s_barrier(); asm volatile("" ::: "memory"); } while (0)
constexpr int HSEG = 8;
__device__ __forceinline__ int seg_first(int s) { return s < 2 ? 9 * s : (s < 6 ? 18 + 8 * (s - 2) : 50 + 7 * (s - 6)); }
__device__ __forceinline__ int seg_len(int s) { return s < 2 ? 9 : (s < 6 ? 8 : 7); }
template <bool FULL>
__device__ void phase_hgseg(const Params& p, char* shm, int bh, int seg) {
    char* ws = p.ws; const int tid = opaque_tid(), w = tid >> 6, lane = tid & 63, fr = lane & 15, fq = lane >> 4, kp = tid & 63, r8 = tid >> 6;
    const int b = bh >> 2, h = bh & 3;
    const unsigned short* LF = (const unsigned short*)(ws + OFF_BC); const bf16_t* QT = (const bf16_t*)(ws + OFF_QT);
    const bf16_t* G = (const bf16_t*)(ws + OFF_QT + 3 * SZ_HALF); const bf16_t* VHT = (const bf16_t*)(ws + OFF_VHT);
    bf16_t* am = (bf16_t*)(ws + OFF_AMIX); float* parth = (float*)(ws + OFF_DC); float* SLOC = (float*)(ws + OFF_SLOC); float* DSEG = (float*)(ws + OFF_SLOC + 32 * MiB);
    float* qs = (float*)shm; float* dvec = (float*)(shm + 4096); float* red = (float*)(shm + 4608);
    char* sQs = shm + 8192; char* sQd = sQs + 17408; char* sKd = sQd + 17408; char* sP = sKd + 17408; char* keT = sP + 9216;
    f32x4 S[8];
#pragma unroll
    for (int kb = 0; kb < 8; ++kb) S[kb] = (f32x4){0.f, 0.f, 0.f, 0.f};
    f32x2 lfn[8]; unsigned qn[8]; bf16x8 vn[2]; u32x2 gn[4];
#define HG_LOAD(cc) do { const size_t _t0 = (size_t)b * NT + 64 * (cc); \
        _Pragma("unroll") for (int i = 0; i < 8; ++i) { const size_t a_ = (_t0 + 8 * r8 + i) * 512 + h * 128 + 2 * kp; lfn[i] = unpk_f16(*(const unsigned*)(LF + a_)); if (FULL) qn[i] = *(const unsigned*)(QT + a_); } \
        _Pragma("unroll") for (int ks = 0; ks < 2; ++ks) vn[ks] = *(const bf16x8*)(VHT + vt_off(h * 128 + 16 * w + fr, _t0) + 32 * ks + 8 * fq); \
        if (FULL) { _Pragma("unroll") for (int tb = 0; tb < 4; ++tb) gn[tb] = *(const u32x2*)(G + (_t0 + 16 * tb + fr) * 512 + h * 128 + 16 * w + 4 * fq); } } while (0)
    const int c0 = seg_first(seg), HCH = seg_len(seg);
    HG_LOAD(c0);
    if (FULL) {
        for (int s = 0; s < seg; ++s) {
            const float* sl = SLOC + ((size_t)(bh * HSEG + s) * 128 + 16 * w + fr) * 128 + 4 * fq; const float* ds = DSEG + (size_t)(bh * HSEG + s) * 128 + 4 * fq;
            f32x4 lv[8], dv[8];
#pragma unroll
            for (int kb = 0; kb < 8; ++kb) { lv[kb] = *(const f32x4*)(sl + 16 * kb); dv[kb] = *(const f32x4*)(ds + 16 * kb); }
#pragma unroll
            for (int kb = 0; kb < 8; ++kb) S[kb] = S[kb] * dv[kb] + lv[kb];
        }
    }
    f32x4 gw = {0.f, 0.f, 0.f, 0.f};
    if (FULL) gw = *(const f32x4*)(p.g_hg + h * 128 + 16 * w + 4 * fq);
    float dsum0 = 0.f, dsum1 = 0.f;
    for (int ci = 0; ci < HCH; ++ci) {
        const int c = c0 + ci; const size_t tok0 = (size_t)b * NT + 64 * c;
        f32x2 lfv[8], kkv[8]; unsigned qv[8]; bf16x8 vfr[2]; u32x2 gv[4];
#pragma unroll
        for (int i = 0; i < 8; ++i) { lfv[i] = lfn[i]; kkv[i].x = 1.0f - fexp2(lfn[i].x); kkv[i].y = 1.0f - fexp2(lfn[i].y); if (FULL) qv[i] = qn[i]; }
        vfr[0] = vn[0]; vfr[1] = vn[1];
        if (FULL) {
#pragma unroll
            for (int tb = 0; tb < 4; ++tb) gv[tb] = gn[tb];
        }
        { const int cn = ci < HCH - 1 ? c + 1 : c; HG_LOAD(cn); }
        f32x2 run = {0.f, 0.f};
#pragma unroll
        for (int i = 0; i < 8; ++i) { run += lfv[i]; lfv[i] = run; }
        *(f32x2*)(qs + r8 * 128 + 2 * kp) = run;
        LDS_BAR();
        if (FULL && ci > 0 && tid < 64) { float s = 0.f;
#pragma unroll
            for (int ww = 0; ww < 8; ++ww) s += red[ww * 64 + tid];
            parth[(tok0 - 64 + tid) * 4 + h] = s; }
        f32x2 off = {0.f, 0.f}, bmid = {0.f, 0.f}, blast = {0.f, 0.f};
#pragma unroll
        for (int j = 0; j < 8; ++j) { const f32x2 q = *(const f32x2*)(qs + j * 128 + 2 * kp); if (j < r8) off += q; if (j < 4) bmid += q; blast += q; }
        if (r8 == 0) { f32x2 d; d.x = fexp2(blast.x); d.y = fexp2(blast.y); *(f32x2*)(dvec + 2 * kp) = d; dsum0 += blast.x; dsum1 += blast.y; }
        f32x2 emid, elast;
        emid.x = fexp2(bmid.x); emid.y = fexp2(bmid.y); elast.x = fexp2(blast.x - bmid.x); elast.y = fexp2(blast.y - bmid.y);
        float ke0[8], ke1[8];
#pragma unroll
        for (int i = 0; i < 8; ++i) {
            const int t = 8 * r8 + i; const f32x2 bb = off + lfv[i];
            const float k0 = kkv[i].x, k1 = kkv[i].y;
            const float f0 = fexp2(bmid.x - bb.x), f1 = fexp2(bmid.y - bb.y);
            const float kd0 = k0 * f0, kd1 = k1 * f1;
            ke0[i] = kd0 * elast.x; ke1[i] = kd1 * elast.y;
            if (FULL) {
                const float e0 = fexp2(bb.x - bmid.x), e1 = fexp2(bb.y - bmid.y);
                const float qd0 = bflo(qv[i]) * e0, qd1 = bfhi(qv[i]) * e1;
                *(unsigned*)(sQd + t * 272 + kp * 4) = cvt_pk_bf16(qd0, qd1);
                *(unsigned*)(sQs + t * 272 + kp * 4) = cvt_pk_bf16(qd0 * emid.x, qd1 * emid.y);
                *(unsigned*)(sKd + t * 272 + kp * 4) = cvt_pk_bf16(kd0, kd1);
            }
        }
        { u32x4 a0, a1;
          a0.x = cvt_pk_bf16(ke0[0], ke0[1]); a0.y = cvt_pk_bf16(ke0[2], ke0[3]); a0.z = cvt_pk_bf16(ke0[4], ke0[5]); a0.w = cvt_pk_bf16(ke0[6], ke0[7]);
          a1.x = cvt_pk_bf16(ke1[0], ke1[1]); a1.y = cvt_pk_bf16(ke1[2], ke1[3]); a1.z = cvt_pk_bf16(ke1[4], ke1[5]); a1.w = cvt_pk_bf16(ke1[6], ke1[7]);
          *(u32x4*)(keT + (2 * kp) * 144 + r8 * 16) = a0; *(u32x4*)(keT + (2 * kp + 1) * 144 + r8 * 16) = a1; }
        LDS_BAR();
        if (FULL) {
            {
                const int tb = w >> 1;
                bf16x8 qf[4], kf[2][4];
#pragma unroll
                for (int ks = 0; ks < 4; ++ks) { qf[ks] = *(const bf16x8*)(sQd + (16 * tb + fr) * 272 + 64 * ks + 16 * fq);
#pragma unroll
                    for (int u = 0; u < 2; ++u) kf[u][ks] = *(const bf16x8*)(sKd + (16 * (2 * (w & 1) + u) + fr) * 272 + 64 * ks + 16 * fq); }
                __builtin_amdgcn_sched_barrier(0);
#pragma unroll
                for (int u = 0; u < 2; ++u) {
                    const int sb = 2 * (w & 1) + u;
                    f32x4 acc = {0.f, 0.f, 0.f, 0.f};
                    if (sb <= tb) {
#pragma unroll
                        for (int ks = 0; ks < 4; ++ks) acc = MFMA16(kf[u][ks], qf[ks], acc);
                    }
                    const int t = 16 * tb + fr, s0 = 16 * sb + 4 * fq;
#pragma unroll
                    for (int j = 0; j < 4; ++j) acc[j] = (s0 + j <= t) ? acc[j] : 0.f;
                    u32x2 o; o.x = cvt_pk_bf16(acc[0], acc[1]); o.y = cvt_pk_bf16(acc[2], acc[3]);
                    *(u32x2*)(sP + t * 144 + s0 * 2) = o;
                }
            }
            LDS_BAR();
            bf16x8 sb16[4];
#pragma unroll
            for (int ks = 0; ks < 4; ++ks) { u32x4 t4; t4.x = cvt_pk_bf16(S[2 * ks][0], S[2 * ks][1]); t4.y = cvt_pk_bf16(S[2 * ks][2], S[2 * ks][3]); t4.z = cvt_pk_bf16(S[2 * ks + 1][0], S[2 * ks + 1][1]); t4.w = cvt_pk_bf16(S[2 * ks + 1][2], S[2 * ks + 1][3]); sb16[ks] = __builtin_bit_cast(bf16x8, t4); }
            bf16x8 qsf[4][4], pf[4][2];
#pragma unroll
            for (int tb = 0; tb < 4; ++tb) {
#pragma unroll
                for (int ks = 0; ks < 4; ++ks) { const u32x2 lo = *(const u32x2*)(sQs + (16 * tb + fr) * 272 + (32 * ks + 4 * fq) * 2), hi = *(const u32x2*)(sQs + (16 * tb + fr) * 272 + (32 * ks + 16 + 4 * fq) * 2); qsf[tb][ks] = mk8(lo, hi); }
#pragma unroll
                for (int ks = 0; ks < 2; ++ks) pf[tb][ks] = *(const bf16x8*)(sP + (16 * tb + fr) * 144 + 64 * ks + 16 * fq);
            }
            __builtin_amdgcn_sched_barrier(0);
#pragma unroll
            for (int tb = 0; tb < 4; ++tb) {
                f32x4 acc = {0.f, 0.f, 0.f, 0.f};
#pragma unroll
                for (int ks = 0; ks < 4; ++ks) acc = MFMA16(sb16[ks], qsf[tb][ks], acc);
#pragma unroll
                for (int ks = 0; ks < 2; ++ks) acc = MFMA16(vfr[ks], pf[tb][ks], acc);
                float s = (acc[0] * acc[0] + acc[1] * acc[1]) + (acc[2] * acc[2] + acc[3] * acc[3]);
                s += __shfl_xor(s, 16); s += __shfl_xor(s, 32);
                if (fq == 0) red[w * 64 + 16 * tb + fr] = s;
                const u32x2 g2 = gv[tb];
                u32x2 o; o.x = cvt_pk_bf16(acc[0] * gw[0] * bflo(g2.x), acc[1] * gw[1] * bfhi(g2.x)); o.y = cvt_pk_bf16(acc[2] * gw[2] * bflo(g2.y), acc[3] * gw[3] * bfhi(g2.y));
                *(u32x2*)(am + (tok0 + 16 * tb + fr) * DM + h * 128 + 16 * w + 4 * fq) = o;
            }
        }
#pragma unroll
        for (int kg = 0; kg < 2; ++kg) {
            f32x4 dd[4]; bf16x8 kf[4][2];
#pragma unroll
            for (int q = 0; q < 4; ++q) { const int kb = 4 * kg + q; dd[q] = *(const f32x4*)(dvec + 16 * kb + 4 * fq);
#pragma unroll
                for (int ks = 0; ks < 2; ++ks) kf[q][ks] = *(const bf16x8*)(keT + (16 * kb + fr) * 144 + 64 * ks + 16 * fq); }
            __builtin_amdgcn_sched_barrier(0);
#pragma unroll
            for (int q = 0; q < 4; ++q) { const int kb = 4 * kg + q;
                f32x4 acc = S[kb] * dd[q];
#pragma unroll
                for (int ks = 0; ks < 2; ++ks) acc = MFMA16(kf[q][ks], vfr[ks], acc);
                S[kb] = acc; }
        }
    }
    if (FULL) {
        __syncthreads();
        if (tid < 64) { float s = 0.f;
#pragma unroll
            for (int ww = 0; ww < 8; ++ww) s += red[ww * 64 + tid];
            parth[((size_t)b * NT + 64 * (c0 + HCH - 1) + tid) * 4 + h] = s; }
    } else {
#pragma unroll
        for (int kb = 0; kb < 8; ++kb) *(f32x4*)(SLOC + ((size_t)(bh * HSEG + seg) * 128 + 16 * w + fr) * 128 + 16 * kb + 4 * fq) = S[kb];
        if (r8 == 0) { f32x2 d; d.x = fexp2(dsum0); d.y = fexp2(dsum1); *(f32x2*)(DSEG + (size_t)(bh * HSEG + seg) * 128 + 2 * kp) = d; }
    }
    __syncthreads();
#undef HG_LOAD
}

#define XB_TMO      128
#define XB_XCNT(j)  (256  + 64 * (j))
#define XB_XSUB(j)  (1280 + 64 * (j))
#define XB_XGEN(j)  (2304 + 64 * (j))
#define XB_TOP      3328
#define XB_TOPGEN   3392
#define XCD_BAR_WORDS 3456
#define XB_SPIN_CAP (1u << 18)
#define LAS __attribute__((address_space(3)))

__device__ __forceinline__ unsigned xb_ld(unsigned* p)              { return __hip_atomic_load(p, __ATOMIC_RELAXED, __HIP_MEMORY_SCOPE_AGENT); }
__device__ __forceinline__ unsigned xb_add(unsigned* p, unsigned v) { return __hip_atomic_fetch_add(p, v, __ATOMIC_RELAXED, __HIP_MEMORY_SCOPE_AGENT); }
__device__ __forceinline__ unsigned xb_xcc_id() { return (unsigned)__builtin_amdgcn_s_getreg((3 << 11) | 20) & 0xFu; }
#define XB_SPIN(cond, bar) do { unsigned _sp = 0; while (cond) { __builtin_amdgcn_s_sleep(1); \
    if ((++_sp & 255u) == 0u) { if (xb_ld(&(bar)[XB_TMO])) break; if (_sp > XB_SPIN_CAP) { atomicAdd(&(bar)[XB_TMO], 1u); break; } } } } while (0)

struct XcdBarrier {
    unsigned* bar; unsigned x;
    volatile LAS unsigned* st;
};

__device__ __forceinline__ XcdBarrier xcd_barrier_post(unsigned* bar, volatile LAS unsigned* st) {
    XcdBarrier b; b.bar = bar; b.x = xb_xcc_id(); b.st = st;
    if (threadIdx.x == 0) (void)xb_add(&bar[XB_XCNT(b.x)], 1u);
    return b;
}
__device__ __forceinline__ void xcd_barrier_complete(unsigned* bar, unsigned x, unsigned& nloc, unsigned& nx) {
    const unsigned G = gridDim.x * gridDim.y * gridDim.z;
    unsigned sum, cnt, mine, sp = 0u;
    for (;;) {
        sum = 0u; cnt = 0u; mine = 0u;
#pragma unroll
        for (unsigned j = 0; j < 16; ++j) { const unsigned c = xb_ld(&bar[XB_XCNT(j)]); sum += c; cnt += (c > 0u) ? 1u : 0u; mine = (j == x) ? c : mine; }
        if (sum == G) break;
        __builtin_amdgcn_s_sleep(1);
        if ((++sp & 255u) == 0u) { if (xb_ld(&bar[XB_TMO])) break; if (sp > XB_SPIN_CAP) { atomicAdd(&bar[XB_TMO], 1u); break; } }
    }
    nloc = mine > 0u ? mine : 1u; nx = cnt > 0u ? cnt : 1u;
}

__device__ __forceinline__ void xcd_barrier(const XcdBarrier& b) {
    asm volatile("s_waitcnt vmcnt(0)" ::: "memory");
    __syncthreads();
    if (threadIdx.x == 0) {
        unsigned* bar = b.bar;
        __builtin_amdgcn_s_waitcnt(0);
        unsigned nloc = b.st[0], nx = b.st[1];
        if (nloc == 0u) { xcd_barrier_complete(bar, b.x, nloc, nx); b.st[0] = nloc; b.st[1] = nx; }
        const unsigned old = xb_add(&bar[XB_XSUB(b.x)], 1u);
        const unsigned gen = old / nloc;
        if (old + 1u == (gen + 1u) * nloc) {
            __builtin_amdgcn_fence(__ATOMIC_RELEASE, "agent");
            asm volatile("s_waitcnt vmcnt(0)" ::: "memory");
            const unsigned og = xb_add(&bar[XB_TOP], 1u);
            const unsigned tg = og / nx;
            if (og + 1u == (tg + 1u) * nx) xb_add(&bar[XB_TOPGEN], 1u);
            else XB_SPIN(xb_ld(&bar[XB_TOPGEN]) == tg, bar);
            __builtin_amdgcn_fence(__ATOMIC_ACQUIRE, "agent");
            xb_add(&bar[XB_XGEN(b.x)], 1u);
            asm volatile("s_waitcnt vmcnt(0)" ::: "memory");
        } else {
            XB_SPIN(xb_ld(&bar[XB_XGEN(b.x)]) == gen, bar);
            __builtin_amdgcn_fence(__ATOMIC_ACQUIRE, "agent");
            asm volatile("s_waitcnt vmcnt(0)" ::: "memory");
        }
    }
    __syncthreads();
}


template <int PH> __device__ __forceinline__ void do_phase(const Params& p, char* shm) {
    char* ws = p.ws; char* epl = shm + SHM_B + 16;
    if (PH == 0) phase0(p, shm);
    if (PH == 1) {
        if (blockIdx.x & 1) phase0_rest(p, shm);
        run_gemm((const bf16_t*)(ws + OFF_XB), (const bf16_t*)(ws + OFF_WIN), MT, 2560, DM, shm, EpiIn{(const float*)(ws + OFF_RX), ws, epl});
        run_gemm((const bf16_t*)(ws + OFF_WIN) + (size_t)2560 * DM, (const bf16_t*)(ws + OFF_XB), 1024, MT, DM, shm, EpiVT{(const float*)(ws + OFF_RX), ws, epl});
        if (!(blockIdx.x & 1)) phase0_rest(p, shm);
    }
    if (PH == 2) { for (int u = blockIdx.x; u < 32 * HSEG; u += gridDim.x) if ((u & (HSEG - 1)) != HSEG - 1) phase_hgseg<false>(p, shm, u / HSEG, u & (HSEG - 1));
                   phase_attn(p, shm, (unsigned*)(ws + OFF_CNT) + 2 * 128 * 64); }
    if (PH == 3) { for (int u = blockIdx.x; u < 32 * HSEG; u += gridDim.x) phase_hgseg<true>(p, shm, u / HSEG, u & (HSEG - 1)); }
    if (PH == 5) run_gemm((const bf16_t*)(ws + OFF_AMIX), (const bf16_t*)(ws + OFF_WOUT), MT, DM, DM, shm,
                          EpiRes<1>{p.g_attn_post, (bf16_t*)(ws + OFF_XB), (float*)(ws + OFF_PART1), (unsigned*)(ws + OFF_CNT), (float*)(ws + OFF_PART2), epl, (const float*)(ws + OFF_DC)});
    if (PH == 7) {
        const bool ple_first = ((blockIdx.x >> 3) & 1) != 0;
        if (ple_first) run_gemm((const bf16_t*)(ws + OFF_PB), (const bf16_t*)(ws + OFF_WPP), MT, DM, PLE, shm, EpiBf16{(bf16_t*)(ws + OFF_PLE), DM});
        run_gemm((const bf16_t*)(ws + OFF_XB), (const bf16_t*)(ws + OFF_WGU), MT, 2 * DFF, DM, shm, EpiAct{(const float*)(ws + OFF_PART2), (bf16_t*)(ws + OFF_ACT), epl});
        if (!ple_first) run_gemm((const bf16_t*)(ws + OFF_PB), (const bf16_t*)(ws + OFF_WPP), MT, DM, PLE, shm, EpiBf16{(bf16_t*)(ws + OFF_PLE), DM});
    }
    if (PH == 8) run_gemm((const bf16_t*)(ws + OFF_ACT), (const bf16_t*)(ws + OFF_WDN), MT, DM, DFF, shm,
                          EpiRes<2>{p.g_ffn_post, (bf16_t*)(ws + OFF_XB), (float*)(ws + OFF_PART3), (unsigned*)(ws + OFF_CNT) + 128 * 64, nullptr, epl, nullptr});
    if (PH == 10) run_gemm((const bf16_t*)(ws + OFF_XB), (const bf16_t*)(ws + OFF_WPG), MT, DM, DM, shm, EpiFinal{p.out, (const bf16_t*)(ws + OFF_PLE), (const bf16_t*)(ws + OFF_XB)});
}
#if MEGA
__global__ __launch_bounds__(512) void k_mega(Params p) {
    extern __shared__ __attribute__((aligned(16))) char shm[];
    cg::grid_group grid = cg::this_grid();
    volatile LAS unsigned* st = (volatile LAS unsigned*)(shm + SHM_B);
    if (threadIdx.x < 2) st[threadIdx.x] = 0u;
    __syncthreads();
    const XcdBarrier xb = xcd_barrier_post((unsigned*)(p.ws + OFF_BAR), st);
    if (p.ws == nullptr) grid.sync();
    do_phase<0>(p, shm); xcd_barrier(xb);
    do_phase<1>(p, shm); xcd_barrier(xb);
    do_phase<2>(p, shm); xcd_barrier(xb);
    do_phase<3>(p, shm); xcd_barrier(xb);
    do_phase<5>(p, shm); xcd_barrier(xb);
    do_phase<7>(p, shm); xcd_barrier(xb);
    do_phase<8>(p, shm); xcd_barrier(xb);
    do_phase<10>(p, shm);
}
#else
template <int PH> __global__ __launch_bounds__(512) void k_phase(Params p) {
    extern __shared__ __attribute__((aligned(16))) char shm[];
    do_phase<PH>(p, shm);
}
template <int PH> static void launch_phase(const Params& p, hipStream_t s) {
    static bool attr = false;
    if (!attr) { (void)hipFuncSetAttribute((const void*)k_phase<PH>, hipFuncAttributeMaxDynamicSharedMemorySize, SHM_B); attr = true; }
    hipLaunchKernelGGL(k_phase<PH>, dim3(256), dim3(512), SHM_B, s, p);
}
#endif

extern "C" void kernel_launch(void* const* d_in, const int* in_sizes, int n_in, void* d_out, int out_size, void* d_ws, size_t ws_size, hipStream_t stream) {
    Params p{};
    p.x = (const float*)d_in[0]; p.p = (const float*)d_in[1]; p.g_attn_pre = (const float*)d_in[2]; p.w_in = (const float*)d_in[3]; p.gamma = (const float*)d_in[4];
    p.g_hg = (const float*)d_in[5]; p.g_sb = (const float*)d_in[6]; p.w_out = (const float*)d_in[7]; p.g_attn_post = (const float*)d_in[8]; p.g_ffn_pre = (const float*)d_in[9];
    p.w_gu = (const float*)d_in[10]; p.w_down = (const float*)d_in[11]; p.g_ffn_post = (const float*)d_in[12]; p.w_pp = (const float*)d_in[13]; p.w_pg = (const float*)d_in[14];
    p.out = (float*)d_out; p.ws = (char*)d_ws;
#if MEGA
    static int grid_blocks = 0;
    if (!grid_blocks) {
        int dev = 0, cus = 0, per_cu = 0;
        (void)hipGetDevice(&dev); (void)hipDeviceGetAttribute(&cus, hipDeviceAttributeMultiprocessorCount, dev);
        (void)hipFuncSetAttribute((const void*)k_mega, hipFuncAttributeMaxDynamicSharedMemorySize, LDS_TOTAL);
        (void)hipOccupancyMaxActiveBlocksPerMultiprocessor(&per_cu, (const void*)k_mega, 512, LDS_TOTAL);
        if (per_cu < 1) per_cu = 1;
        grid_blocks = cus * per_cu;
    }
    (void)hipMemsetAsync((char*)d_ws + OFF_BAR, 0, CTL_BYTES, stream);
    void* args[] = {&p};
    hipError_t e = hipLaunchCooperativeKernel((const void*)k_mega, dim3(grid_blocks), dim3(512), args, LDS_TOTAL, stream);
    if (e != hipSuccess) fprintf(stderr, "cooperative launch failed: %s (grid %d)\n", hipGetErrorString(e), grid_blocks);
#else
    launch_phase<0>(p, stream); launch_phase<1>(p, stream); launch_phase<2>(p, stream); launch_phase<3>(p, stream); launch_phase<5>(p, stream);
    launch_phase<7>(p, stream); launch_phase<8>(p, stream); launch_phase<10>(p, stream);
#endif
}
```
